# Optimizing an MI355X kernel written in HIP

```python
import jax
import jax.numpy as jnp
from jax import lax
import numpy as np

D_MODEL = 1024
BATCH = 16
SEQ = 2048
DEPTH = 2

HEAD_DIM = 64
BLOCK_Q = 128
A_HEADS = 8
A_KV_HEADS = 2
A_WINDOW = 128
B_HEADS = 8
B_KV_HEADS = 2
CMP_LEN = 32
CMP_STRIDE = 16
CMP_HIDDEN = 256
SLC_BLOCK = 64
SLC_TOPN = 8
B_WINDOW = 256
N_ATT_HEADS = A_HEADS + B_HEADS
A_Q_W = A_HEADS * HEAD_DIM
A_KV_W = A_KV_HEADS * HEAD_DIM
B_Q_W = B_HEADS * HEAD_DIM
B_KV_W = B_KV_HEADS * HEAD_DIM
N_GATES = 3 * B_HEADS
IN_SPLITS = (A_Q_W, A_KV_W, A_KV_W, B_Q_W, B_KV_W, B_KV_W, B_KV_W, B_KV_W, B_KV_W, B_KV_W, N_GATES)
IN_PROJ_W = sum(IN_SPLITS)
ATT_W = N_ATT_HEADS * HEAD_DIM
GMLP_W = D_MODEL
GMLP_GROUPS = 8
GMLP_CHUNK = 128
D_FF = 2816
N_EXPERTS = 8
TOP_K = 2
D_FF_EXPERT = 3584
MOE_BLOCK = 256
DN_ALPHA = (2.0 * DEPTH) ** 0.25
DN_BETA = (8.0 * DEPTH) ** -0.25
LN_EPS = 1e-5
N_EVEN = (DEPTH + 1) // 2
N_ODD = DEPTH // 2

kernel_name = 'hybrid_swa_nsa_gmlp_moe_deepnorm'


def layer_norm(x, g, b):
    xf = x.astype(jnp.float32)
    mu = jnp.mean(xf, axis=-1, keepdims=True)
    var = jnp.mean(jnp.square(xf - mu), axis=-1, keepdims=True)
    return ((xf - mu) * lax.rsqrt(var + LN_EPS)).astype(x.dtype) * g + b


def masked_softmax(s, mask, sink=None):
    s = jnp.where(mask, s, -jnp.inf)
    m = jnp.max(s, axis=-1, keepdims=True)
    if sink is not None:
        m = jnp.maximum(m, sink)
    m = jnp.where(jnp.isfinite(m), m, 0.0)
    e = jnp.where(mask, jnp.exp(s - m), 0.0)
    den = jnp.sum(e, axis=-1, keepdims=True)
    if sink is not None:
        den = den + jnp.exp(sink - m)
    return e / jnp.where(den > 0.0, den, 1.0)


def alibi_slopes():
    return 2.0 ** (-8.0 * jnp.arange(1, N_ATT_HEADS + 1, dtype=jnp.float32) / N_ATT_HEADS)


def banded_gqa(q, k, v, slopes, window, sink=None):
    bsz, seq, hkv, grp, hd = q.shape
    nblk = seq // BLOCK_Q
    n_prev = -(-window // BLOCK_Q)
    span = (n_prev + 1) * BLOCK_Q
    pad = ((0, 0), (n_prev * BLOCK_Q, 0), (0, 0), (0, 0))
    kb = jnp.pad(k, pad).reshape(bsz, nblk + n_prev, BLOCK_Q, hkv, hd)
    vb = jnp.pad(v, pad).reshape(bsz, nblk + n_prev, BLOCK_Q, hkv, hd)
    k_band = jnp.concatenate([kb[:, j:j + nblk] for j in range(n_prev + 1)], axis=2)
    v_band = jnp.concatenate([vb[:, j:j + nblk] for j in range(n_prev + 1)], axis=2)
    qb = q.reshape(bsz, nblk, BLOCK_Q, hkv, grp, hd)
    s = jnp.einsum('bnqhgd,bnkhd->bnhgqk', qb, k_band).astype(jnp.float32) * (hd ** -0.5)
    q_pos = jnp.arange(nblk)[:, None] * BLOCK_Q + jnp.arange(BLOCK_Q)[None, :]
    k_pos = jnp.arange(nblk)[:, None] * BLOCK_Q - n_prev * BLOCK_Q + jnp.arange(span)[None, :]
    dist = q_pos[:, :, None] - k_pos[:, None, :]
    mask = (dist >= 0) & (dist < window) & (k_pos[:, None, :] >= 0)
    s = s - slopes[None, None, :, :, None, None] * dist[None, :, None, None].astype(jnp.float32)
    sink_b = None if sink is None else sink.astype(jnp.float32)[None, None, :, :, None, None]
    p = masked_softmax(s, mask[None, :, None, None], sink_b)
    o = jnp.einsum('bnhgqk,bnkhd->bnqhgd', p.astype(v.dtype), v_band)
    return o.reshape(bsz, seq, hkv, grp, hd)


def nsa_compress(k, pe, w1, w2):
    bsz, seq, hkv, hd = k.shape
    r = CMP_LEN // CMP_STRIDE
    n_str = seq // CMP_STRIDE
    n_cmp = n_str - r + 1
    ks = k.reshape(bsz, n_str, CMP_STRIDE, hkv, hd)
    win = jnp.concatenate([ks[:, j:j + n_cmp] for j in range(r)], axis=2)
    win = win + pe[None, None, :, None, :]
    flat = jnp.moveaxis(win, 3, 2).reshape(bsz, n_cmp, hkv, CMP_LEN * hd)
    return jax.nn.gelu(flat @ w1) @ w2


def nsa_attention(q, k_cmp, v_cmp, k_slc, v_slc, k_win, v_win, gates, slopes, pe_k, wk1, wk2, pe_v, wv1, wv2):
    bsz, seq, hkv, grp, hd = q.shape
    scale = hd ** -0.5
    t = jnp.arange(seq)
    kc = nsa_compress(k_cmp, pe_k, wk1, wk2)
    vc = nsa_compress(v_cmp, pe_v, wv1, wv2)
    n_cmp = kc.shape[1]
    c_start = jnp.arange(n_cmp) * CMP_STRIDE
    c_end = c_start + CMP_LEN - 1
    dist_c = t[:, None] - c_end[None, :]
    s_c = jnp.einsum('bthgd,bchd->bhgtc', q, kc).astype(jnp.float32) * scale
    s_c = s_c - slopes[None, :, :, None, None] * dist_c.astype(jnp.float32)
    p_c = masked_softmax(s_c, (dist_c >= 0)[None, None, None])
    o_cmp = jnp.einsum('bhgtc,bchd->bthgd', p_c.astype(vc.dtype), vc)
    n_sel = seq // SLC_BLOCK
    s_start = jnp.arange(n_sel) * SLC_BLOCK
    overlap = ((c_start[:, None] < s_start[None, :] + SLC_BLOCK) & (c_start[:, None] + CMP_LEN > s_start[None, :])).astype(jnp.float32)
    imp = jnp.einsum('bhgtc,cj->bhtj', p_c, overlap)
    t_blk = t // SLC_BLOCK
    jb = jnp.arange(n_sel)
    valid = jb[None, :] <= t_blk[:, None]
    forced = (jb[None, :] == 0) | (jb[None, :] == t_blk[:, None]) | (jb[None, :] == t_blk[:, None] - 1)
    rank = jnp.where(forced, jnp.inf, jnp.where(valid, imp, -jnp.inf))
    top_n = min(SLC_TOPN, n_sel)
    _, sel_idx = lax.top_k(rank, top_n)
    nq = seq // BLOCK_Q
    kb = k_slc.reshape(bsz, n_sel, SLC_BLOCK, hkv, hd).transpose(0, 3, 1, 2, 4)
    vb = v_slc.reshape(bsz, n_sel, SLC_BLOCK, hkv, hd).transpose(0, 3, 1, 2, 4)
    q_blocks = jnp.moveaxis(q.reshape(bsz, nq, BLOCK_Q, hkv, grp, hd), 1, 0)
    i_blocks = jnp.moveaxis(sel_idx.reshape(bsz, hkv, nq, BLOCK_Q, top_n), 2, 0)
    b_ix = jnp.arange(bsz)[:, None, None, None]
    h_ix = jnp.arange(hkv)[None, :, None, None]
    span = top_n * SLC_BLOCK

    def selected_block(args):
        qi, ii, t0 = args
        kg = kb[b_ix, h_ix, ii].reshape(bsz, hkv, BLOCK_Q, span, hd)
        vg = vb[b_ix, h_ix, ii].reshape(bsz, hkv, BLOCK_Q, span, hd)
        s = jnp.einsum('bqhgd,bhqmd->bhgqm', qi, kg).astype(jnp.float32) * scale
        k_pos = (ii[..., None] * SLC_BLOCK + jnp.arange(SLC_BLOCK)).reshape(bsz, hkv, BLOCK_Q, span)
        dist = (t0 + jnp.arange(BLOCK_Q))[None, None, :, None] - k_pos
        s = s - slopes[None, :, :, None, None] * dist[:, :, None].astype(jnp.float32)
        p = masked_softmax(s, (dist >= 0)[:, :, None])
        return jnp.einsum('bhgqm,bhqmd->bqhgd', p.astype(vg.dtype), vg)

    o_slc = lax.map(selected_block, (q_blocks, i_blocks, jnp.arange(nq) * BLOCK_Q))
    o_slc = jnp.moveaxis(o_slc, 0, 1).reshape(bsz, seq, hkv, grp, hd)
    o_win = banded_gqa(q, k_win, v_win, slopes, B_WINDOW)
    g = jax.nn.sigmoid(gates.astype(jnp.float32)).astype(q.dtype).reshape(bsz, seq, hkv, grp, 3)
    return g[..., 0:1] * o_cmp + g[..., 1:2] * o_slc + g[..., 2:3] * o_win


def hybrid_attention(h, w_in, sinks, pe_k, wk1, wk2, pe_v, wv1, wv2, w_o):
    bsz, seq, _ = h.shape
    proj = h @ w_in
    offs = np.cumsum(IN_SPLITS)[:-1].tolist()
    qa, ka, va, qb, kc, vc, ks, vs, kw, vw, gates = jnp.split(proj, offs, axis=-1)
    ga = A_HEADS // A_KV_HEADS
    gb = B_HEADS // B_KV_HEADS
    slopes = alibi_slopes()

    def kv_heads(z, n):
        return z.reshape(bsz, seq, n, HEAD_DIM)

    o_a = banded_gqa(qa.reshape(bsz, seq, A_KV_HEADS, ga, HEAD_DIM), kv_heads(ka, A_KV_HEADS), kv_heads(va, A_KV_HEADS),
                     slopes[:A_HEADS].reshape(A_KV_HEADS, ga), A_WINDOW, sinks.reshape(A_KV_HEADS, ga))
    o_b = nsa_attention(qb.reshape(bsz, seq, B_KV_HEADS, gb, HEAD_DIM),
                        kv_heads(kc, B_KV_HEADS), kv_heads(vc, B_KV_HEADS),
                        kv_heads(ks, B_KV_HEADS), kv_heads(vs, B_KV_HEADS),
                        kv_heads(kw, B_KV_HEADS), kv_heads(vw, B_KV_HEADS),
                        gates, slopes[A_HEADS:].reshape(B_KV_HEADS, gb), pe_k, wk1, wk2, pe_v, wv1, wv2)
    o = jnp.concatenate([o_a.reshape(bsz, seq, A_Q_W), o_b.reshape(bsz, seq, B_Q_W)], axis=-1)
    return o @ w_o


def chunked_gmlp(h, w_in, ln_g, ln_b, w_s, b_s, w_out):
    bsz, seq, _ = h.shape
    u, v = jnp.split(jax.nn.gelu(h @ w_in), 2, axis=-1)
    v = layer_norm(v, ln_g, ln_b)
    gd = GMLP_W // GMLP_GROUPS
    vc = v.reshape(bsz, seq // GMLP_CHUNK, GMLP_CHUNK, GMLP_GROUPS, gd)
    mixed = jnp.einsum('gts,bcsgd->bctgd', jnp.tril(w_s), vc) + b_s.T[None, None, :, :, None]
    return (u * mixed.reshape(bsz, seq, GMLP_W)) @ w_out


def swiglu(h, w_gate, w_up, w_down):
    return (jax.nn.silu(h @ w_gate) * (h @ w_up)) @ w_down


def moe_swiglu(h, w_router, w_gate, w_up, w_down):
    bsz, seq, dm = h.shape
    xf = h.reshape(-1, dm)
    n_tok = xf.shape[0]
    logits = (xf @ w_router).astype(jnp.float32)
    top_val, top_idx = lax.top_k(logits, TOP_K)
    gate = jax.nn.softmax(top_val, axis=-1)
    n_asg = n_tok * TOP_K
    flat_e = top_idx.reshape(-1)
    flat_tok = jnp.repeat(jnp.arange(n_tok, dtype=jnp.int32), TOP_K)
    flat_g = gate.reshape(-1)
    order = jnp.argsort(flat_e)
    e_sorted = flat_e[order]
    tok_sorted = flat_tok[order]
    g_sorted = flat_g[order]
    counts = jnp.bincount(flat_e, length=N_EXPERTS)
    starts = jnp.cumsum(counts) - counts
    padded = (counts + MOE_BLOCK - 1) // MOE_BLOCK * MOE_BLOCK
    pad_ends = jnp.cumsum(padded)
    pad_starts = pad_ends - padded
    dest = pad_starts[e_sorted] + (jnp.arange(n_asg) - starts[e_sorted])
    n_blocks = -(-n_asg // MOE_BLOCK) + N_EXPERTS
    n_rows = n_blocks * MOE_BLOCK
    row_tok = jnp.full((n_rows,), n_tok, dtype=jnp.int32).at[dest].set(tok_sorted)
    x_pad = jnp.concatenate([xf, jnp.zeros((1, dm), xf.dtype)], axis=0)
    xin = x_pad[row_tok].reshape(n_blocks, MOE_BLOCK, dm)
    blk_e = jnp.minimum(jnp.searchsorted(pad_ends, jnp.arange(n_blocks) * MOE_BLOCK, side='right'), N_EXPERTS - 1)

    def expert_block(args):
        xb, e = args
        return (jax.nn.silu(xb @ w_gate[e]) * (xb @ w_up[e])) @ w_down[e]

    yb = lax.map(expert_block, (xin, blk_e)).reshape(n_rows, dm)
    contrib = yb[dest] * g_sorted[:, None].astype(yb.dtype)
    y = jnp.zeros((n_tok, dm), yb.dtype).at[tok_sorted].add(contrib)
    return y.reshape(bsz, seq, dm)


def setup_inputs(seed: int = 0) -> dict:
    key = jax.random.key(seed)
    ks = jax.random.split(key, 26)
    f32 = jnp.float32

    def nrm(k, shape, scale):
        return jax.random.normal(k, shape, f32) * scale

    dm = D_MODEL
    cmp_in = CMP_LEN * HEAD_DIM
    return {
        'x': nrm(ks[0], (BATCH, SEQ, dm), 1.0),
        'att_w_in': nrm(ks[1], (N_EVEN, dm, IN_PROJ_W), dm ** -0.5),
        'att_sinks': nrm(ks[2], (N_EVEN, A_HEADS), 0.5),
        'cmp_pe_k': nrm(ks[3], (N_EVEN, CMP_LEN, HEAD_DIM), 0.1),
        'cmp_wk1': nrm(ks[4], (N_EVEN, cmp_in, CMP_HIDDEN), cmp_in ** -0.5),
        'cmp_wk2': nrm(ks[5], (N_EVEN, CMP_HIDDEN, HEAD_DIM), CMP_HIDDEN ** -0.5),
        'cmp_pe_v': nrm(ks[6], (N_EVEN, CMP_LEN, HEAD_DIM), 0.1),
        'cmp_wv1': nrm(ks[7], (N_EVEN, cmp_in, CMP_HIDDEN), cmp_in ** -0.5),
        'cmp_wv2': nrm(ks[8], (N_EVEN, CMP_HIDDEN, HEAD_DIM), CMP_HIDDEN ** -0.5),
        'att_w_o': nrm(ks[9], (N_EVEN, ATT_W, dm), DN_BETA * ATT_W ** -0.5),
        'ffn_w_gate': nrm(ks[10], (N_EVEN, dm, D_FF), dm ** -0.5),
        'ffn_w_up': nrm(ks[11], (N_EVEN, dm, D_FF), dm ** -0.5),
        'ffn_w_down': nrm(ks[12], (N_EVEN, D_FF, dm), DN_BETA * D_FF ** -0.5),
        'gmlp_w_in': nrm(ks[13], (N_ODD, dm, 2 * GMLP_W), dm ** -0.5),
        'gmlp_ln_g': 1.0 + nrm(ks[14], (N_ODD, GMLP_W), 0.02),
        'gmlp_ln_b': nrm(ks[15], (N_ODD, GMLP_W), 0.02),
        'gmlp_w_s': nrm(ks[16], (N_ODD, GMLP_GROUPS, GMLP_CHUNK, GMLP_CHUNK), GMLP_CHUNK ** -0.5),
        'gmlp_b_s': 1.0 + nrm(ks[17], (N_ODD, GMLP_GROUPS, GMLP_CHUNK), 0.1),
        'gmlp_w_out': nrm(ks[18], (N_ODD, GMLP_W, dm), DN_BETA * GMLP_W ** -0.5),
        'moe_w_router': nrm(ks[19], (N_ODD, dm, N_EXPERTS), dm ** -0.5),
        'moe_w_gate': nrm(ks[20], (N_ODD, N_EXPERTS, dm, D_FF_EXPERT), dm ** -0.5),
        'moe_w_up': nrm(ks[21], (N_ODD, N_EXPERTS, dm, D_FF_EXPERT), dm ** -0.5),
        'moe_w_down': nrm(ks[22], (N_ODD, N_EXPERTS, D_FF_EXPERT, dm), DN_BETA * D_FF_EXPERT ** -0.5),
        'ln_g': 1.0 + nrm(ks[23], (DEPTH, 2, dm), 0.02),
        'ln_b': nrm(ks[24], (DEPTH, 2, dm), 0.02),
    }


def reference(x, att_w_in, att_sinks, cmp_pe_k, cmp_wk1, cmp_wk2, cmp_pe_v, cmp_wv1, cmp_wv2, att_w_o,
              ffn_w_gate, ffn_w_up, ffn_w_down, gmlp_w_in, gmlp_ln_g, gmlp_ln_b, gmlp_w_s, gmlp_b_s, gmlp_w_out,
              moe_w_router, moe_w_gate, moe_w_up, moe_w_down, ln_g, ln_b):
    for i in range(DEPTH):
        j = i // 2
        if i % 2 == 0:
            mix = hybrid_attention(x, att_w_in[j], att_sinks[j], cmp_pe_k[j], cmp_wk1[j], cmp_wk2[j],
                                   cmp_pe_v[j], cmp_wv1[j], cmp_wv2[j], att_w_o[j])
            x = layer_norm(DN_ALPHA * x + mix, ln_g[i, 0], ln_b[i, 0])
            ff = swiglu(x, ffn_w_gate[j], ffn_w_up[j], ffn_w_down[j])
        else:
            mix = chunked_gmlp(x, gmlp_w_in[j], gmlp_ln_g[j], gmlp_ln_b[j], gmlp_w_s[j], gmlp_b_s[j], gmlp_w_out[j])
            x = layer_norm(DN_ALPHA * x + mix, ln_g[i, 0], ln_b[i, 0])
            ff = moe_swiglu(x, moe_w_router[j], moe_w_gate[j], moe_w_up[j], moe_w_down[j])
        x = layer_norm(DN_ALPHA * x + ff, ln_g[i, 1], ln_b[i, 1])
    return x
```

```cpp
#include <hip/hip_runtime.h>
#include <cstdio>
#include <cstdint>

#ifndef MK_ONE_LAUNCH
#define MK_ONE_LAUNCH 1
#endif

#define LAS __attribute__((address_space(3)))
#define GAS __attribute__((address_space(1)))
typedef unsigned short bf16;
typedef short bf16x8 __attribute__((ext_vector_type(8)));
typedef float f32x4 __attribute__((ext_vector_type(4)));
typedef float f32x2 __attribute__((ext_vector_type(2)));
typedef unsigned u32x4 __attribute__((ext_vector_type(4)));
typedef unsigned u32x2 __attribute__((ext_vector_type(2)));
typedef GAS unsigned gu32;

constexpr int NB = 16, SEQ = 2048, D = 1024, M = NB * SEQ;
constexpr int PW = 2048;
constexpr int INW = 2072;
constexpr int DFF = 2816, DFE = 3584, NEXP = 8, CAP = 32768;
constexpr int NCMP = 127;
constexpr float ALPHA = 1.4142135623730951f;
constexpr float LN_EPS = 1e-5f;
constexpr int NWAVES = 8, NTHREADS = 512;

constexpr size_t MiB = 1u << 20;
constexpr size_t WS_CTL = 0, CTL_ZERO_BYTES = 1 * MiB;
constexpr size_t WS_SMALL = 1 * MiB;
constexpr size_t WS_ROWTOK = 2 * MiB, WS_ROWDST = 3 * MiB, WS_ROWGATE = 4 * MiB;
constexpr size_t WS_WIN = 5 * MiB;
constexpr size_t WS_WC1 = 9 * MiB;
constexpr size_t WS_WO = 11 * MiB;
constexpr size_t WS_FGU = 13 * MiB;
constexpr size_t WS_FDN = 24 * MiB;
constexpr size_t WS_GIN = 30 * MiB;
constexpr size_t WS_GOUT = 34 * MiB;
constexpr size_t WS_MGU = 36 * MiB;
constexpr size_t WS_MDN = 148 * MiB;
constexpr size_t WS_XB = 204 * MiB;
constexpr size_t WS_BIG = 268 * MiB;
constexpr size_t WS_P = WS_BIG;
constexpr size_t WS_O = WS_BIG + 128 * MiB;
constexpr size_t WS_H = WS_BIG;
constexpr size_t WS_U = WS_BIG, WS_V = WS_BIG + 64 * MiB, WS_Z = WS_BIG + 128 * MiB;
constexpr size_t WS_HM = WS_BIG;
constexpr size_t WS_Y2 = WS_BIG + 112 * MiB;
constexpr size_t WS_GATES = 460 * MiB;
constexpr size_t WS_KC = 463 * MiB;
constexpr size_t WS_H1 = 480 * MiB;
constexpr size_t WS_KCC = 484 * MiB;
constexpr size_t WS_END = 508 * MiB;
static_assert(WS_Y2 + 128 * MiB <= WS_END && WS_H + (size_t)M * DFF * 2 <= WS_GATES && WS_KC + 17 * MiB <= WS_H1, "ws map");
constexpr int CW_BAR = 4096;
constexpr int CW_CNT = 16384;

constexpr int RING_BYTES = 131072;
constexpr int LDSCTL_OFF = RING_BYTES;
constexpr int LDS_STATS_OFF = RING_BYTES + 1024;
constexpr int LDS_MOE_OFF = RING_BYTES + 4096;
constexpr int LDS_BYTES = 147456;

#define LDS_WAIT() asm volatile("s_waitcnt lgkmcnt(0)" ::: "memory")
#define VM_WAIT() asm volatile("s_waitcnt vmcnt(0)" ::: "memory")
__device__ __forceinline__ unsigned f2bf(float f) { unsigned u = __builtin_bit_cast(unsigned, f); return (u + 0x7fffu + ((u >> 16) & 1u)) >> 16; }
__device__ __forceinline__ unsigned pk2(float lo, float hi) { return f2bf(lo) | (f2bf(hi) << 16); }
__device__ __forceinline__ float bflo(unsigned u) { return __builtin_bit_cast(float, u << 16); }
__device__ __forceinline__ float bfhi(unsigned u) { return __builtin_bit_cast(float, u & 0xffff0000u); }
__device__ __forceinline__ float bf2f(bf16 b) { return __builtin_bit_cast(float, (unsigned)b << 16); }
__device__ __forceinline__ float wave_sum(float v) {
#pragma unroll
    for (int o = 1; o < 64; o <<= 1) v += __shfl_xor(v, o);
    return v;
}
__device__ __forceinline__ float wave_max(float v) {
#pragma unroll
    for (int o = 1; o < 64; o <<= 1) v = fmaxf(v, __shfl_xor(v, o));
    return v;
}
__device__ __forceinline__ float gelu_tanh(float x) {
    const float u = 0.7978845608028654f * (x + 0.044715f * x * x * x);
    return x / (1.0f + __expf(-2.0f * u));
}
__device__ __forceinline__ float silu(float x) { return x / (1.0f + __expf(-x)); }
__device__ __forceinline__ float sigmoidf(float x) { return 1.0f / (1.0f + __expf(-x)); }

namespace pg8 {
constexpr int BM = 256, BK = 64, HALF = 128, HTB = HALF * BK * 2, STAGE_BYTES = 8 * HTB, NXCD = 8, WGM = 8;
__host__ __device__ __forceinline__ int lds_byte(int r, int c) { const int st = (r >> 4) * 2 + (c >> 5), rr = r & 15, cc = c & 31, ob = rr * 64 + cc * 2; return st * 1024 + (ob ^ (((ob >> 9) & 1) << 5)); }
__host__ __device__ __forceinline__ void stage_rc(int b, int& R, int& C) { const int st = b / 1024, sb = b % 1024, swz = sb ^ (((sb >> 9) & 1) << 5); R = (st >> 1) * 16 + swz / 64; C = (st & 1) * 32 + (swz % 64) / 2; }
__host__ __device__ __forceinline__ int perm32(int rho) { const int n = rho >> 4, i = rho & 15; return 8 * (i >> 2) + 4 * n + (i & 3); }

struct Unit { int pm, pn, e, te, ne; };
struct Gemm { const char* A; const char* Bt; int K; size_t eStrideB; };

struct ADense { unsigned pitchB; __device__ __forceinline__ unsigned operator()(const Unit& u, int R) const { return (unsigned)(u.pm * 256 + R) * pitchB; } };
struct AGather { const int* rowtok; unsigned pitchB;
    __device__ __forceinline__ unsigned operator()(const Unit& u, int R) const { const int ri = u.te * 256 + R; const int tok = ri < u.ne ? rowtok[u.e * CAP + ri] : 0; return (unsigned)tok * pitchB; } };

__device__ __forceinline__ bool static_unit(int i, int G, int c, int nM, int nN, int& pm, int& pn) {
    const int nwg = nM * nN; const long L = (long)i * G + c; if (L >= nwg) return false;
    int wgid = (int)L; { const int q = nwg / NXCD, r = nwg % NXCD, xcd = wgid % NXCD, off = wgid / NXCD; wgid = (xcd < r ? xcd * (q + 1) : r * (q + 1) + (xcd - r) * q) + off; }
    const int nig = WGM * nN, gid = wgid / nig, fm = gid * WGM, gsz = (nM - fm) < WGM ? (nM - fm) : WGM;
    pm = fm + ((wgid % nig) % gsz); pn = (wgid % nig) / gsz; return true;
}
struct StaticOrder { int nM, nN, G, c;
    __device__ __forceinline__ bool next(int i, Unit& u) const { u.e = 0; u.te = 0; u.ne = 0; return static_unit(i, G, c, nM, nN, u.pm, u.pn); } };
struct CmpOrder { int c;
    __device__ __forceinline__ bool next(int i, Unit& u) const { if (i > 0 || c >= 32) return false; u.pm = c; u.pn = 0; u.e = c >> 4; u.te = 0; u.ne = 0; return true; } };
struct MoeOrder { int nM, nN, G, c, tile0; const LAS int* tab;
    __device__ __forceinline__ bool next(int i, Unit& u) const {
        int pm, pn; if (!static_unit(i, G, c, nM, nN, pm, pn)) return false;
        const int ct = tile0 + pm; int e = 0;
#pragma unroll
        for (int k = 1; k < 8; ++k) e += (ct >= tab[8 + k]) ? 1 : 0;
        e = __builtin_amdgcn_readfirstlane(e);
        u.pm = pm; u.pn = pn; u.e = e; u.te = __builtin_amdgcn_readfirstlane(ct - tab[8 + e]); u.ne = __builtin_amdgcn_readfirstlane(tab[e]); return true; } };

__device__ __forceinline__ u32x4 pack8(const f32x4& a, const f32x4& b) { u32x4 w; w.x = pk2(a[0], a[1]); w.y = pk2(a[2], a[3]); w.z = pk2(b[0], b[1]); w.w = pk2(b[2], b[3]); return w; }

struct EpiRes {
    static constexpr bool PERM = false;
    const float* res; float* out; float alpha;
    __device__ __forceinline__ void operator()(const f32x4 (&acc)[2][2][4][2], const Unit& u, int wr, int wc, int fr, int fq) const {
        const int row0 = u.pm * BM + wr * 64 + fr, col0 = u.pn * BM + wc * 32 + 4 * fq;
#pragma unroll
        for (int ai = 0; ai < 2; ++ai)
#pragma unroll
            for (int m = 0; m < 4; ++m) { const size_t off = (size_t)(row0 + ai * HALF + m * 16) * D + col0;
#pragma unroll
                for (int bj = 0; bj < 2; ++bj)
#pragma unroll
                    for (int n = 0; n < 2; ++n) { const size_t o = off + bj * HALF + n * 16; const f32x4 r = *(const f32x4*)(res + o); *(f32x4*)(out + o) = acc[ai][bj][m][n] + alpha * r; } }
    }
};
template <int MODE> struct EpiBf {
    static constexpr bool PERM = true;
    bf16* O; bf16* O2; int ldc; const float* bias; const int* rowdst; const float* rowgate;
    __device__ __forceinline__ void operator()(const f32x4 (&acc)[2][2][4][2], const Unit& u, int wr, int wc, int fr, int fq) const {
        const int lr0 = wr * 64 + fr, ct = wc * 32 + 8 * fq;
#pragma unroll
        for (int ai = 0; ai < 2; ++ai)
#pragma unroll
            for (int m = 0; m < 4; ++m) {
                const int lr = lr0 + ai * HALF + m * 16; const int row = u.pm * BM + lr;
                if (MODE == 0) {
#pragma unroll
                    for (int bj = 0; bj < 2; ++bj) { const u32x4 w = pack8(acc[ai][bj][m][0], acc[ai][bj][m][1]);
                        *(u32x4*)(O + (size_t)row * PW + u.pn * BM + bj * HALF + ct) = w;
                        if (u.pn == 5) { const int b = row >> 11, t = row & 2047, hh = wc >> 1, d = (wc & 1) * 32 + 8 * fq;
                            *(u32x4*)(O2 + ((size_t)((bj * 32 + b * 2 + hh) * 2048 + t)) * 64 + d) = w; } }
                } else if (MODE == 1) {
#pragma unroll
                    for (int bj = 0; bj < 2; ++bj) { const int col = bj * HALF + ct; const float* bp = bias + u.e * 256 + col;
                        const f32x4 b0 = *(const f32x4*)bp, b1 = *(const f32x4*)(bp + 4); f32x4 v0 = acc[ai][bj][m][0] + b0, v1 = acc[ai][bj][m][1] + b1;
#pragma unroll
                        for (int j = 0; j < 4; ++j) { v0[j] = gelu_tanh(v0[j]); v1[j] = gelu_tanh(v1[j]); }
                        *(u32x4*)(O + (size_t)row * 256 + col) = pack8(v0, v1); }
                } else if (MODE == 2) {
                    bf16* dst = (u.pn < 4) ? O : O2;
#pragma unroll
                    for (int bj = 0; bj < 2; ++bj) { f32x4 v0 = acc[ai][bj][m][0], v1 = acc[ai][bj][m][1];
#pragma unroll
                        for (int j = 0; j < 4; ++j) { v0[j] = gelu_tanh(v0[j]); v1[j] = gelu_tanh(v1[j]); }
                        *(u32x4*)(dst + (size_t)row * D + (u.pn & 3) * BM + bj * HALF + ct) = pack8(v0, v1); }
                } else if (MODE == 3) {
                    f32x4 v0, v1;
#pragma unroll
                    for (int j = 0; j < 4; ++j) { v0[j] = silu(acc[ai][0][m][0][j]) * acc[ai][1][m][0][j]; v1[j] = silu(acc[ai][0][m][1][j]) * acc[ai][1][m][1][j]; }
                    *(u32x4*)(O + (size_t)row * ldc + u.pn * HALF + ct) = pack8(v0, v1);
                } else {
                    const int gi = u.te * 256 + lr;
                    if (gi < u.ne) { const int dst = rowdst[u.e * CAP + gi]; const float gt = rowgate[u.e * CAP + gi];
#pragma unroll
                        for (int bj = 0; bj < 2; ++bj) { const f32x4 v0 = acc[ai][bj][m][0] * gt, v1 = acc[ai][bj][m][1] * gt;
                            *(u32x4*)(O + (size_t)dst * D + u.pn * BM + bj * HALF + ct) = pack8(v0, v1); } }
                }
            }
    }
};

template <class Epi, class Sched, class AL>
__device__ __forceinline__ void gemm_phase(LAS unsigned char* lds, const Gemm g, const Sched& S, const Epi& E, const AL& al) {
    const int tid = threadIdx.x, wid = __builtin_amdgcn_readfirstlane(tid >> 6), lane = tid & 63, wr = wid >> 2, wc = wid & 3, fr = lane & 15, fq = lane >> 4;
    const int K = g.K, nt = K / BK;
    int Rs[2]; unsigned Cb[2], voffB[2];
#pragma unroll
    for (int i = 0; i < 2; ++i) { int R, C; stage_rc(tid * 16 + i * 8192, R, C); const int Rb = Epi::PERM ? ((R & ~31) + perm32(R & 31)) : R;
        Rs[i] = R; Cb[i] = (unsigned)C * 2u; voffB[i] = (unsigned)(Rb * K + C) * 2u; }
    const size_t kstep = (size_t)(BK * 2);
    const size_t hstepB = (size_t)HALF * K * 2;
    const size_t tstepB = 2 * hstepB;
    const unsigned ldsw = (unsigned)wid * 1024u;
    const int aoff = lds_byte(wr * 64 + fr, fq * 8), boff = lds_byte(wc * 32 + fr, fq * 8);
#define PG8_SA(b, h) (((b) * 2 + (h)) * HTB)
#define PG8_SB(b, h) ((4 + (b) * 2 + (h)) * HTB)
#define PG8_STAGE(bufoff, gbase, voff) do { _Pragma("unroll") for (int _i = 0; _i < 2; ++_i) \
        __builtin_amdgcn_global_load_lds((const unsigned*)((const char*)(gbase) + (voff)[_i]), (LAS unsigned*)(lds + (bufoff) + ldsw + _i * 8192), 16, 0, 0); } while (0)
#define PG8_LDA(dst, b, h) do { _Pragma("unroll") for (int m = 0; m < 4; ++m) _Pragma("unroll") for (int k = 0; k < 2; ++k) dst[m][k] = *(const LAS bf16x8*)(lds + PG8_SA(b, h) + aoff + m * 2048 + k * 1024); } while (0)
#define PG8_LDB(dst, b, h) do { _Pragma("unroll") for (int n = 0; n < 2; ++n) _Pragma("unroll") for (int k = 0; k < 2; ++k) dst[n][k] = *(const LAS bf16x8*)(lds + PG8_SB(b, h) + boff + n * 2048 + k * 1024); } while (0)
#define PG8_MMA(ai, bj, At, Bt) do { __builtin_amdgcn_s_setprio(1); _Pragma("unroll") for (int m = 0; m < 4; ++m) _Pragma("unroll") for (int n = 0; n < 2; ++n) _Pragma("unroll") for (int k = 0; k < 2; ++k) \
        acc[ai][bj][m][n] = __builtin_amdgcn_mfma_f32_16x16x32_bf16(Bt[n][k], At[m][k], acc[ai][bj][m][n], 0, 0, 0); __builtin_amdgcn_s_setprio(0); } while (0)
#define PG8_WAIT_V(n) asm volatile("s_waitcnt vmcnt(" #n ")" ::: "memory")
#define PG8_WAIT_L(n) asm volatile("s_waitcnt lgkmcnt(" #n ")" ::: "memory")
#define PG8_BAR __builtin_amdgcn_s_barrier()
#define PG8_SCHED __builtin_amdgcn_sched_barrier(0)
#define PG8_VOFF(dst, u) do { _Pragma("unroll") for (int _h = 0; _h < 2; ++_h) _Pragma("unroll") for (int _i = 0; _i < 2; ++_i) dst[_h][_i] = al(u, _h * HALF + Rs[_i]) + Cb[_i]; } while (0)
    Unit cur, nxt; int ui = 0;
    if (!S.next(0, cur)) return;
    f32x4 acc[2][2][4][2];
#pragma unroll
    for (int a = 0; a < 2; ++a)
#pragma unroll
        for (int b = 0; b < 2; ++b)
#pragma unroll
            for (int m = 0; m < 4; ++m)
#pragma unroll
                for (int n = 0; n < 2; ++n) acc[a][b][m][n] = (f32x4){0.f, 0.f, 0.f, 0.f};
    bf16x8 At[4][2], B0[2][2], B1[2][2];
    unsigned vC[2][2], vP[2][2], vN[2][2];
    PG8_VOFF(vC, cur);
#pragma unroll
    for (int h = 0; h < 2; ++h)
#pragma unroll
        for (int i = 0; i < 2; ++i) vP[h][i] = vC[h][i];
    const char* const A0 = g.A;
    const char* cB = g.Bt + (size_t)cur.e * g.eStrideB + (size_t)cur.pn * tstepB;
    PG8_STAGE(PG8_SB(0, 0), cB, voffB); PG8_STAGE(PG8_SB(0, 1), cB + hstepB, voffB); PG8_STAGE(PG8_SA(0, 0), A0, vC[0]); PG8_STAGE(PG8_SA(0, 1), A0, vC[1]);
    if (wr == 1) PG8_BAR;
    PG8_WAIT_V(2); PG8_BAR;
    PG8_STAGE(PG8_SB(1, 0), cB + kstep, voffB); PG8_STAGE(PG8_SA(1, 0), A0 + kstep, vC[0]); PG8_STAGE(PG8_SB(1, 1), cB + hstepB + kstep, voffB);
    PG8_WAIT_V(6); PG8_BAR;
    for (;;) {
        const bool has_next = S.next(ui + 1, nxt);
        const char* nB = cB;
        if (has_next) { PG8_VOFF(vN, nxt); nB = g.Bt + (size_t)nxt.e * g.eStrideB + (size_t)nxt.pn * tstepB; }
        else {
#pragma unroll
            for (int h = 0; h < 2; ++h)
#pragma unroll
                for (int i = 0; i < 2; ++i) vN[h][i] = vC[h][i]; }
        for (int t = 0; t < nt; t += 2) {
            const bool last = (t == nt - 2);
            if (last) {
#pragma unroll
                for (int h = 0; h < 2; ++h)
#pragma unroll
                    for (int i = 0; i < 2; ++i) vP[h][i] = vN[h][i]; }
            const char* a1 = A0 + (size_t)(t + 1) * kstep;
            const char* a2 = last ? A0 : A0 + (size_t)(t + 2) * kstep; const char* b2 = last ? nB : cB + (size_t)(t + 2) * kstep;
            const char* a3 = a2 + kstep; const char* b3 = b2 + kstep;
            PG8_LDB(B0, 0, 0); PG8_LDB(B1, 0, 1); PG8_SCHED; PG8_LDA(At, 0, 0); PG8_STAGE(PG8_SA(1, 1), a1, vC[1]);
            PG8_WAIT_V(8); PG8_WAIT_L(0); PG8_BAR; PG8_MMA(0, 0, At, B0); PG8_MMA(0, 1, At, B1); PG8_BAR; PG8_SCHED;
            PG8_LDA(At, 0, 1); PG8_STAGE(PG8_SB(0, 0), b2, voffB); PG8_STAGE(PG8_SB(0, 1), b2 + hstepB, voffB); PG8_STAGE(PG8_SA(0, 0), a2, vP[0]);
            PG8_WAIT_V(8); PG8_WAIT_L(0); PG8_BAR; PG8_MMA(1, 0, At, B0); PG8_MMA(1, 1, At, B1); PG8_BAR; PG8_SCHED;
            PG8_LDB(B0, 1, 0); PG8_LDB(B1, 1, 1); PG8_SCHED; PG8_LDA(At, 1, 0); PG8_STAGE(PG8_SA(0, 1), a2, vP[1]);
            PG8_WAIT_V(8); PG8_WAIT_L(0); PG8_BAR; PG8_MMA(0, 0, At, B0); PG8_MMA(0, 1, At, B1); PG8_BAR; PG8_SCHED;
            PG8_LDA(At, 1, 1); PG8_STAGE(PG8_SB(1, 0), b3, voffB); PG8_STAGE(PG8_SB(1, 1), b3 + hstepB, voffB); PG8_STAGE(PG8_SA(1, 0), a3, vP[0]);
            PG8_WAIT_V(8); PG8_WAIT_L(0); PG8_BAR; PG8_MMA(1, 0, At, B0); PG8_MMA(1, 1, At, B1); PG8_BAR; PG8_SCHED;
        }
        if (wr == 0) PG8_BAR;
        E(acc, cur, wr, wc, fr, fq);
        if (!has_next) break;
#pragma unroll
        for (int a = 0; a < 2; ++a)
#pragma unroll
            for (int b = 0; b < 2; ++b)
#pragma unroll
                for (int m = 0; m < 4; ++m)
#pragma unroll
                    for (int n = 0; n < 2; ++n) acc[a][b][m][n] = (f32x4){0.f, 0.f, 0.f, 0.f};
        cur = nxt; cB = nB; ++ui;
#pragma unroll
        for (int h = 0; h < 2; ++h)
#pragma unroll
            for (int i = 0; i < 2; ++i) vC[h][i] = vP[h][i];
        if (wr == 1) PG8_BAR;
    }
    PG8_WAIT_V(0);
    PG8_BAR;
#undef PG8_SA
#undef PG8_SB
#undef PG8_STAGE
#undef PG8_LDA
#undef PG8_LDB
#undef PG8_MMA
#undef PG8_WAIT_V
#undef PG8_WAIT_L
#undef PG8_BAR
#undef PG8_SCHED
#undef PG8_VOFF
}
}

#define XB_TMO      128
#define XB_XCNT(j)  (256  + 64 * (j))
#define XB_XSUB(j)  (1280 + 64 * (j))
#define XB_XGEN(j)  (2304 + 64 * (j))
#define XB_TOP      3328
#define XB_TOPGEN   3392
#define XCD_BAR_WORDS 3456
#define XB_SPIN_CAP (1u << 18)
__device__ __forceinline__ unsigned xb_ld(unsigned* p)              { return __hip_atomic_load(p, __ATOMIC_RELAXED, __HIP_MEMORY_SCOPE_AGENT); }
__device__ __forceinline__ unsigned xb_add(unsigned* p, unsigned v) { return __hip_atomic_fetch_add(p, v, __ATOMIC_RELAXED, __HIP_MEMORY_SCOPE_AGENT); }
__device__ __forceinline__ unsigned xb_xcc_id() { return (unsigned)__builtin_amdgcn_s_getreg((3 << 11) | 20) & 0xFu; }
#define XB_SPIN(cond, bar) do { unsigned _sp = 0; while (cond) { __builtin_amdgcn_s_sleep(1); \
    if ((++_sp & 255u) == 0u) { if (xb_ld(&(bar)[XB_TMO])) break; if (_sp > XB_SPIN_CAP) { atomicAdd(&(bar)[XB_TMO], 1u); break; } } } } while (0)
struct XcdBarrier { unsigned* bar; unsigned x; volatile LAS unsigned* st; };
__device__ __forceinline__ XcdBarrier xcd_barrier_post(unsigned* bar, volatile LAS unsigned* st) {
    XcdBarrier b; b.bar = bar; b.x = xb_xcc_id(); b.st = st;
    if (threadIdx.x == 0) (void)xb_add(&bar[XB_XCNT(b.x)], 1u);
    return b;
}
__device__ __forceinline__ void xcd_barrier_complete(unsigned* bar, unsigned x, unsigned& nloc, unsigned& nx) {
    const unsigned G = gridDim.x * gridDim.y * gridDim.z;
    unsigned sum, cnt, mine, sp = 0u;
    for (;;) {
        sum = 0u; cnt = 0u; mine = 0u;
#pragma unroll
        for (unsigned j = 0; j < 16; ++j) { const unsigned c = xb_ld(&bar[XB_XCNT(j)]); sum += c; cnt += (c > 0u) ? 1u : 0u; mine = (j == x) ? c : mine; }
        if (sum == G) break;
        __builtin_amdgcn_s_sleep(1);
        if ((++sp & 255u) == 0u) { if (xb_ld(&bar[XB_TMO])) break; if (sp > XB_SPIN_CAP) { atomicAdd(&bar[XB_TMO], 1u); break; } }
    }
    nloc = mine > 0u ? mine : 1u; nx = cnt > 0u ? cnt : 1u;
}
__device__ __forceinline__ void xcd_barrier(const XcdBarrier& b) {
    asm volatile("s_waitcnt vmcnt(0)" ::: "memory");
    __syncthreads();
    if (threadIdx.x == 0) {
        unsigned* bar = b.bar;
        __builtin_amdgcn_s_waitcnt(0);
        unsigned nloc = b.st[0], nx = b.st[1];
        if (nloc == 0u) { xcd_barrier_complete(bar, b.x, nloc, nx); b.st[0] = nloc; b.st[1] = nx; }
        const unsigned old = xb_add(&bar[XB_XSUB(b.x)], 1u);
        const unsigned gen = old / nloc;
        if (old + 1u == (gen + 1u) * nloc) {
            __builtin_amdgcn_fence(__ATOMIC_RELEASE, "agent");
            asm volatile("s_waitcnt vmcnt(0)" ::: "memory");
            const unsigned og = xb_add(&bar[XB_TOP], 1u);
            const unsigned tg = og / nx;
            if (og + 1u == (tg + 1u) * nx) xb_add(&bar[XB_TOPGEN], 1u);
            else XB_SPIN(xb_ld(&bar[XB_TOPGEN]) == tg, bar);
            __builtin_amdgcn_fence(__ATOMIC_ACQUIRE, "agent");
            xb_add(&bar[XB_XGEN(b.x)], 1u);
            asm volatile("s_waitcnt vmcnt(0)" ::: "memory");
        } else {
            XB_SPIN(xb_ld(&bar[XB_XGEN(b.x)]) == gen, bar);
            __builtin_amdgcn_fence(__ATOMIC_ACQUIRE, "agent");
            asm volatile("s_waitcnt vmcnt(0)" ::: "memory");
        }
    }
    __syncthreads();
}

struct Args {
    const float* in[25]; float* out; unsigned char* ws; int ph_lo, ph_hi;
};
struct Frame {
    LAS unsigned char* lds; gu32* ctl; unsigned char* ws;
    int tid, lane, wave, vcu, G;
};
enum { I_X = 0, I_WIN, I_SINK, I_PEK, I_WK1, I_WK2, I_PEV, I_WV1, I_WV2, I_WO, I_FG, I_FU, I_FD, I_GIN, I_GLNG, I_GLNB, I_GWS, I_GBS, I_GOUT, I_RT, I_MG, I_MU, I_MD, I_LNG, I_LNB };

__device__ __forceinline__ void tr_item(const float* W, int pitch, int k0, int n0, bf16* dst, int ldk, LAS float* scr, int lane) {
#pragma unroll 8
    for (int i = 0; i < 32; ++i) { const int kk = 2 * i + (lane >> 5); scr[kk * 33 + (lane & 31)] = W[(size_t)(k0 + kk) * pitch + n0 + (lane & 31)]; }
    LDS_WAIT(); asm volatile("" ::: "memory");
    const int c = lane & 7;
#pragma unroll
    for (int j = 0; j < 4; ++j) { const int n = (lane >> 3) + 8 * j; const LAS float* s = scr + (8 * c) * 33 + n;
        u32x4 o; o.x = pk2(s[0 * 33], s[1 * 33]); o.y = pk2(s[2 * 33], s[3 * 33]); o.z = pk2(s[4 * 33], s[5 * 33]); o.w = pk2(s[6 * 33], s[7 * 33]);
        *(u32x4*)(dst + (size_t)n * ldk + 8 * c) = o; }
    LDS_WAIT(); asm volatile("" ::: "memory");
}
__device__ __forceinline__ void tr_matrix_item(const float* W, int pitch, int K, int N, bf16* WT, int inter_up  , LAS float* scr, int item, int lane) {
    const int nblk = N / 32, kb = item / nblk, nb = item % nblk, k0 = 64 * kb, n0 = 32 * nb;
    const int drow = inter_up < 0 ? n0 : ((n0 >> 7) * 256 + (n0 & 127) + inter_up * 128);
    tr_item(W, pitch, k0, n0, WT + (size_t)drow * K + k0, K, scr, lane);
}

__device__ __forceinline__ void p0_prologue(Frame& F, const Args& a) {
    LAS float* scr = (LAS float*)(F.lds + F.wave * 16384);
    const int gw = F.vcu * NWAVES + F.wave, NGW = F.G * NWAVES;
    unsigned char* ws = F.ws;
    constexpr int IT_WIN = (D / 64) * (2048 / 32), IT_C1 = (2048 / 64) * (256 / 32), IT_SQ = (D / 64) * (D / 32), IT_FG = (D / 64) * (DFF / 32), IT_FD = (DFF / 64) * (D / 32),
                  IT_GIN = (D / 64) * (2048 / 32), IT_MG = (D / 64) * (DFE / 32), IT_MD = (DFE / 64) * (D / 32);
    constexpr int NITEMS = IT_WIN + 2 * IT_C1 + IT_SQ + 2 * IT_FG + IT_FD + IT_GIN + IT_SQ + NEXP * (2 * IT_MG + IT_MD);
    for (int it = gw; it < NITEMS; it += NGW) {
        int r = it;
        if (r < IT_WIN) { tr_matrix_item(a.in[I_WIN], INW, D, 2048, (bf16*)(ws + WS_WIN), -1, scr, r, F.lane); continue; } r -= IT_WIN;
        if (r < IT_C1) { tr_matrix_item(a.in[I_WK1], 256, 2048, 256, (bf16*)(ws + WS_WC1), -1, scr, r, F.lane); continue; } r -= IT_C1;
        if (r < IT_C1) { tr_matrix_item(a.in[I_WV1], 256, 2048, 256, (bf16*)(ws + WS_WC1) + 256 * 2048, -1, scr, r, F.lane); continue; } r -= IT_C1;
        if (r < IT_SQ) { tr_matrix_item(a.in[I_WO], D, D, D, (bf16*)(ws + WS_WO), -1, scr, r, F.lane); continue; } r -= IT_SQ;
        if (r < IT_FG) { tr_matrix_item(a.in[I_FG], DFF, D, DFF, (bf16*)(ws + WS_FGU), 0, scr, r, F.lane); continue; } r -= IT_FG;
        if (r < IT_FG) { tr_matrix_item(a.in[I_FU], DFF, D, DFF, (bf16*)(ws + WS_FGU), 1, scr, r, F.lane); continue; } r -= IT_FG;
        if (r < IT_FD) { tr_matrix_item(a.in[I_FD], D, DFF, D, (bf16*)(ws + WS_FDN), -1, scr, r, F.lane); continue; } r -= IT_FD;
        if (r < IT_GIN) { tr_matrix_item(a.in[I_GIN], 2048, D, 2048, (bf16*)(ws + WS_GIN), -1, scr, r, F.lane); continue; } r -= IT_GIN;
        if (r < IT_SQ) { tr_matrix_item(a.in[I_GOUT], D, D, D, (bf16*)(ws + WS_GOUT), -1, scr, r, F.lane); continue; } r -= IT_SQ;
        { const int per_e = 2 * IT_MG + IT_MD; const int e = r / per_e; int q = r % per_e;
          if (q < IT_MG) { tr_matrix_item(a.in[I_MG] + (size_t)e * D * DFE, DFE, D, DFE, (bf16*)(ws + WS_MGU) + (size_t)e * 2 * DFE * D, 0, scr, q, F.lane); continue; } q -= IT_MG;
          if (q < IT_MG) { tr_matrix_item(a.in[I_MU] + (size_t)e * D * DFE, DFE, D, DFE, (bf16*)(ws + WS_MGU) + (size_t)e * 2 * DFE * D, 1, scr, q, F.lane); continue; } q -= IT_MG;
          tr_matrix_item(a.in[I_MD] + (size_t)e * DFE * D, D, DFE, D, (bf16*)(ws + WS_MDN) + (size_t)e * D * DFE, -1, scr, q, F.lane); }
    }
    {
        const float* x = a.in[I_X]; const float* win = a.in[I_WIN]; bf16* xb = (bf16*)(ws + WS_XB); float* gates = (float*)(ws + WS_GATES);
        for (int m = gw; m < M; m += NGW) {
            const f32x4* xr = (const f32x4*)(x + (size_t)m * D) + F.lane; f32x4 v[4];
#pragma unroll
            for (int j = 0; j < 4; ++j) v[j] = xr[64 * j];
            unsigned long long* o8 = (unsigned long long*)(xb + (size_t)m * D) + F.lane;
#pragma unroll
            for (int j = 0; j < 4; ++j) o8[64 * j] = (unsigned long long)pk2(v[j][0], v[j][1]) | ((unsigned long long)pk2(v[j][2], v[j][3]) << 32);
            float g[24];
#pragma unroll
            for (int q = 0; q < 24; ++q) g[q] = 0.f;
#pragma unroll
            for (int j = 0; j < 4; ++j)
#pragma unroll
                for (int i = 0; i < 4; ++i) { const float* wrow = win + (size_t)(256 * j + 4 * F.lane + i) * INW + 2048; const float xv = v[j][i];
#pragma unroll
                    for (int q4 = 0; q4 < 6; ++q4) { const f32x4 w = *(const f32x4*)(wrow + 4 * q4); g[4 * q4] += xv * w[0]; g[4 * q4 + 1] += xv * w[1]; g[4 * q4 + 2] += xv * w[2]; g[4 * q4 + 3] += xv * w[3]; } }
#pragma unroll
            for (int q = 0; q < 24; ++q) g[q] = wave_sum(g[q]);
            float mine = 0.f;
#pragma unroll
            for (int q = 0; q < 24; ++q) mine = (F.lane == q) ? g[q] : mine;
            if (F.lane < 24) gates[(size_t)m * 24 + F.lane] = mine;
        }
    }
    if (blockIdx.x < 2) {
        const int kv = blockIdx.x; const float* pe = a.in[kv ? I_PEV : I_PEK]; const float* w1 = a.in[kv ? I_WV1 : I_WK1]; float* b1 = (float*)(ws + WS_SMALL) + kv * 256;
        if (F.tid < 256) { float s = 0.f; for (int k = 0; k < 2048; ++k) s += pe[k] * w1[(size_t)k * 256 + F.tid]; b1[F.tid] = s; }
    }
    if (blockIdx.x == 2 && F.tid < 256) ((u32x4*)(ws + WS_KC + (size_t)2 * 32 * 2048 * 64 * 2))[F.tid] = (u32x4){0u, 0u, 0u, 0u};
}

__device__ __forceinline__ void load_q(float (&q)[64], const bf16* qp, float scale) {
#pragma unroll
    for (int i = 0; i < 8; ++i) { const u32x4 v = ((const u32x4*)qp)[i];
        q[8 * i + 0] = bflo(v.x) * scale; q[8 * i + 1] = bfhi(v.x) * scale; q[8 * i + 2] = bflo(v.y) * scale; q[8 * i + 3] = bfhi(v.y) * scale;
        q[8 * i + 4] = bflo(v.z) * scale; q[8 * i + 5] = bfhi(v.z) * scale; q[8 * i + 6] = bflo(v.w) * scale; q[8 * i + 7] = bfhi(v.w) * scale; }
}
__device__ __forceinline__ float dot_bf(const float (&q)[64], const bf16* kp) {
    float s = 0.f;
#pragma unroll
    for (int i = 0; i < 8; ++i) { const u32x4 v = ((const u32x4*)kp)[i];
        s += q[8 * i + 0] * bflo(v.x) + q[8 * i + 1] * bfhi(v.x) + q[8 * i + 2] * bflo(v.y) + q[8 * i + 3] * bfhi(v.y)
           + q[8 * i + 4] * bflo(v.z) + q[8 * i + 5] * bfhi(v.z) + q[8 * i + 6] * bflo(v.w) + q[8 * i + 7] * bfhi(v.w); }
    return s;
}
__device__ __forceinline__ float dot_f32(const float (&q)[64], const float* kp) {
    float s = 0.f;
#pragma unroll
    for (int i = 0; i < 16; ++i) { const f32x4 v = ((const f32x4*)kp)[i]; s += q[4 * i] * v[0] + q[4 * i + 1] * v[1] + q[4 * i + 2] * v[2] + q[4 * i + 3] * v[3]; }
    return s;
}
__device__ __forceinline__ float pv_bf(float o, float e, const bf16* vbase, size_t pitch, int j0, int j1, int lane) {
    for (int j = j0; j < j1; ++j) { const float p = __builtin_bit_cast(float, __builtin_amdgcn_readlane(__builtin_bit_cast(int, e), j)); o += p * bf2f(vbase[(size_t)j * pitch + lane]); }
    return o;
}
__device__ __forceinline__ float pv_f32(float o, float e, const float* vbase, size_t pitch, int j0, int j1, int lane) {
    for (int j = j0; j < j1; ++j) { const float p = __builtin_bit_cast(float, __builtin_amdgcn_readlane(__builtin_bit_cast(int, e), j)); o += p * vbase[(size_t)j * pitch + lane]; }
    return o;
}
__device__ __forceinline__ float alibi_slope(int h) { return exp2f(-0.5f * (float)(h + 1)); }

__device__ __forceinline__ void p4_attention(Frame& F, const Args& a) {
    const int gw = F.vcu * NWAVES + F.wave, NGW = F.G * NWAVES, lane = F.lane;
    const bf16* P = (const bf16*)(F.ws + WS_P); bf16* O = (bf16*)(F.ws + WS_O);
    const float NINF = -__builtin_inff();
    for (int task = gw; task < M * 8; task += NGW) {
        const int m = task >> 3, h = task & 7, b = m >> 11, t = m & 2047, kvh = h >> 2;
        const float slope = alibi_slope(h), sink = a.in[I_SINK][h];
        float q[64]; load_q(q, P + (size_t)m * PW + h * 64, 0.125f);
        const bf16* Kb = P + (size_t)b * SEQ * PW + 512 + kvh * 64; const bf16* Vb = P + (size_t)b * SEQ * PW + 640 + kvh * 64;
        float s[2];
#pragma unroll
        for (int c = 0; c < 2; ++c) { const int kp = t - 127 + 64 * c + lane; const bool valid = kp >= 0; const int kc = valid ? kp : 0;
            const float d = dot_bf(q, Kb + (size_t)kc * PW); s[c] = valid ? d - slope * (float)(t - kp) : NINF; }
        float mx = fmaxf(wave_max(fmaxf(s[0], s[1])), sink);
        float e0 = __expf(s[0] - mx), e1 = __expf(s[1] - mx);
        const float den = wave_sum(e0 + e1) + __expf(sink - mx);
        float o = 0.f;
#pragma unroll
        for (int c = 0; c < 2; ++c) { const int base = t - 127 + 64 * c; const int j0 = base < 0 ? (-base < 64 ? -base : 64) : 0;
            o = pv_bf(o, c ? e1 : e0, Vb + (long)base * PW, PW, j0, 64, lane); }
        O[(size_t)m * D + h * 64 + lane] = (bf16)f2bf(o / den);
    }
    const float* KCC = (const float*)(F.ws + WS_KCC); const float* gates = (const float*)(F.ws + WS_GATES);
    LAS float* sc = (LAS float*)(F.lds + F.wave * 1024);
    for (int task = gw; task < M * 2; task += NGW) {
        const int m = task >> 1, hkv = task & 1, b = m >> 11, t = m & 2047, tb = t >> 6;
        const int nvc = t >= 31 ? ((t - 31) / 16 + 1 < NCMP ? (t - 31) / 16 + 1 : NCMP) : 0;
        const float* kcc = KCC + (size_t)((b * 2 + hkv) * 128) * 64; const float* vcc = KCC + (size_t)4096 * 64 + (size_t)((b * 2 + hkv) * 128) * 64;
        float oc0 = 0.f, oc1 = 0.f, oc2 = 0.f, oc3 = 0.f, ps0 = 0.f, ps1 = 0.f;
#pragma unroll 1
        for (int g = 0; g < 4; ++g) {
            const int hb = hkv * 4 + g; const float slope = alibi_slope(8 + hb);
            float q[64]; load_q(q, P + (size_t)m * PW + 768 + hb * 64, 0.125f);
            float s[2];
#pragma unroll
            for (int c = 0; c < 2; ++c) { const int cb = 64 * c + lane; const bool valid = cb < nvc;
                const float d = dot_f32(q, kcc + (size_t)cb * 64); s[c] = valid ? d - slope * (float)(t - (16 * cb + 31)) : NINF; }
            float mx = wave_max(fmaxf(s[0], s[1])); if (!(mx > NINF)) mx = 0.f;
            float e0 = (lane < nvc) ? __expf(s[0] - mx) : 0.f, e1 = (64 + lane < nvc) ? __expf(s[1] - mx) : 0.f;
            const float den = wave_sum(e0 + e1); const float inv = den > 0.f ? 1.0f / den : 1.0f;
            e0 *= inv; e1 *= inv; ps0 += e0; ps1 += e1;
            float o = 0.f;
            o = pv_f32(o, e0, vcc, 64, 0, nvc < 64 ? nvc : 64, lane);
            o = pv_f32(o, e1, vcc + 64 * 64, 64, 0, nvc > 64 ? nvc - 64 : 0, lane);
            oc0 = (g == 0) ? o : oc0; oc1 = (g == 1) ? o : oc1; oc2 = (g == 2) ? o : oc2; oc3 = (g == 3) ? o : oc3;
        }
        sc[lane] = ps0; sc[64 + lane] = ps1; LDS_WAIT(); asm volatile("" ::: "memory");
        float imp = 0.f;
        if (lane < 32) {
#pragma unroll
            for (int k = -1; k <= 3; ++k) { const int c = 4 * lane + k; if (c >= 0 && c < NCMP) imp += sc[c]; } }
        LDS_WAIT(); asm volatile("" ::: "memory");
        const bool validj = lane <= tb, forced = (lane == 0) || (lane == tb) || (lane == tb - 1);
        const float rank = (lane >= 32) ? NINF : (forced ? __builtin_inff() : (validj ? imp : NINF));
        int cnt = 0;
        for (int jj = 0; jj < 32; ++jj) { const float rj = __builtin_bit_cast(float, __builtin_amdgcn_readlane(__builtin_bit_cast(int, rank), jj)); cnt += (rj > rank || (rj == rank && jj < lane)) ? 1 : 0; }
        const unsigned selmask = (unsigned)__ballot(lane < 32 && cnt < 8 && validj);
#pragma unroll 1
        for (int g = 0; g < 4; ++g) {
            const int hb = hkv * 4 + g; const float slope = alibi_slope(8 + hb);
            float q[64]; load_q(q, P + (size_t)m * PW + 768 + hb * 64, 0.125f);
            float oslc = 0.f;
            {
                const bf16* Kb = P + (size_t)b * SEQ * PW + 1536 + hkv * 64; const bf16* Vb = P + (size_t)b * SEQ * PW + 1664 + hkv * 64;
                float s[8]; unsigned mm = selmask; float mx = NINF;
#pragma unroll
                for (int i = 0; i < 8; ++i) { s[i] = NINF;
                    if (mm) { const int j = __builtin_ctz(mm); mm &= mm - 1; const int kp = 64 * j + lane; const bool valid = kp <= t; const int kc = valid ? kp : t;
                        const float d = dot_bf(q, Kb + (size_t)kc * PW); s[i] = valid ? d - slope * (float)(t - kp) : NINF; }
                    mx = fmaxf(mx, s[i]); }
                mx = wave_max(mx);
                float den = 0.f;
#pragma unroll
                for (int i = 0; i < 8; ++i) { s[i] = __expf(s[i] - mx); den += s[i]; }
                den = wave_sum(den);
                mm = selmask;
#pragma unroll
                for (int i = 0; i < 8; ++i) { if (mm) { const int j = __builtin_ctz(mm); mm &= mm - 1; const int nk = (t - 64 * j + 1) < 64 ? (t - 64 * j + 1) : 64;
                        oslc = pv_bf(oslc, s[i], Vb + (size_t)(64 * j) * PW, PW, 0, nk, lane); } }
                oslc /= den;
            }
            float owin = 0.f;
            {
                const bf16* Kb = P + (size_t)b * SEQ * PW + 1792 + hkv * 64; const bf16* Vb = P + (size_t)b * SEQ * PW + 1920 + hkv * 64;
                float s[4]; float mx = NINF;
#pragma unroll
                for (int c = 0; c < 4; ++c) { const int kp = t - 255 + 64 * c + lane; const bool valid = kp >= 0; const int kc = valid ? kp : 0;
                    const float d = dot_bf(q, Kb + (size_t)kc * PW); s[c] = valid ? d - slope * (float)(t - kp) : NINF; mx = fmaxf(mx, s[c]); }
                mx = wave_max(mx);
                float den = 0.f;
#pragma unroll
                for (int c = 0; c < 4; ++c) { s[c] = __expf(s[c] - mx); den += s[c]; }
                den = wave_sum(den);
#pragma unroll
                for (int c = 0; c < 4; ++c) { const int base = t - 255 + 64 * c; const int j0 = base < 0 ? (-base < 64 ? -base : 64) : 0;
                    owin = pv_bf(owin, s[c], Vb + (long)base * PW, PW, j0, 64, lane); }
                owin /= den;
            }
            const float* gp = gates + (size_t)m * 24 + hb * 3;
            const float oc = (g == 0) ? oc0 : (g == 1) ? oc1 : (g == 2) ? oc2 : oc3;
            const float r = sigmoidf(gp[0]) * oc + sigmoidf(gp[1]) * oslc + sigmoidf(gp[2]) * owin;
            O[(size_t)m * D + 512 + hb * 64 + lane] = (bf16)f2bf(r);
        }
    }
}

template <int MODE>
__device__ __forceinline__ void ln_phase(Frame& F, const Args& a, const float* lg, const float* lb) {
    const int gw = F.vcu * NWAVES + F.wave, NGW = F.G * NWAVES, lane = F.lane;
    float* out = a.out; bf16* xb = (bf16*)(F.ws + WS_XB);
    f32x4 gg[4], bb[4];
#pragma unroll
    for (int j = 0; j < 4; ++j) { gg[j] = *((const f32x4*)lg + lane + 64 * j); bb[j] = *((const f32x4*)lb + lane + 64 * j); }
    for (int m = gw; m < M; m += NGW) {
        f32x4* xr = (f32x4*)(out + (size_t)m * D) + lane; f32x4 v[4]; float s = 0.f;
#pragma unroll
        for (int j = 0; j < 4; ++j) v[j] = xr[64 * j];
        if (MODE == 2) {
            const bf16* y = (const bf16*)(F.ws + WS_Y2) + (size_t)m * 2 * D;
#pragma unroll
            for (int j = 0; j < 4; ++j) { const u32x2 y0 = *((const u32x2*)y + lane + 64 * j), y1 = *((const u32x2*)(y + D) + lane + 64 * j);
                v[j][0] = ALPHA * v[j][0] + bflo(y0.x) + bflo(y1.x); v[j][1] = ALPHA * v[j][1] + bfhi(y0.x) + bfhi(y1.x);
                v[j][2] = ALPHA * v[j][2] + bflo(y0.y) + bflo(y1.y); v[j][3] = ALPHA * v[j][3] + bfhi(y0.y) + bfhi(y1.y); }
        }
#pragma unroll
        for (int j = 0; j < 4; ++j) s += (v[j][0] + v[j][1]) + (v[j][2] + v[j][3]);
        const float mean = wave_sum(s) * (1.f / D); float s2 = 0.f;
#pragma unroll
        for (int j = 0; j < 4; ++j) { v[j] = v[j] - mean; s2 += (v[j][0] * v[j][0] + v[j][1] * v[j][1]) + (v[j][2] * v[j][2] + v[j][3] * v[j][3]); }
        const float rstd = 1.f / sqrtf(wave_sum(s2) * (1.f / D) + LN_EPS);
#pragma unroll
        for (int j = 0; j < 4; ++j) { v[j] = v[j] * rstd * gg[j] + bb[j]; xr[64 * j] = v[j]; }
        if (MODE != 2) {
            unsigned long long* o8 = (unsigned long long*)(xb + (size_t)m * D) + lane;
#pragma unroll
            for (int j = 0; j < 4; ++j) o8[64 * j] = (unsigned long long)pk2(v[j][0], v[j][1]) | ((unsigned long long)pk2(v[j][2], v[j][3]) << 32);
        }
        if (MODE == 1) {
            const float* wr = a.in[I_RT]; float lg8[8];
#pragma unroll
            for (int e = 0; e < 8; ++e) lg8[e] = 0.f;
#pragma unroll
            for (int j = 0; j < 4; ++j)
#pragma unroll
                for (int i = 0; i < 4; ++i) { const float* w = wr + (size_t)(256 * j + 4 * lane + i) * 8; const f32x4 w0 = *(const f32x4*)w, w1 = *(const f32x4*)(w + 4); const float xv = v[j][i];
                    lg8[0] += xv * w0[0]; lg8[1] += xv * w0[1]; lg8[2] += xv * w0[2]; lg8[3] += xv * w0[3]; lg8[4] += xv * w1[0]; lg8[5] += xv * w1[1]; lg8[6] += xv * w1[2]; lg8[7] += xv * w1[3]; }
#pragma unroll
            for (int e = 0; e < 8; ++e) lg8[e] = wave_sum(lg8[e]);
            int e0 = 0; float v0 = lg8[0];
#pragma unroll
            for (int e = 1; e < 8; ++e) if (lg8[e] > v0) { v0 = lg8[e]; e0 = e; }
            int e1 = -1; float v1 = -__builtin_inff();
#pragma unroll
            for (int e = 0; e < 8; ++e) if (e != e0 && lg8[e] > v1) { v1 = lg8[e]; e1 = e; }
            const float g0 = 1.0f / (1.0f + __expf(v1 - v0)), g1 = 1.0f - g0;
            if (lane == 0) {
                int* rowtok = (int*)(F.ws + WS_ROWTOK); int* rowdst = (int*)(F.ws + WS_ROWDST); float* rowgate = (float*)(F.ws + WS_ROWGATE);
                const unsigned p0 = atomicAdd((unsigned*)(F.ctl + CW_CNT + 64 * e0), 1u), p1 = atomicAdd((unsigned*)(F.ctl + CW_CNT + 64 * e1), 1u);
                rowtok[e0 * CAP + p0] = m; rowdst[e0 * CAP + p0] = 2 * m; rowgate[e0 * CAP + p0] = g0;
                rowtok[e1 * CAP + p1] = m; rowdst[e1 * CAP + p1] = 2 * m + 1; rowgate[e1 * CAP + p1] = g1;
            }
        }
    }
}

__device__ __forceinline__ void p3_compress2(Frame& F, const Args& a) {
    const bf16* H1 = (const bf16*)(F.ws + WS_H1); float* KCC = (float*)(F.ws + WS_KCC);
    const int gt = blockIdx.x * NTHREADS + F.tid, NT = F.G * NTHREADS;
    for (int idx = gt; idx < 2 * 4096 * 64; idx += NT) {
        const int n = idx & 63, r = (idx >> 6) & 4095, kv = idx >> 18;
        const float* w2 = a.in[kv ? I_WV2 : I_WK2]; const bf16* h = H1 + (size_t)(kv * 4096 + r) * 256; float s = 0.f;
        for (int j8 = 0; j8 < 32; ++j8) { const u32x4 v = ((const u32x4*)h)[j8]; const float* w = w2 + (size_t)(8 * j8) * 64 + n;
            s += bflo(v.x) * w[0] + bfhi(v.x) * w[64] + bflo(v.y) * w[128] + bfhi(v.y) * w[192] + bflo(v.z) * w[256] + bfhi(v.z) * w[320] + bflo(v.w) * w[384] + bfhi(v.w) * w[448]; }
        KCC[idx] = s;
    }
}

__device__ __forceinline__ void p11_spatial(Frame& F, const Args& a) {
    const bf16* U = (const bf16*)(F.ws + WS_U); const bf16* V = (const bf16*)(F.ws + WS_V); bf16* Z = (bf16*)(F.ws + WS_Z);
    LAS float* Wl = (LAS float*)(F.lds); LAS float* vn = (LAS float*)(F.lds + 65536); LAS f32x2* st = (LAS f32x2*)(F.lds + LDS_STATS_OFF);
    const float* lng = a.in[I_GLNG]; const float* lnb = a.in[I_GLNB]; const float* ws_ = a.in[I_GWS]; const float* bs = a.in[I_GBS];
    const int tid = F.tid, lane = F.lane;
    for (int unit = blockIdx.x; unit < NB * 16; unit += F.G) {
        const int m0 = unit * 128;
        __syncthreads();
        for (int rr = 0; rr < 16; ++rr) { const int r = F.wave * 16 + rr; const bf16* vr = V + (size_t)(m0 + r) * D;
            const u32x4 p0 = ((const u32x4*)vr)[lane], p1 = ((const u32x4*)vr)[64 + lane]; float x[16];
            x[0] = bflo(p0.x); x[1] = bfhi(p0.x); x[2] = bflo(p0.y); x[3] = bfhi(p0.y); x[4] = bflo(p0.z); x[5] = bfhi(p0.z); x[6] = bflo(p0.w); x[7] = bfhi(p0.w);
            x[8] = bflo(p1.x); x[9] = bfhi(p1.x); x[10] = bflo(p1.y); x[11] = bfhi(p1.y); x[12] = bflo(p1.z); x[13] = bfhi(p1.z); x[14] = bflo(p1.w); x[15] = bfhi(p1.w);
            float s = 0.f;
#pragma unroll
            for (int i = 0; i < 16; ++i) s += x[i];
            const float mean = wave_sum(s) * (1.f / D); float s2 = 0.f;
#pragma unroll
            for (int i = 0; i < 16; ++i) { const float d = x[i] - mean; s2 += d * d; }
            const float rstd = 1.f / sqrtf(wave_sum(s2) * (1.f / D) + LN_EPS);
            if (lane == 0) st[r] = (f32x2){mean, rstd}; }
        __syncthreads();
        for (int g = 0; g < 8; ++g) {
            for (int i = tid; i < 128 * 32; i += NTHREADS) { const int t = i >> 5, s4 = (i & 31) * 4; f32x4 w = *(const f32x4*)(ws_ + (size_t)g * 16384 + t * 128 + s4);
                if (s4 + 0 > t) w[0] = 0.f; if (s4 + 1 > t) w[1] = 0.f; if (s4 + 2 > t) w[2] = 0.f; if (s4 + 3 > t) w[3] = 0.f; *(LAS f32x4*)(Wl + t * 128 + s4) = w; }
            { const int ch = tid & 127; const float gch = lng[g * 128 + ch], bch = lnb[g * 128 + ch];
              for (int s = tid >> 7; s < 128; s += 4) { const f32x2 ms = st[s]; vn[s * 128 + ch] = (bf2f(V[(size_t)(m0 + s) * D + g * 128 + ch]) - ms.x) * ms.y * gch + bch; } }
            __syncthreads();
            { const int ch = tid & 127, tq = tid >> 7; float acc[32];
#pragma unroll
              for (int i = 0; i < 32; ++i) acc[i] = 0.f;
              const int s4end = (tq * 32 + 32) / 4;
              for (int s4 = 0; s4 < s4end; ++s4) { const float v0 = vn[(4 * s4) * 128 + ch], v1 = vn[(4 * s4 + 1) * 128 + ch], v2 = vn[(4 * s4 + 2) * 128 + ch], v3 = vn[(4 * s4 + 3) * 128 + ch];
#pragma unroll
                  for (int i = 0; i < 32; ++i) { const f32x4 w = *(const LAS f32x4*)(Wl + (tq * 32 + i) * 128 + 4 * s4); acc[i] += w[0] * v0 + w[1] * v1 + w[2] * v2 + w[3] * v3; } }
#pragma unroll
              for (int i = 0; i < 32; ++i) { const int t = tq * 32 + i; const size_t o = (size_t)(m0 + t) * D + g * 128 + ch;
                  Z[o] = (bf16)f2bf(bf2f(U[o]) * (acc[i] + bs[g * 128 + t])); } }
            __syncthreads();
        }
    }
}

constexpr int N_PHASES = 25;
__global__ void __launch_bounds__(NTHREADS, 2) fwd(Args args) {
    extern __shared__ __attribute__((aligned(16))) unsigned char lds[];
    Frame F;
    F.lds = (LAS unsigned char*)lds; F.ws = args.ws; F.ctl = (gu32*)(args.ws + WS_CTL);
    F.tid = threadIdx.x; F.lane = F.tid & 63; F.wave = __builtin_amdgcn_readfirstlane(F.tid >> 6);
    F.G = gridDim.x; { const int bx = blockIdx.x; F.vcu = (F.G % 8 == 0) ? (bx % 8) * (F.G / 8) + bx / 8 : bx; }
    for (int u = F.tid; u < (LDS_BYTES - LDSCTL_OFF) / 4; u += NTHREADS) ((LAS unsigned*)(F.lds + LDSCTL_OFF))[u] = 0u;
    __syncthreads();
    unsigned char* ws = args.ws;
#if MK_ONE_LAUNCH
    XcdBarrier bar = xcd_barrier_post((unsigned*)(F.ctl + CW_BAR), (volatile LAS unsigned*)(F.lds + LDSCTL_OFF));
#define GRID_BAR() xcd_barrier(bar)
#else
#define GRID_BAR() do { } while (0)
#endif
    const int lo = args.ph_lo, hi = args.ph_hi;
#define IN(k) (lo <= (k) && (k) < hi)
#define SEAM(k) do { if (IN(k) && IN((k) + 1)) GRID_BAR(); } while (0)
    const int G = F.G, c = (int)blockIdx.x;
    const float* lng = args.in[I_LNG]; const float* lnb = args.in[I_LNB];

    if (IN(0)) { p0_prologue(F, args); } SEAM(0);
    if (IN(1)) { pg8::Gemm g{(const char*)(ws + WS_XB), (const char*)(ws + WS_WIN), D, 0}; pg8::StaticOrder S{M / 256, 8, G, c};
        pg8::EpiBf<0> E{(bf16*)(ws + WS_P), (bf16*)(ws + WS_KC), PW, nullptr, nullptr, nullptr}; pg8::ADense al{(unsigned)D * 2u};
        pg8::gemm_phase(F.lds, g, S, E, al); } SEAM(1);
    if (IN(2)) { pg8::Gemm g{(const char*)(ws + WS_KC), (const char*)(ws + WS_WC1), 2048, (size_t)256 * 2048 * 2}; pg8::CmpOrder S{c};
        pg8::EpiBf<1> E{(bf16*)(ws + WS_H1), nullptr, 256, (const float*)(ws + WS_SMALL), nullptr, nullptr}; pg8::ADense al{1024u * 2u};
        pg8::gemm_phase(F.lds, g, S, E, al); } SEAM(2);
    if (IN(3)) { p3_compress2(F, args); } SEAM(3);
    if (IN(4)) { p4_attention(F, args); } SEAM(4);
    if (IN(5)) { pg8::Gemm g{(const char*)(ws + WS_O), (const char*)(ws + WS_WO), D, 0}; pg8::StaticOrder S{M / 256, 4, G, c};
        pg8::EpiRes E{args.in[I_X], args.out, ALPHA}; pg8::ADense al{(unsigned)D * 2u};
        pg8::gemm_phase(F.lds, g, S, E, al); } SEAM(5);
    if (IN(6)) { ln_phase<0>(F, args, lng + 0 * D, lnb + 0 * D); } SEAM(6);
    if (IN(7)) { pg8::Gemm g{(const char*)(ws + WS_XB), (const char*)(ws + WS_FGU), D, 0}; pg8::StaticOrder S{M / 256, DFF / 128, G, c};
        pg8::EpiBf<3> E{(bf16*)(ws + WS_H), nullptr, DFF, nullptr, nullptr, nullptr}; pg8::ADense al{(unsigned)D * 2u};
        pg8::gemm_phase(F.lds, g, S, E, al); } SEAM(7);
    if (IN(8)) { pg8::Gemm g{(const char*)(ws + WS_H), (const char*)(ws + WS_FDN), DFF, 0}; pg8::StaticOrder S{M / 256, 4, G, c};
        pg8::EpiRes E{args.out, args.out, ALPHA}; pg8::ADense al{(unsigned)DFF * 2u};
        pg8::gemm_phase(F.lds, g, S, E, al); } SEAM(8);
    if (IN(9)) { ln_phase<0>(F, args, lng + 1 * D, lnb + 1 * D); } SEAM(9);
    if (IN(10)) { pg8::Gemm g{(const char*)(ws + WS_XB), (const char*)(ws + WS_GIN), D, 0}; pg8::StaticOrder S{M / 256, 8, G, c};
        pg8::EpiBf<2> E{(bf16*)(ws + WS_U), (bf16*)(ws + WS_V), D, nullptr, nullptr, nullptr}; pg8::ADense al{(unsigned)D * 2u};
        pg8::gemm_phase(F.lds, g, S, E, al); } SEAM(10);
    if (IN(11)) { p11_spatial(F, args); } SEAM(11);
    if (IN(12)) { pg8::Gemm g{(const char*)(ws + WS_Z), (const char*)(ws + WS_GOUT), D, 0}; pg8::StaticOrder S{M / 256, 4, G, c};
        pg8::EpiRes E{args.out, args.out, ALPHA}; pg8::ADense al{(unsigned)D * 2u};
        pg8::gemm_phase(F.lds, g, S, E, al); } SEAM(12);
    if (IN(13)) { ln_phase<1>(F, args, lng + 2 * D, lnb + 2 * D); } SEAM(13);
    {
        LAS int* tab = (LAS int*)(F.lds + LDS_MOE_OFF);
        if (hi > 14 && lo < 24) {
            __syncthreads();
            if (F.tid == 0) { int ts = 0;
                for (int e = 0; e < 8; ++e) { int n = (int)__hip_atomic_load(F.ctl + CW_CNT + 64 * e, __ATOMIC_RELAXED, __HIP_MEMORY_SCOPE_AGENT); if (n > CAP) n = CAP; tab[e] = n; tab[8 + e] = ts; ts += (n + 255) >> 8; }
                tab[16] = ts; }
            __syncthreads();
        }
        const int T = tab[16];
#pragma unroll 1
        for (int ch = 0; ch < 5; ++ch) {
            const int tile0 = 64 * ch; int nM = T - tile0; nM = nM < 0 ? 0 : (nM > 64 ? 64 : nM);
            nM = __builtin_amdgcn_readfirstlane(nM);
            if (IN(14 + 2 * ch)) { pg8::Gemm g{(const char*)(ws + WS_XB), (const char*)(ws + WS_MGU), D, (size_t)2 * DFE * D * 2}; pg8::MoeOrder S{nM, DFE / 128, G, c, tile0, tab};
                pg8::EpiBf<3> E{(bf16*)(ws + WS_HM), nullptr, DFE, nullptr, nullptr, nullptr}; pg8::AGather al{(const int*)(ws + WS_ROWTOK), (unsigned)D * 2u};
                pg8::gemm_phase(F.lds, g, S, E, al); }
            SEAM(14 + 2 * ch);
            if (IN(15 + 2 * ch)) { pg8::Gemm g{(const char*)(ws + WS_HM), (const char*)(ws + WS_MDN), DFE, (size_t)D * DFE * 2}; pg8::MoeOrder S{nM, 4, G, c, tile0, tab};
                pg8::EpiBf<4> E{(bf16*)(ws + WS_Y2), nullptr, D, nullptr, (const int*)(ws + WS_ROWDST), (const float*)(ws + WS_ROWGATE)}; pg8::ADense al{(unsigned)DFE * 2u};
                pg8::gemm_phase(F.lds, g, S, E, al); }
            SEAM(15 + 2 * ch);
        }
    }
    if (IN(24)) { ln_phase<2>(F, args, lng + 3 * D, lnb + 3 * D); }
#undef IN
#undef SEAM
}

extern "C" void kernel_launch(void* const* d_in, const int* in_sizes, int n_in, void* d_out, int out_size, void* d_ws, size_t ws_size, hipStream_t stream) {
    static int grid = 0;
    if (grid == 0) {
        if (n_in != 25 || in_sizes[0] != M * D || out_size != M * D || ws_size < WS_END) { fprintf(stderr, "kernel_launch: unexpected shapes (n_in %d, in0 %d, out %d, ws %zu); nothing launched\n", n_in, n_in > 0 ? in_sizes[0] : -1, out_size, ws_size); grid = -1; return; }
        int dev = 0, cus = 0, per_cu = 0;
        if (hipGetDevice(&dev) != hipSuccess || hipDeviceGetAttribute(&cus, hipDeviceAttributeMultiprocessorCount, dev) != hipSuccess) { grid = -1; return; }
        if (hipFuncSetAttribute((const void*)fwd, hipFuncAttributeMaxDynamicSharedMemorySize, LDS_BYTES) != hipSuccess) { fprintf(stderr, "kernel_launch: hipFuncSetAttribute failed\n"); grid = -1; return; }
        if (hipOccupancyMaxActiveBlocksPerMultiprocessor(&per_cu, (const void*)fwd, NTHREADS, LDS_BYTES) != hipSuccess || per_cu < 1) fprintf(stderr, "kernel_launch: occupancy query reports %d\n", per_cu);
        (void)hipGetLastError();
        grid = cus;
    }
    if (grid < 0) return;
    if (hipMemsetAsync((char*)d_ws + WS_CTL, 0, CTL_ZERO_BYTES, stream) != hipSuccess) return;
    Args a{};
    for (int i = 0; i < 25; ++i) a.in[i] = (const float*)d_in[i];
    a.out = (float*)d_out; a.ws = (unsigned char*)d_ws;
#if MK_ONE_LAUNCH
    a.ph_lo = 0; a.ph_hi = N_PHASES;
    hipLaunchKernelGGL(fwd, dim3(grid), dim3(NTHREADS), LDS_BYTES, stream, a);
#else
    for (int p = 0; p < N_PHASES; ++p) { a.ph_lo = p; a.ph_hi = p + 1; hipLaunchKernelGGL(fwd, dim3(grid), dim3(NTHREADS), LDS_BYTES, stream, a); }
#endif
}
```

```cpp
#include <hip/hip_runtime.h>
#include <cstdio>
#include <cstdint>

#ifndef MK_ONE_LAUNCH
#define MK_ONE_LAUNCH 1
#endif

#define LAS __attribute__((address_space(3)))
#define GAS __attribute__((address_space(1)))
typedef unsigned short bf16;
typedef short bf16x8 __attribute__((ext_vector_type(8)));
typedef float f32x4 __attribute__((ext_vector_type(4)));
typedef float f32x2 __attribute__((ext_vector_type(2)));
typedef unsigned u32x4 __attribute__((ext_vector_type(4)));
typedef unsigned u32x2 __attribute__((ext_vector_type(2)));
typedef GAS unsigned gu32;

constexpr int NB = 16, SEQ = 2048, D = 1024, M = NB * SEQ;
constexpr int PW = 2048;
constexpr int INW = 2072;
constexpr int DFF = 2816, DFE = 3584, NEXP = 8, CAP = 32768;
constexpr int NCMP = 127;
constexpr float ALPHA = 1.4142135623730951f;
constexpr float LN_EPS = 1e-5f;
constexpr int NWAVES = 8, NTHREADS = 512;

constexpr size_t MiB = 1u << 20;
constexpr size_t WS_CTL = 0, CTL_ZERO_BYTES = 1 * MiB;
constexpr size_t WS_SMALL = 1 * MiB;
constexpr size_t WS_ROWTOK = 2 * MiB, WS_ROWDST = 3 * MiB, WS_ROWGATE = 4 * MiB;
constexpr size_t WS_WIN = 5 * MiB;
constexpr size_t WS_WC1 = 9 * MiB;
constexpr size_t WS_WO = 11 * MiB;
constexpr size_t WS_FGU = 13 * MiB;
constexpr size_t WS_FDN = 24 * MiB;
constexpr size_t WS_GIN = 30 * MiB;
constexpr size_t WS_GOUT = 34 * MiB;
constexpr size_t WS_MGU = 36 * MiB;
constexpr size_t WS_MDN = 148 * MiB;
constexpr size_t WS_XB = 204 * MiB;
constexpr size_t WS_BIG = 268 * MiB;
constexpr size_t WS_P = WS_BIG;
constexpr size_t WS_O = WS_BIG + 128 * MiB;
constexpr size_t WS_H = WS_BIG;
constexpr size_t WS_U = WS_BIG, WS_V = WS_BIG + 64 * MiB, WS_Z = WS_BIG + 128 * MiB;
constexpr size_t WS_HM = WS_BIG;
constexpr size_t WS_Y2 = WS_BIG + 112 * MiB;
constexpr size_t WS_GATES = 460 * MiB;
constexpr size_t WS_KC = 463 * MiB;
constexpr size_t WS_H1 = 480 * MiB;
constexpr size_t WS_KCC = 484 * MiB;
constexpr size_t WS_KCCB = 486 * MiB;
constexpr size_t WS_END = 508 * MiB;
static_assert(WS_Y2 + 128 * MiB <= WS_END && WS_H + (size_t)M * DFF * 2 <= WS_GATES && WS_KC + 17 * MiB <= WS_H1, "ws map");
constexpr int CW_BAR = 4096;
constexpr int CW_CNT = 16384;

constexpr int RING_BYTES = 131072;
constexpr int LDSCTL_OFF = RING_BYTES;
constexpr int LDS_STATS_OFF = RING_BYTES + 1024;
constexpr int LDS_MOE_OFF = RING_BYTES + 4096;
constexpr int LDS_BYTES = 147456;

#define LDS_WAIT() asm volatile("s_waitcnt lgkmcnt(0)" ::: "memory")
#define VM_WAIT() asm volatile("s_waitcnt vmcnt(0)" ::: "memory")
__device__ __forceinline__ unsigned f2bf(float f) { unsigned u = __builtin_bit_cast(unsigned, f); return (u + 0x7fffu + ((u >> 16) & 1u)) >> 16; }
__device__ __forceinline__ unsigned pk2(float lo, float hi) { return f2bf(lo) | (f2bf(hi) << 16); }
__device__ __forceinline__ float bflo(unsigned u) { return __builtin_bit_cast(float, u << 16); }
__device__ __forceinline__ float bfhi(unsigned u) { return __builtin_bit_cast(float, u & 0xffff0000u); }
__device__ __forceinline__ float bf2f(bf16 b) { return __builtin_bit_cast(float, (unsigned)b << 16); }
__device__ __forceinline__ float wave_sum(float v) {
#pragma unroll
    for (int o = 1; o < 64; o <<= 1) v += __shfl_xor(v, o);
    return v;
}
__device__ __forceinline__ float wave_max(float v) {
#pragma unroll
    for (int o = 1; o < 64; o <<= 1) v = fmaxf(v, __shfl_xor(v, o));
    return v;
}
__device__ __forceinline__ float gelu_tanh(float x) {
    const float u = 0.7978845608028654f * (x + 0.044715f * x * x * x);
    return x / (1.0f + __expf(-2.0f * u));
}
__device__ __forceinline__ float silu(float x) { return x / (1.0f + __expf(-x)); }
__device__ __forceinline__ float sigmoidf(float x) { return 1.0f / (1.0f + __expf(-x)); }

namespace pg8 {
constexpr int BM = 256, BK = 64, HALF = 128, HTB = HALF * BK * 2, STAGE_BYTES = 8 * HTB, NXCD = 8, WGM = 8;
__host__ __device__ __forceinline__ int lds_byte(int r, int c) { const int st = (r >> 4) * 2 + (c >> 5), rr = r & 15, cc = c & 31, ob = rr * 64 + cc * 2; return st * 1024 + (ob ^ (((ob >> 9) & 1) << 5)); }
__host__ __device__ __forceinline__ void stage_rc(int b, int& R, int& C) { const int st = b / 1024, sb = b % 1024, swz = sb ^ (((sb >> 9) & 1) << 5); R = (st >> 1) * 16 + swz / 64; C = (st & 1) * 32 + (swz % 64) / 2; }
__host__ __device__ __forceinline__ int perm32(int rho) { const int n = rho >> 4, i = rho & 15; return 8 * (i >> 2) + 4 * n + (i & 3); }

struct Unit { int pm, pn, e, te, ne; };
struct Gemm { const char* A; const char* Bt; int K; size_t eStrideB; };

struct ADense { unsigned pitchB; __device__ __forceinline__ unsigned operator()(const Unit& u, int R) const { return (unsigned)(u.pm * 256 + R) * pitchB; } };
struct AGather { const int* rowtok; unsigned pitchB;
    __device__ __forceinline__ unsigned operator()(const Unit& u, int R) const { const int ri = u.te * 256 + R; const int tok = ri < u.ne ? rowtok[u.e * CAP + ri] : 0; return (unsigned)tok * pitchB; } };

__device__ __forceinline__ bool static_unit(int i, int G, int c, int nM, int nN, int& pm, int& pn) {
    const int nwg = nM * nN; const long L = (long)i * G + c; if (L >= nwg) return false;
    int wgid = (int)L; { const int q = nwg / NXCD, r = nwg % NXCD, xcd = wgid % NXCD, off = wgid / NXCD; wgid = (xcd < r ? xcd * (q + 1) : r * (q + 1) + (xcd - r) * q) + off; }
    const int nig = WGM * nN, gid = wgid / nig, fm = gid * WGM, gsz = (nM - fm) < WGM ? (nM - fm) : WGM;
    pm = fm + ((wgid % nig) % gsz); pn = (wgid % nig) / gsz; return true;
}
struct StaticOrder { int nM, nN, G, c;
    __device__ __forceinline__ bool next(int i, Unit& u) const { u.e = 0; u.te = 0; u.ne = 0; return static_unit(i, G, c, nM, nN, u.pm, u.pn); } };
struct CmpOrder { int c;
    __device__ __forceinline__ bool next(int i, Unit& u) const { if (i > 0 || c >= 32) return false; u.pm = c; u.pn = 0; u.e = c >> 4; u.te = 0; u.ne = 0; return true; } };
struct MoeOrder { int nM, nN, G, c, tile0; const LAS int* tab;
    __device__ __forceinline__ bool next(int i, Unit& u) const {
        int pm, pn; if (!static_unit(i, G, c, nM, nN, pm, pn)) return false;
        const int ct = tile0 + pm; int e = 0;
#pragma unroll
        for (int k = 1; k < 8; ++k) e += (ct >= tab[8 + k]) ? 1 : 0;
        e = __builtin_amdgcn_readfirstlane(e);
        u.pm = pm; u.pn = pn; u.e = e; u.te = __builtin_amdgcn_readfirstlane(ct - tab[8 + e]); u.ne = __builtin_amdgcn_readfirstlane(tab[e]); return true; } };

__device__ __forceinline__ u32x4 pack8(const f32x4& a, const f32x4& b) { u32x4 w; w.x = pk2(a[0], a[1]); w.y = pk2(a[2], a[3]); w.z = pk2(b[0], b[1]); w.w = pk2(b[2], b[3]); return w; }

struct EpiRes {
    static constexpr bool PERM = false;
    const float* res; float* out; float alpha;
    __device__ __forceinline__ void operator()(const f32x4 (&acc)[2][2][4][2], const Unit& u, int wr, int wc, int fr, int fq) const {
        const int row0 = u.pm * BM + wr * 64 + fr, col0 = u.pn * BM + wc * 32 + 4 * fq;
#pragma unroll
        for (int ai = 0; ai < 2; ++ai)
#pragma unroll
            for (int m = 0; m < 4; ++m) { const size_t off = (size_t)(row0 + ai * HALF + m * 16) * D + col0;
#pragma unroll
                for (int bj = 0; bj < 2; ++bj)
#pragma unroll
                    for (int n = 0; n < 2; ++n) { const size_t o = off + bj * HALF + n * 16; const f32x4 r = *(const f32x4*)(res + o); *(f32x4*)(out + o) = acc[ai][bj][m][n] + alpha * r; } }
    }
};
template <int MODE> struct EpiBf {
    static constexpr bool PERM = true;
    bf16* O; bf16* O2; int ldc; const float* bias; const int* rowdst; const float* rowgate;
    __device__ __forceinline__ void operator()(const f32x4 (&acc)[2][2][4][2], const Unit& u, int wr, int wc, int fr, int fq) const {
        const int lr0 = wr * 64 + fr, ct = wc * 32 + 8 * fq;
#pragma unroll
        for (int ai = 0; ai < 2; ++ai)
#pragma unroll
            for (int m = 0; m < 4; ++m) {
                const int lr = lr0 + ai * HALF + m * 16; const int row = u.pm * BM + lr;
                if (MODE == 0) {
#pragma unroll
                    for (int bj = 0; bj < 2; ++bj) { const u32x4 w = pack8(acc[ai][bj][m][0], acc[ai][bj][m][1]);
                        *(u32x4*)(O + (size_t)row * PW + u.pn * BM + bj * HALF + ct) = w;
                        if (u.pn == 5) { const int b = row >> 11, t = row & 2047, hh = wc >> 1, d = (wc & 1) * 32 + 8 * fq;
                            *(u32x4*)(O2 + ((size_t)((bj * 32 + b * 2 + hh) * 2048 + t)) * 64 + d) = w; } }
                } else if (MODE == 1) {
#pragma unroll
                    for (int bj = 0; bj < 2; ++bj) { const int col = bj * HALF + ct; const float* bp = bias + u.e * 256 + col;
                        const f32x4 b0 = *(const f32x4*)bp, b1 = *(const f32x4*)(bp + 4); f32x4 v0 = acc[ai][bj][m][0] + b0, v1 = acc[ai][bj][m][1] + b1;
#pragma unroll
                        for (int j = 0; j < 4; ++j) { v0[j] = gelu_tanh(v0[j]); v1[j] = gelu_tanh(v1[j]); }
                        *(u32x4*)(O + (size_t)row * 256 + col) = pack8(v0, v1); }
                } else if (MODE == 2) {
                    bf16* dst = (u.pn < 4) ? O : O2;
#pragma unroll
                    for (int bj = 0; bj < 2; ++bj) { f32x4 v0 = acc[ai][bj][m][0], v1 = acc[ai][bj][m][1];
#pragma unroll
                        for (int j = 0; j < 4; ++j) { v0[j] = gelu_tanh(v0[j]); v1[j] = gelu_tanh(v1[j]); }
                        *(u32x4*)(dst + (size_t)row * D + (u.pn & 3) * BM + bj * HALF + ct) = pack8(v0, v1); }
                } else if (MODE == 3) {
                    f32x4 v0, v1;
#pragma unroll
                    for (int j = 0; j < 4; ++j) { v0[j] = silu(acc[ai][0][m][0][j]) * acc[ai][1][m][0][j]; v1[j] = silu(acc[ai][0][m][1][j]) * acc[ai][1][m][1][j]; }
                    *(u32x4*)(O + (size_t)row * ldc + u.pn * HALF + ct) = pack8(v0, v1);
                } else {
                    const int gi = u.te * 256 + lr;
                    if (gi < u.ne) { const int dst = rowdst[u.e * CAP + gi]; const float gt = rowgate[u.e * CAP + gi];
#pragma unroll
                        for (int bj = 0; bj < 2; ++bj) { const f32x4 v0 = acc[ai][bj][m][0] * gt, v1 = acc[ai][bj][m][1] * gt;
                            *(u32x4*)(O + (size_t)dst * D + u.pn * BM + bj * HALF + ct) = pack8(v0, v1); } }
                }
            }
    }
};

template <class Epi, class Sched, class AL>
__device__ __forceinline__ void gemm_phase(LAS unsigned char* lds, const Gemm g, const Sched& S, const Epi& E, const AL& al) {
    const int tid = threadIdx.x, wid = __builtin_amdgcn_readfirstlane(tid >> 6), lane = tid & 63, wr = wid >> 2, wc = wid & 3, fr = lane & 15, fq = lane >> 4;
    const int K = g.K, nt = K / BK;
    int Rs[2]; unsigned Cb[2], voffB[2];
#pragma unroll
    for (int i = 0; i < 2; ++i) { int R, C; stage_rc(tid * 16 + i * 8192, R, C); const int Rb = Epi::PERM ? ((R & ~31) + perm32(R & 31)) : R;
        Rs[i] = R; Cb[i] = (unsigned)C * 2u; voffB[i] = (unsigned)(Rb * K + C) * 2u; }
    const size_t kstep = (size_t)(BK * 2);
    const size_t hstepB = (size_t)HALF * K * 2;
    const size_t tstepB = 2 * hstepB;
    const unsigned ldsw = (unsigned)wid * 1024u;
    const int aoff = lds_byte(wr * 64 + fr, fq * 8), boff = lds_byte(wc * 32 + fr, fq * 8);
#define PG8_SA(b, h) (((b) * 2 + (h)) * HTB)
#define PG8_SB(b, h) ((4 + (b) * 2 + (h)) * HTB)
#define PG8_STAGE(bufoff, gbase, voff) do { _Pragma("unroll") for (int _i = 0; _i < 2; ++_i) \
        __builtin_amdgcn_global_load_lds((const unsigned*)((const char*)(gbase) + (voff)[_i]), (LAS unsigned*)(lds + (bufoff) + ldsw + _i * 8192), 16, 0, 0); } while (0)
#define PG8_LDA(dst, b, h) do { _Pragma("unroll") for (int m = 0; m < 4; ++m) _Pragma("unroll") for (int k = 0; k < 2; ++k) dst[m][k] = *(const LAS bf16x8*)(lds + PG8_SA(b, h) + aoff + m * 2048 + k * 1024); } while (0)
#define PG8_LDB(dst, b, h) do { _Pragma("unroll") for (int n = 0; n < 2; ++n) _Pragma("unroll") for (int k = 0; k < 2; ++k) dst[n][k] = *(const LAS bf16x8*)(lds + PG8_SB(b, h) + boff + n * 2048 + k * 1024); } while (0)
#define PG8_MMA(ai, bj, At, Bt) do { __builtin_amdgcn_s_setprio(1); _Pragma("unroll") for (int m = 0; m < 4; ++m) _Pragma("unroll") for (int n = 0; n < 2; ++n) _Pragma("unroll") for (int k = 0; k < 2; ++k) \
        acc[ai][bj][m][n] = __builtin_amdgcn_mfma_f32_16x16x32_bf16(Bt[n][k], At[m][k], acc[ai][bj][m][n], 0, 0, 0); __builtin_amdgcn_s_setprio(0); } while (0)
#define PG8_WAIT_V(n) asm volatile("s_waitcnt vmcnt(" #n ")" ::: "memory")
#define PG8_WAIT_L(n) asm volatile("s_waitcnt lgkmcnt(" #n ")" ::: "memory")
#define PG8_BAR __builtin_amdgcn_s_barrier()
#define PG8_SCHED __builtin_amdgcn_sched_barrier(0)
#define PG8_VOFF(dst, u) do { _Pragma("unroll") for (int _h = 0; _h < 2; ++_h) _Pragma("unroll") for (int _i = 0; _i < 2; ++_i) dst[_h][_i] = al(u, _h * HALF + Rs[_i]) + Cb[_i]; } while (0)
    Unit cur, nxt; int ui = 0;
    if (!S.next(0, cur)) return;
    f32x4 acc[2][2][4][2];
#pragma unroll
    for (int a = 0; a < 2; ++a)
#pragma unroll
        for (int b = 0; b < 2; ++b)
#pragma unroll
            for (int m = 0; m < 4; ++m)
#pragma unroll
                for (int n = 0; n < 2; ++n) acc[a][b][m][n] = (f32x4){0.f, 0.f, 0.f, 0.f};
    bf16x8 At[4][2], B0[2][2], B1[2][2];
    unsigned vC[2][2], vP[2][2], vN[2][2];
    PG8_VOFF(vC, cur);
#pragma unroll
    for (int h = 0; h < 2; ++h)
#pragma unroll
        for (int i = 0; i < 2; ++i) vP[h][i] = vC[h][i];
    const char* const A0 = g.A;
    const char* cB = g.Bt + (size_t)cur.e * g.eStrideB + (size_t)cur.pn * tstepB;
    PG8_STAGE(PG8_SB(0, 0), cB, voffB); PG8_STAGE(PG8_SB(0, 1), cB + hstepB, voffB); PG8_STAGE(PG8_SA(0, 0), A0, vC[0]); PG8_STAGE(PG8_SA(0, 1), A0, vC[1]);
    if (wr == 1) PG8_BAR;
    PG8_WAIT_V(2); PG8_BAR;
    PG8_STAGE(PG8_SB(1, 0), cB + kstep, voffB); PG8_STAGE(PG8_SA(1, 0), A0 + kstep, vC[0]); PG8_STAGE(PG8_SB(1, 1), cB + hstepB + kstep, voffB);
    PG8_WAIT_V(6); PG8_BAR;
    for (;;) {
        const bool has_next = S.next(ui + 1, nxt);
        const char* nB = cB;
        if (has_next) { PG8_VOFF(vN, nxt); nB = g.Bt + (size_t)nxt.e * g.eStrideB + (size_t)nxt.pn * tstepB; }
        else {
#pragma unroll
            for (int h = 0; h < 2; ++h)
#pragma unroll
                for (int i = 0; i < 2; ++i) vN[h][i] = vC[h][i]; }
        for (int t = 0; t < nt; t += 2) {
            const bool last = (t == nt - 2);
            if (last) {
#pragma unroll
                for (int h = 0; h < 2; ++h)
#pragma unroll
                    for (int i = 0; i < 2; ++i) vP[h][i] = vN[h][i]; }
            const char* a1 = A0 + (size_t)(t + 1) * kstep;
            const char* a2 = last ? A0 : A0 + (size_t)(t + 2) * kstep; const char* b2 = last ? nB : cB + (size_t)(t + 2) * kstep;
            const char* a3 = a2 + kstep; const char* b3 = b2 + kstep;
            PG8_LDB(B0, 0, 0); PG8_LDB(B1, 0, 1); PG8_SCHED; PG8_LDA(At, 0, 0); PG8_STAGE(PG8_SA(1, 1), a1, vC[1]);
            PG8_WAIT_V(8); PG8_WAIT_L(0); PG8_BAR; PG8_MMA(0, 0, At, B0); PG8_MMA(0, 1, At, B1); PG8_BAR; PG8_SCHED;
            PG8_LDA(At, 0, 1); PG8_STAGE(PG8_SB(0, 0), b2, voffB); PG8_STAGE(PG8_SB(0, 1), b2 + hstepB, voffB); PG8_STAGE(PG8_SA(0, 0), a2, vP[0]);
            PG8_WAIT_V(8); PG8_WAIT_L(0); PG8_BAR; PG8_MMA(1, 0, At, B0); PG8_MMA(1, 1, At, B1); PG8_BAR; PG8_SCHED;
            PG8_LDB(B0, 1, 0); PG8_LDB(B1, 1, 1); PG8_SCHED; PG8_LDA(At, 1, 0); PG8_STAGE(PG8_SA(0, 1), a2, vP[1]);
            PG8_WAIT_V(8); PG8_WAIT_L(0); PG8_BAR; PG8_MMA(0, 0, At, B0); PG8_MMA(0, 1, At, B1); PG8_BAR; PG8_SCHED;
            PG8_LDA(At, 1, 1); PG8_STAGE(PG8_SB(1, 0), b3, voffB); PG8_STAGE(PG8_SB(1, 1), b3 + hstepB, voffB); PG8_STAGE(PG8_SA(1, 0), a3, vP[0]);
            PG8_WAIT_V(8); PG8_WAIT_L(0); PG8_BAR; PG8_MMA(1, 0, At, B0); PG8_MMA(1, 1, At, B1); PG8_BAR; PG8_SCHED;
        }
        if (wr == 0) PG8_BAR;
        E(acc, cur, wr, wc, fr, fq);
        if (!has_next) break;
#pragma unroll
        for (int a = 0; a < 2; ++a)
#pragma unroll
            for (int b = 0; b < 2; ++b)
#pragma unroll
                for (int m = 0; m < 4; ++m)
#pragma unroll
                    for (int n = 0; n < 2; ++n) acc[a][b][m][n] = (f32x4){0.f, 0.f, 0.f, 0.f};
        cur = nxt; cB = nB; ++ui;
#pragma unroll
        for (int h = 0; h < 2; ++h)
#pragma unroll
            for (int i = 0; i < 2; ++i) vC[h][i] = vP[h][i];
        if (wr == 1) PG8_BAR;
    }
    PG8_WAIT_V(0);
    PG8_BAR;
#undef PG8_SA
#undef PG8_SB
#undef PG8_STAGE
#undef PG8_LDA
#undef PG8_LDB
#undef PG8_MMA
#undef PG8_WAIT_V
#undef PG8_WAIT_L
#undef PG8_BAR
#undef PG8_SCHED
#undef PG8_VOFF
}
}

#define XB_TMO      128
#define XB_XCNT(j)  (256  + 64 * (j))
#define XB_XSUB(j)  (1280 + 64 * (j))
#define XB_XGEN(j)  (2304 + 64 * (j))
#define XB_TOP      3328
#define XB_TOPGEN   3392
#define XCD_BAR_WORDS 3456
#define XB_SPIN_CAP (1u << 18)
__device__ __forceinline__ unsigned xb_ld(unsigned* p)              { return __hip_atomic_load(p, __ATOMIC_RELAXED, __HIP_MEMORY_SCOPE_AGENT); }
__device__ __forceinline__ unsigned xb_add(unsigned* p, unsigned v) { return __hip_atomic_fetch_add(p, v, __ATOMIC_RELAXED, __HIP_MEMORY_SCOPE_AGENT); }
__device__ __forceinline__ unsigned xb_xcc_id() { return (unsigned)__builtin_amdgcn_s_getreg((3 << 11) | 20) & 0xFu; }
#define XB_SPIN(cond, bar) do { unsigned _sp = 0; while (cond) { __builtin_amdgcn_s_sleep(1); \
    if ((++_sp & 255u) == 0u) { if (xb_ld(&(bar)[XB_TMO])) break; if (_sp > XB_SPIN_CAP) { atomicAdd(&(bar)[XB_TMO], 1u); break; } } } } while (0)
struct XcdBarrier { unsigned* bar; unsigned x; volatile LAS unsigned* st; };
__device__ __forceinline__ XcdBarrier xcd_barrier_post(unsigned* bar, volatile LAS unsigned* st) {
    XcdBarrier b; b.bar = bar; b.x = xb_xcc_id(); b.st = st;
    if (threadIdx.x == 0) (void)xb_add(&bar[XB_XCNT(b.x)], 1u);
    return b;
}
__device__ __forceinline__ void xcd_barrier_complete(unsigned* bar, unsigned x, unsigned& nloc, unsigned& nx) {
    const unsigned G = gridDim.x * gridDim.y * gridDim.z;
    unsigned sum, cnt, mine, sp = 0u;
    for (;;) {
        sum = 0u; cnt = 0u; mine = 0u;
#pragma unroll
        for (unsigned j = 0; j < 16; ++j) { const unsigned c = xb_ld(&bar[XB_XCNT(j)]); sum += c; cnt += (c > 0u) ? 1u : 0u; mine = (j == x) ? c : mine; }
        if (sum == G) break;
        __builtin_amdgcn_s_sleep(1);
        if ((++sp & 255u) == 0u) { if (xb_ld(&bar[XB_TMO])) break; if (sp > XB_SPIN_CAP) { atomicAdd(&bar[XB_TMO], 1u); break; } }
    }
    nloc = mine > 0u ? mine : 1u; nx = cnt > 0u ? cnt : 1u;
}
__device__ __forceinline__ void xcd_barrier(const XcdBarrier& b) {
    asm volatile("s_waitcnt vmcnt(0)" ::: "memory");
    __syncthreads();
    if (threadIdx.x == 0) {
        unsigned* bar = b.bar;
        __builtin_amdgcn_s_waitcnt(0);
        unsigned nloc = b.st[0], nx = b.st[1];
        if (nloc == 0u) { xcd_barrier_complete(bar, b.x, nloc, nx); b.st[0] = nloc; b.st[1] = nx; }
        const unsigned old = xb_add(&bar[XB_XSUB(b.x)], 1u);
        const unsigned gen = old / nloc;
        if (old + 1u == (gen + 1u) * nloc) {
            __builtin_amdgcn_fence(__ATOMIC_RELEASE, "agent");
            asm volatile("s_waitcnt vmcnt(0)" ::: "memory");
            const unsigned og = xb_add(&bar[XB_TOP], 1u);
            const unsigned tg = og / nx;
            if (og + 1u == (tg + 1u) * nx) xb_add(&bar[XB_TOPGEN], 1u);
            else XB_SPIN(xb_ld(&bar[XB_TOPGEN]) == tg, bar);
            __builtin_amdgcn_fence(__ATOMIC_ACQUIRE, "agent");
            xb_add(&bar[XB_XGEN(b.x)], 1u);
            asm volatile("s_waitcnt vmcnt(0)" ::: "memory");
        } else {
            XB_SPIN(xb_ld(&bar[XB_XGEN(b.x)]) == gen, bar);
            __builtin_amdgcn_fence(__ATOMIC_ACQUIRE, "agent");
            asm volatile("s_waitcnt vmcnt(0)" ::: "memory");
        }
    }
    __syncthreads();
}

struct Args {
    const float* in[25]; float* out; unsigned char* ws; int ph_lo, ph_hi;
};
struct Frame {
    LAS unsigned char* lds; gu32* ctl; unsigned char* ws;
    int tid, lane, wave, vcu, G;
};
enum { I_X = 0, I_WIN, I_SINK, I_PEK, I_WK1, I_WK2, I_PEV, I_WV1, I_WV2, I_WO, I_FG, I_FU, I_FD, I_GIN, I_GLNG, I_GLNB, I_GWS, I_GBS, I_GOUT, I_RT, I_MG, I_MU, I_MD, I_LNG, I_LNB };

__device__ __forceinline__ void tr_item(const float* W, int pitch, int k0, int n0, bf16* dst, int ldk, LAS float* scr, int lane) {
#pragma unroll 8
    for (int i = 0; i < 32; ++i) { const int kk = 2 * i + (lane >> 5); scr[kk * 33 + (lane & 31)] = W[(size_t)(k0 + kk) * pitch + n0 + (lane & 31)]; }
    LDS_WAIT(); asm volatile("" ::: "memory");
    const int c = lane & 7;
#pragma unroll
    for (int j = 0; j < 4; ++j) { const int n = (lane >> 3) + 8 * j; const LAS float* s = scr + (8 * c) * 33 + n;
        u32x4 o; o.x = pk2(s[0 * 33], s[1 * 33]); o.y = pk2(s[2 * 33], s[3 * 33]); o.z = pk2(s[4 * 33], s[5 * 33]); o.w = pk2(s[6 * 33], s[7 * 33]);
        *(u32x4*)(dst + (size_t)n * ldk + 8 * c) = o; }
    LDS_WAIT(); asm volatile("" ::: "memory");
}
__device__ __forceinline__ void tr_matrix_item(const float* W, int pitch, int K, int N, bf16* WT, int inter_up  , LAS float* scr, int item, int lane) {
    const int nblk = N / 32, kb = item / nblk, nb = item % nblk, k0 = 64 * kb, n0 = 32 * nb;
    const int drow = inter_up < 0 ? n0 : ((n0 >> 7) * 256 + (n0 & 127) + inter_up * 128);
    tr_item(W, pitch, k0, n0, WT + (size_t)drow * K + k0, K, scr, lane);
}

__device__ __forceinline__ void p0_prologue(Frame& F, const Args& a) {
    LAS float* scr = (LAS float*)(F.lds + F.wave * 16384);
    const int gw = F.vcu * NWAVES + F.wave, NGW = F.G * NWAVES;
    unsigned char* ws = F.ws;
    constexpr int IT_WIN = (D / 64) * (2048 / 32), IT_C1 = (2048 / 64) * (256 / 32), IT_SQ = (D / 64) * (D / 32), IT_FG = (D / 64) * (DFF / 32), IT_FD = (DFF / 64) * (D / 32),
                  IT_GIN = (D / 64) * (2048 / 32), IT_MG = (D / 64) * (DFE / 32), IT_MD = (DFE / 64) * (D / 32);
    constexpr int NITEMS = IT_WIN + 2 * IT_C1 + IT_SQ + 2 * IT_FG + IT_FD + IT_GIN + IT_SQ + NEXP * (2 * IT_MG + IT_MD);
    for (int it = gw; it < NITEMS; it += NGW) {
        int r = it;
        if (r < IT_WIN) { tr_matrix_item(a.in[I_WIN], INW, D, 2048, (bf16*)(ws + WS_WIN), -1, scr, r, F.lane); continue; } r -= IT_WIN;
        if (r < IT_C1) { tr_matrix_item(a.in[I_WK1], 256, 2048, 256, (bf16*)(ws + WS_WC1), -1, scr, r, F.lane); continue; } r -= IT_C1;
        if (r < IT_C1) { tr_matrix_item(a.in[I_WV1], 256, 2048, 256, (bf16*)(ws + WS_WC1) + 256 * 2048, -1, scr, r, F.lane); continue; } r -= IT_C1;
        if (r < IT_SQ) { tr_matrix_item(a.in[I_WO], D, D, D, (bf16*)(ws + WS_WO), -1, scr, r, F.lane); continue; } r -= IT_SQ;
        if (r < IT_FG) { tr_matrix_item(a.in[I_FG], DFF, D, DFF, (bf16*)(ws + WS_FGU), 0, scr, r, F.lane); continue; } r -= IT_FG;
        if (r < IT_FG) { tr_matrix_item(a.in[I_FU], DFF, D, DFF, (bf16*)(ws + WS_FGU), 1, scr, r, F.lane); continue; } r -= IT_FG;
        if (r < IT_FD) { tr_matrix_item(a.in[I_FD], D, DFF, D, (bf16*)(ws + WS_FDN), -1, scr, r, F.lane); continue; } r -= IT_FD;
        if (r < IT_GIN) { tr_matrix_item(a.in[I_GIN], 2048, D, 2048, (bf16*)(ws + WS_GIN), -1, scr, r, F.lane); continue; } r -= IT_GIN;
        if (r < IT_SQ) { tr_matrix_item(a.in[I_GOUT], D, D, D, (bf16*)(ws + WS_GOUT), -1, scr, r, F.lane); continue; } r -= IT_SQ;
        { const int per_e = 2 * IT_MG + IT_MD; const int e = r / per_e; int q = r % per_e;
          if (q < IT_MG) { tr_matrix_item(a.in[I_MG] + (size_t)e * D * DFE, DFE, D, DFE, (bf16*)(ws + WS_MGU) + (size_t)e * 2 * DFE * D, 0, scr, q, F.lane); continue; } q -= IT_MG;
          if (q < IT_MG) { tr_matrix_item(a.in[I_MU] + (size_t)e * D * DFE, DFE, D, DFE, (bf16*)(ws + WS_MGU) + (size_t)e * 2 * DFE * D, 1, scr, q, F.lane); continue; } q -= IT_MG;
          tr_matrix_item(a.in[I_MD] + (size_t)e * DFE * D, D, DFE, D, (bf16*)(ws + WS_MDN) + (size_t)e * D * DFE, -1, scr, q, F.lane); }
    }
    {
        const float* x = a.in[I_X]; const float* win = a.in[I_WIN]; bf16* xb = (bf16*)(ws + WS_XB); float* gates = (float*)(ws + WS_GATES);
        for (int m = gw; m < M; m += NGW) {
            const f32x4* xr = (const f32x4*)(x + (size_t)m * D) + F.lane; f32x4 v[4];
#pragma unroll
            for (int j = 0; j < 4; ++j) v[j] = xr[64 * j];
            unsigned long long* o8 = (unsigned long long*)(xb + (size_t)m * D) + F.lane;
#pragma unroll
            for (int j = 0; j < 4; ++j) o8[64 * j] = (unsigned long long)pk2(v[j][0], v[j][1]) | ((unsigned long long)pk2(v[j][2], v[j][3]) << 32);
            float g[24];
#pragma unroll
            for (int q = 0; q < 24; ++q) g[q] = 0.f;
#pragma unroll
            for (int j = 0; j < 4; ++j)
#pragma unroll
                for (int i = 0; i < 4; ++i) { const float* wrow = win + (size_t)(256 * j + 4 * F.lane + i) * INW + 2048; const float xv = v[j][i];
#pragma unroll
                    for (int q4 = 0; q4 < 6; ++q4) { const f32x4 w = *(const f32x4*)(wrow + 4 * q4); g[4 * q4] += xv * w[0]; g[4 * q4 + 1] += xv * w[1]; g[4 * q4 + 2] += xv * w[2]; g[4 * q4 + 3] += xv * w[3]; } }
#pragma unroll
            for (int q = 0; q < 24; ++q) g[q] = wave_sum(g[q]);
            float mine = 0.f;
#pragma unroll
            for (int q = 0; q < 24; ++q) mine = (F.lane == q) ? g[q] : mine;
            if (F.lane < 24) gates[(size_t)m * 24 + F.lane] = mine;
        }
    }
    if (blockIdx.x < 2) {
        const int kv = blockIdx.x; const float* pe = a.in[kv ? I_PEV : I_PEK]; const float* w1 = a.in[kv ? I_WV1 : I_WK1]; float* b1 = (float*)(ws + WS_SMALL) + kv * 256;
        if (F.tid < 256) { float s = 0.f; for (int k = 0; k < 2048; ++k) s += pe[k] * w1[(size_t)k * 256 + F.tid]; b1[F.tid] = s; }
    }
    if (blockIdx.x == 2 && F.tid < 256) ((u32x4*)(ws + WS_KC + (size_t)2 * 32 * 2048 * 64 * 2))[F.tid] = (u32x4){0u, 0u, 0u, 0u};
}

__device__ __forceinline__ void load_q(float (&q)[64], const bf16* qp, float scale) {
#pragma unroll
    for (int i = 0; i < 8; ++i) { const u32x4 v = ((const u32x4*)qp)[i];
        q[8 * i + 0] = bflo(v.x) * scale; q[8 * i + 1] = bfhi(v.x) * scale; q[8 * i + 2] = bflo(v.y) * scale; q[8 * i + 3] = bfhi(v.y) * scale;
        q[8 * i + 4] = bflo(v.z) * scale; q[8 * i + 5] = bfhi(v.z) * scale; q[8 * i + 6] = bflo(v.w) * scale; q[8 * i + 7] = bfhi(v.w) * scale; }
}
__device__ __forceinline__ float dot_bf(const float (&q)[64], const bf16* kp) {
    float s = 0.f;
#pragma unroll
    for (int i = 0; i < 8; ++i) { const u32x4 v = ((const u32x4*)kp)[i];
        s += q[8 * i + 0] * bflo(v.x) + q[8 * i + 1] * bfhi(v.x) + q[8 * i + 2] * bflo(v.y) + q[8 * i + 3] * bfhi(v.y)
           + q[8 * i + 4] * bflo(v.z) + q[8 * i + 5] * bfhi(v.z) + q[8 * i + 6] * bflo(v.w) + q[8 * i + 7] * bfhi(v.w); }
    return s;
}
__device__ __forceinline__ float dot_f32(const float (&q)[64], const float* kp) {
    float s = 0.f;
#pragma unroll
    for (int i = 0; i < 16; ++i) { const f32x4 v = ((const f32x4*)kp)[i]; s += q[4 * i] * v[0] + q[4 * i + 1] * v[1] + q[4 * i + 2] * v[2] + q[4 * i + 3] * v[3]; }
    return s;
}
__device__ __forceinline__ float pv_bf(float o, float e, const bf16* vbase, size_t pitch, int j0, int j1, int lane) {
    for (int j = j0; j < j1; ++j) { const float p = __builtin_bit_cast(float, __builtin_amdgcn_readlane(__builtin_bit_cast(int, e), j)); o += p * bf2f(vbase[(size_t)j * pitch + lane]); }
    return o;
}
__device__ __forceinline__ float pv_f32(float o, float e, const float* vbase, size_t pitch, int j0, int j1, int lane) {
    for (int j = j0; j < j1; ++j) { const float p = __builtin_bit_cast(float, __builtin_amdgcn_readlane(__builtin_bit_cast(int, e), j)); o += p * vbase[(size_t)j * pitch + lane]; }
    return o;
}
__device__ __forceinline__ float alibi_slope(int h) { return exp2f(-0.5f * (float)(h + 1)); }

__device__ __forceinline__ void p4_attention(Frame& F, const Args& a) {
    const int gw = F.vcu * NWAVES + F.wave, NGW = F.G * NWAVES, lane = F.lane;
    const bf16* P = (const bf16*)(F.ws + WS_P); bf16* O = (bf16*)(F.ws + WS_O);
    const float NINF = -__builtin_inff();
    for (int task = gw; task < M * 8; task += NGW) {
        const int m = task >> 3, h = task & 7, b = m >> 11, t = m & 2047, kvh = h >> 2;
        const float slope = alibi_slope(h), sink = a.in[I_SINK][h];
        float q[64]; load_q(q, P + (size_t)m * PW + h * 64, 0.125f);
        const bf16* Kb = P + (size_t)b * SEQ * PW + 512 + kvh * 64; const bf16* Vb = P + (size_t)b * SEQ * PW + 640 + kvh * 64;
        float s[2];
#pragma unroll
        for (int c = 0; c < 2; ++c) { const int kp = t - 127 + 64 * c + lane; const bool valid = kp >= 0; const int kc = valid ? kp : 0;
            const float d = dot_bf(q, Kb + (size_t)kc * PW); s[c] = valid ? d - slope * (float)(t - kp) : NINF; }
        float mx = fmaxf(wave_max(fmaxf(s[0], s[1])), sink);
        float e0 = __expf(s[0] - mx), e1 = __expf(s[1] - mx);
        const float den = wave_sum(e0 + e1) + __expf(sink - mx);
        float o = 0.f;
#pragma unroll
        for (int c = 0; c < 2; ++c) { const int base = t - 127 + 64 * c; const int j0 = base < 0 ? (-base < 64 ? -base : 64) : 0;
            o = pv_bf(o, c ? e1 : e0, Vb + (long)base * PW, PW, j0, 64, lane); }
        O[(size_t)m * D + h * 64 + lane] = (bf16)f2bf(o / den);
    }
    const float* KCC = (const float*)(F.ws + WS_KCC); const float* gates = (const float*)(F.ws + WS_GATES);
    LAS float* sc = (LAS float*)(F.lds + F.wave * 1024);
    for (int task = gw; task < M * 2; task += NGW) {
        const int m = task >> 1, hkv = task & 1, b = m >> 11, t = m & 2047, tb = t >> 6;
        const int nvc = t >= 31 ? ((t - 31) / 16 + 1 < NCMP ? (t - 31) / 16 + 1 : NCMP) : 0;
        const float* kcc = KCC + (size_t)((b * 2 + hkv) * 128) * 64; const float* vcc = KCC + (size_t)4096 * 64 + (size_t)((b * 2 + hkv) * 128) * 64;
        float oc0 = 0.f, oc1 = 0.f, oc2 = 0.f, oc3 = 0.f, ps0 = 0.f, ps1 = 0.f;
#pragma unroll 1
        for (int g = 0; g < 4; ++g) {
            const int hb = hkv * 4 + g; const float slope = alibi_slope(8 + hb);
            float q[64]; load_q(q, P + (size_t)m * PW + 768 + hb * 64, 0.125f);
            float s[2];
#pragma unroll
            for (int c = 0; c < 2; ++c) { const int cb = 64 * c + lane; const bool valid = cb < nvc;
                const float d = dot_f32(q, kcc + (size_t)cb * 64); s[c] = valid ? d - slope * (float)(t - (16 * cb + 31)) : NINF; }
            float mx = wave_max(fmaxf(s[0], s[1])); if (!(mx > NINF)) mx = 0.f;
            float e0 = (lane < nvc) ? __expf(s[0] - mx) : 0.f, e1 = (64 + lane < nvc) ? __expf(s[1] - mx) : 0.f;
            const float den = wave_sum(e0 + e1); const float inv = den > 0.f ? 1.0f / den : 1.0f;
            e0 *= inv; e1 *= inv; ps0 += e0; ps1 += e1;
            float o = 0.f;
            o = pv_f32(o, e0, vcc, 64, 0, nvc < 64 ? nvc : 64, lane);
            o = pv_f32(o, e1, vcc + 64 * 64, 64, 0, nvc > 64 ? nvc - 64 : 0, lane);
            oc0 = (g == 0) ? o : oc0; oc1 = (g == 1) ? o : oc1; oc2 = (g == 2) ? o : oc2; oc3 = (g == 3) ? o : oc3;
        }
        sc[lane] = ps0; sc[64 + lane] = ps1; LDS_WAIT(); asm volatile("" ::: "memory");
        float imp = 0.f;
        if (lane < 32) {
#pragma unroll
            for (int k = -1; k <= 3; ++k) { const int c = 4 * lane + k; if (c >= 0 && c < NCMP) imp += sc[c]; } }
        LDS_WAIT(); asm volatile("" ::: "memory");
        const bool validj = lane <= tb, forced = (lane == 0) || (lane == tb) || (lane == tb - 1);
        const float rank = (lane >= 32) ? NINF : (forced ? __builtin_inff() : (validj ? imp : NINF));
        int cnt = 0;
        for (int jj = 0; jj < 32; ++jj) { const float rj = __builtin_bit_cast(float, __builtin_amdgcn_readlane(__builtin_bit_cast(int, rank), jj)); cnt += (rj > rank || (rj == rank && jj < lane)) ? 1 : 0; }
        const unsigned selmask = (unsigned)__ballot(lane < 32 && cnt < 8 && validj);
#pragma unroll 1
        for (int g = 0; g < 4; ++g) {
            const int hb = hkv * 4 + g; const float slope = alibi_slope(8 + hb);
            float q[64]; load_q(q, P + (size_t)m * PW + 768 + hb * 64, 0.125f);
            float oslc = 0.f;
            {
                const bf16* Kb = P + (size_t)b * SEQ * PW + 1536 + hkv * 64; const bf16* Vb = P + (size_t)b * SEQ * PW + 1664 + hkv * 64;
                float s[8]; unsigned mm = selmask; float mx = NINF;
#pragma unroll
                for (int i = 0; i < 8; ++i) { s[i] = NINF;
                    if (mm) { const int j = __builtin_ctz(mm); mm &= mm - 1; const int kp = 64 * j + lane; const bool valid = kp <= t; const int kc = valid ? kp : t;
                        const float d = dot_bf(q, Kb + (size_t)kc * PW); s[i] = valid ? d - slope * (float)(t - kp) : NINF; }
                    mx = fmaxf(mx, s[i]); }
                mx = wave_max(mx);
                float den = 0.f;
#pragma unroll
                for (int i = 0; i < 8; ++i) { s[i] = __expf(s[i] - mx); den += s[i]; }
                den = wave_sum(den);
                mm = selmask;
#pragma unroll
                for (int i = 0; i < 8; ++i) { if (mm) { const int j = __builtin_ctz(mm); mm &= mm - 1; const int nk = (t - 64 * j + 1) < 64 ? (t - 64 * j + 1) : 64;
                        oslc = pv_bf(oslc, s[i], Vb + (size_t)(64 * j) * PW, PW, 0, nk, lane); } }
                oslc /= den;
            }
            float owin = 0.f;
            {
                const bf16* Kb = P + (size_t)b * SEQ * PW + 1792 + hkv * 64; const bf16* Vb = P + (size_t)b * SEQ * PW + 1920 + hkv * 64;
                float s[4]; float mx = NINF;
#pragma unroll
                for (int c = 0; c < 4; ++c) { const int kp = t - 255 + 64 * c + lane; const bool valid = kp >= 0; const int kc = valid ? kp : 0;
                    const float d = dot_bf(q, Kb + (size_t)kc * PW); s[c] = valid ? d - slope * (float)(t - kp) : NINF; mx = fmaxf(mx, s[c]); }
                mx = wave_max(mx);
                float den = 0.f;
#pragma unroll
                for (int c = 0; c < 4; ++c) { s[c] = __expf(s[c] - mx); den += s[c]; }
                den = wave_sum(den);
#pragma unroll
                for (int c = 0; c < 4; ++c) { const int base = t - 255 + 64 * c; const int j0 = base < 0 ? (-base < 64 ? -base : 64) : 0;
                    owin = pv_bf(owin, s[c], Vb + (long)base * PW, PW, j0, 64, lane); }
                owin /= den;
            }
            const float* gp = gates + (size_t)m * 24 + hb * 3;
            const float oc = (g == 0) ? oc0 : (g == 1) ? oc1 : (g == 2) ? oc2 : oc3;
            const float r = sigmoidf(gp[0]) * oc + sigmoidf(gp[1]) * oslc + sigmoidf(gp[2]) * owin;
            O[(size_t)m * D + 512 + hb * 64 + lane] = (bf16)f2bf(r);
        }
    }
}


namespace att {
typedef float f32x16 __attribute__((ext_vector_type(16)));
typedef short s16x4 __attribute__((ext_vector_type(4)));
typedef __bf16 bf16x2_t __attribute__((ext_vector_type(2)));
constexpr int KP = 144;
constexpr int TILEB = 64 * KP;
constexpr int BUFB = 2 * TILEB;
constexpr float LOG2E = 1.4426950408889634f;
__device__ __forceinline__ unsigned cvtpk(float lo, float hi) { f32x2 v = {lo, hi}; bf16x2_t b = __builtin_convertvector(v, bf16x2_t); return __builtin_bit_cast(unsigned, b); }
__device__ __forceinline__ f32x16 zero16() { f32x16 z;
#pragma unroll
    for (int i = 0; i < 16; ++i) z[i] = 0.f; return z; }
struct Stage { u32x4 k, v; };
__device__ __forceinline__ void stage_load(Stage& s, const bf16* Kg, const bf16* Vg, size_t pitch, int row0, int tid) {
    const int key = tid >> 3, ch = tid & 7; s.k = *(const u32x4*)(Kg + (size_t)(row0 + key) * pitch + ch * 8); s.v = *(const u32x4*)(Vg + (size_t)(row0 + key) * pitch + ch * 8); }
__device__ __forceinline__ void stage_store(const Stage& s, LAS unsigned char* buf, int tid) {
    const int key = tid >> 3, ch = tid & 7; *(LAS u32x4*)(buf + key * KP + ch * 16) = s.k; *(LAS u32x4*)(buf + TILEB + key * KP + ch * 16) = s.v; }
__device__ __forceinline__ bf16x8 pack_frag(const f32x16& x, int s) {
    u32x4 w; w.x = cvtpk(x[8 * s], x[8 * s + 1]); w.y = cvtpk(x[8 * s + 2], x[8 * s + 3]); w.z = cvtpk(x[8 * s + 4], x[8 * s + 5]); w.w = cvtpk(x[8 * s + 6], x[8 * s + 7]); return __builtin_bit_cast(bf16x8, w); }

template <int MODE>
__device__ __forceinline__ void stream(f32x16 (&oT)[2], f32x16& imp, float& m_run, float& l_run, const bf16x8 (&qf)[4], const bf16* Kg, const bf16* Vg, size_t pitch,
                                       int first, int ntile, unsigned umask, int tq, float slope, unsigned selmask, int W, LAS unsigned char* lds, int tid, int lane) {
    const int r = lane & 31, h = lane >> 5;
    const float NINF = -__builtin_inff();
    if (ntile <= 0) return;
    __syncthreads();
    Stage st; unsigned mm = umask;
    int kt = (MODE == 1) ? __builtin_ctz(mm) : first; if (MODE == 1) mm &= mm - 1;
    stage_load(st, Kg, Vg, pitch, 64 * kt, tid);
    for (int i = 0; i < ntile; ++i) {
        LAS unsigned char* buf = lds + (i & 1) * BUFB;
        stage_store(st, buf, tid);
        __syncthreads();
        const int ktc = kt;
        if (i + 1 < ntile) { kt = (MODE == 1) ? __builtin_ctz(mm) : kt + 1; if (MODE == 1) mm &= mm - 1; stage_load(st, Kg, Vg, pitch, 64 * kt, tid); }
        f32x16 p[2];
#pragma unroll
        for (int blk = 0; blk < 2; ++blk) { p[blk] = zero16();
#pragma unroll
            for (int d0 = 0; d0 < 4; ++d0) { const bf16x8 ka = *(const LAS bf16x8*)(buf + (32 * blk + r) * KP + (16 * d0 + 8 * h) * 2);
                p[blk] = __builtin_amdgcn_mfma_f32_32x32x16_bf16(ka, qf[d0], p[blk], 0, 0, 0); } }
        float fb, step;
        if (MODE == 2) { fb = (float)(tq - 31 - 16 * (64 * ktc + 4 * h)); step = 16.f; } else { fb = (float)(tq - 64 * ktc - 4 * h); step = 1.f; }
        const bool lane_on = (MODE == 1) ? ((selmask >> ktc) & 1u) != 0u : true;
        float tmax = NINF;
#pragma unroll
        for (int blk = 0; blk < 2; ++blk)
#pragma unroll
            for (int i2 = 0; i2 < 16; ++i2) { const float dist = fb - step * (float)(32 * blk + (i2 & 3) + 8 * (i2 >> 2));
                bool valid = dist >= 0.f && lane_on; if (MODE == 0) valid = valid && dist < (float)W;
                const float sv = valid ? p[blk][i2] - slope * dist : NINF; p[blk][i2] = sv; tmax = fmaxf(tmax, sv); }
        tmax = fmaxf(tmax, __shfl_xor(tmax, 32));
        const float m_new = fmaxf(m_run, tmax), m_use = (m_new == NINF) ? 0.f : m_new;
        const float alpha = __builtin_amdgcn_exp2f((m_run - m_use) * LOG2E), mb = -m_use * LOG2E;
        float rs = 0.f;
#pragma unroll
        for (int blk = 0; blk < 2; ++blk)
#pragma unroll
            for (int i2 = 0; i2 < 16; ++i2) { const float e = __builtin_amdgcn_exp2f(fmaf(p[blk][i2], LOG2E, mb)); p[blk][i2] = e; rs += e; }
        l_run = l_run * alpha + rs; m_run = m_new;
#pragma unroll
        for (int i2 = 0; i2 < 16; ++i2) { oT[0][i2] *= alpha; oT[1][i2] *= alpha; if (MODE == 2) imp[i2] *= alpha; }
        const LAS unsigned char* vb = buf + TILEB + (4 * h + ((lane >> 2) & 3)) * KP + (16 * ((lane >> 4) & 1) + 4 * (lane & 3)) * 2;
#pragma unroll
        for (int blk = 0; blk < 2; ++blk)
#pragma unroll
            for (int s = 0; s < 2; ++s) { const int ks = 2 * blk + s; const bf16x8 pf = pack_frag(p[blk], s);
#pragma unroll
                for (int db = 0; db < 2; ++db) { const LAS unsigned char* ad = vb + (16 * ks) * KP + (32 * db) * 2;
                    const s16x4 lo = __builtin_bit_cast(s16x4, __builtin_amdgcn_ds_read_tr16_b64_v4i16((LAS s16x4*)ad));
                    const s16x4 hi = __builtin_bit_cast(s16x4, __builtin_amdgcn_ds_read_tr16_b64_v4i16((LAS s16x4*)(ad + 8 * KP)));
                    const bf16x8 vf = (bf16x8){lo[0], lo[1], lo[2], lo[3], hi[0], hi[1], hi[2], hi[3]};
                    oT[db] = __builtin_amdgcn_mfma_f32_32x32x16_bf16(vf, pf, oT[db], 0, 0, 0); }
                if (MODE == 2) {
                    u32x4 w;
#pragma unroll
                    for (int e2 = 0; e2 < 4; ++e2) { const int c0 = 64 * ktc + 16 * ks + 8 * (e2 >> 1) + 4 * h + 2 * (e2 & 1), c1 = c0 + 1;
                        const unsigned b0 = (c0 >= 4 * r - 1 && c0 <= 4 * r + 3) ? 0x3F80u : 0u, b1 = (c1 >= 4 * r - 1 && c1 <= 4 * r + 3) ? 0x3F80u : 0u; w[e2] = b0 | (b1 << 16); }
                    imp = __builtin_amdgcn_mfma_f32_32x32x16_bf16(__builtin_bit_cast(bf16x8, w), pf, imp, 0, 0, 0); } }
    }
}
__device__ __forceinline__ void load_qfrag(bf16x8 (&qf)[4], const bf16* qrow, int h) {
#pragma unroll
    for (int d0 = 0; d0 < 4; ++d0) { const u32x4 v = *(const u32x4*)(qrow + 16 * d0 + 8 * h); u32x4 w;
        w.x = cvtpk(bflo(v.x) * 0.125f, bfhi(v.x) * 0.125f); w.y = cvtpk(bflo(v.y) * 0.125f, bfhi(v.y) * 0.125f); w.z = cvtpk(bflo(v.z) * 0.125f, bfhi(v.z) * 0.125f); w.w = cvtpk(bflo(v.w) * 0.125f, bfhi(v.w) * 0.125f);
        qf[d0] = __builtin_bit_cast(bf16x8, w); }
}
__device__ __forceinline__ void fold(f32x16 (&res)[2], const f32x16 (&oT)[2], float sc) {
#pragma unroll
    for (int i = 0; i < 16; ++i) { res[0][i] += sc * oT[0][i]; res[1][i] += sc * oT[1][i]; } }
__device__ __forceinline__ void store_o(bf16* orow, const f32x16 (&res)[2], int h) {
#pragma unroll
    for (int db = 0; db < 2; ++db)
#pragma unroll
        for (int a4 = 0; a4 < 4; ++a4) { u32x2 w; w.x = cvtpk(res[db][4 * a4], res[db][4 * a4 + 1]); w.y = cvtpk(res[db][4 * a4 + 2], res[db][4 * a4 + 3]);
            *(u32x2*)(orow + 32 * db + 8 * a4 + 4 * h) = w; }
}
}

__device__ __forceinline__ void p4_attention_mfma(Frame& F, const Args& a) {
    using namespace att;
    const int lane = F.lane, tid = F.tid, w = F.wave, r = lane & 31, h = lane >> 5, g = r >> 3, qi = r & 7;
    const bf16* P = (const bf16*)(F.ws + WS_P); bf16* O = (bf16*)(F.ws + WS_O);
    const bf16* KCB = (const bf16*)(F.ws + WS_KCCB); const float* gates = (const float*)(F.ws + WS_GATES);
    LAS unsigned* ubuf = (LAS unsigned*)(F.lds + 4 * BUFB);
    const float NINF = -__builtin_inff();
    const int x = F.vcu, bh = x >> 3, qslot = x & 7, b = bh >> 1, hkv = bh & 1;
    if (x >= 256) return;
    for (int rr = 0; rr < 4; ++rr) {
        const int qt = (rr & 1) ? 8 * rr + 7 - qslot : 8 * rr + qslot;
        const int tq = 64 * qt + 8 * w + qi; const size_t m = (size_t)b * SEQ + tq;
        const bf16* Pb = P + (size_t)b * SEQ * PW;
        {
            const int hd = hkv * 4 + g; const float slope = alibi_slope(hd);
            bf16x8 qf[4]; load_qfrag(qf, P + m * PW + hd * 64, h);
            f32x16 oT[2] = {zero16(), zero16()}, dummy = zero16(); float m_run = NINF, l_run = 0.f;
            const int first = qt >= 2 ? qt - 2 : 0;
            stream<0>(oT, dummy, m_run, l_run, qf, Pb + 512 + hkv * 64, Pb + 640 + hkv * 64, PW, first, qt - first + 1, 0u, tq, slope, 0u, 128, F.lds, tid, lane);
            float l_tot = l_run + __shfl_xor(l_run, 32); l_tot += __expf(a.in[I_SINK][hd] - m_run);
            f32x16 res[2] = {zero16(), zero16()}; fold(res, oT, 1.0f / l_tot);
            store_o(O + m * D + hd * 64, res, h);
        }
        {
            const int hb = hkv * 4 + g; const float slope = alibi_slope(8 + hb);
            bf16x8 qf[4]; load_qfrag(qf, P + m * PW + 768 + hb * 64, h);
            const float* gp = gates + m * 24 + hb * 3;
            const float g0 = sigmoidf(gp[0]), g1 = sigmoidf(gp[1]), g2 = sigmoidf(gp[2]);
            f32x16 res[2] = {zero16(), zero16()};
            unsigned selmask = 0u;
            {
                f32x16 oT[2] = {zero16(), zero16()}, imp = zero16(); float m_run = NINF, l_run = 0.f;
                const int nvc_max = (64 * qt + 63 >= 31) ? ((64 * qt + 63 - 31) / 16 + 1) : 0;
                const int ntile = nvc_max > 64 ? 2 : (nvc_max > 0 ? 1 : 0);
                stream<2>(oT, imp, m_run, l_run, qf, KCB + (size_t)(bh * 128) * 64, KCB + (size_t)4096 * 64 + (size_t)(bh * 128) * 64, 64, 0, ntile, 0u, tq, slope, 0u, 0, F.lds, tid, lane);
                const float l_tot = l_run + __shfl_xor(l_run, 32); const float inv = l_tot > 0.f ? 1.0f / l_tot : 0.f;
                fold(res, oT, g0 * inv);
                float R[32];
#pragma unroll
                for (int i = 0; i < 16; ++i) { float v = imp[i] * inv; v += __shfl_xor(v, 8); v += __shfl_xor(v, 16); const float o = __shfl_xor(v, 32);
                    const int j0 = (i & 3) + 8 * (i >> 2); R[j0] = h ? o : v; R[j0 + 4] = h ? v : o; }
                const int tb = tq >> 6;
#pragma unroll
                for (int j = 0; j < 32; ++j) R[j] = (j == 0 || j == tb || j == tb - 1) ? __builtin_inff() : (j <= tb ? R[j] : NINF);
#pragma unroll 1
                for (int rd = 0; rd < 8; ++rd) { float best = NINF; int bj = -1;
#pragma unroll
                    for (int j = 0; j < 32; ++j) { if (R[j] > best) { best = R[j]; bj = j; } }
                    if (bj >= 0) selmask |= 1u << bj;
#pragma unroll
                    for (int j = 0; j < 32; ++j) R[j] = (j == bj) ? NINF : R[j]; }
            }
            unsigned um = selmask;
#pragma unroll
            for (int o2 = 1; o2 < 64; o2 <<= 1) um |= (unsigned)__shfl_xor((int)um, o2);
            __syncthreads();
            if (lane == 0) ubuf[w] = um;
            __syncthreads();
            um = ubuf[0] | ubuf[1] | ubuf[2] | ubuf[3] | ubuf[4] | ubuf[5] | ubuf[6] | ubuf[7];
            um = (unsigned)__builtin_amdgcn_readfirstlane((int)um);
            {
                f32x16 oT[2] = {zero16(), zero16()}, dummy = zero16(); float m_run = NINF, l_run = 0.f;
                stream<1>(oT, dummy, m_run, l_run, qf, Pb + 1536 + hkv * 64, Pb + 1664 + hkv * 64, PW, 0, __builtin_popcount(um), um, tq, slope, selmask, 0, F.lds, tid, lane);
                const float l_tot = l_run + __shfl_xor(l_run, 32); fold(res, oT, g1 / l_tot);
            }
            {
                f32x16 oT[2] = {zero16(), zero16()}, dummy = zero16(); float m_run = NINF, l_run = 0.f;
                const int first = qt >= 4 ? qt - 4 : 0;
                stream<0>(oT, dummy, m_run, l_run, qf, Pb + 1792 + hkv * 64, Pb + 1920 + hkv * 64, PW, first, qt - first + 1, 0u, tq, slope, 0u, 256, F.lds, tid, lane);
                const float l_tot = l_run + __shfl_xor(l_run, 32); fold(res, oT, g2 / l_tot);
            }
            store_o(O + m * D + 512 + hb * 64, res, h);
        }
    }
}

template <int MODE>
__device__ __forceinline__ void ln_phase(Frame& F, const Args& a, const float* lg, const float* lb) {
    const int gw = F.vcu * NWAVES + F.wave, NGW = F.G * NWAVES, lane = F.lane;
    float* out = a.out; bf16* xb = (bf16*)(F.ws + WS_XB);
    f32x4 gg[4], bb[4];
#pragma unroll
    for (int j = 0; j < 4; ++j) { gg[j] = *((const f32x4*)lg + lane + 64 * j); bb[j] = *((const f32x4*)lb + lane + 64 * j); }
    for (int m = gw; m < M; m += NGW) {
        f32x4* xr = (f32x4*)(out + (size_t)m * D) + lane; f32x4 v[4]; float s = 0.f;
#pragma unroll
        for (int j = 0; j < 4; ++j) v[j] = xr[64 * j];
        if (MODE == 2) {
            const bf16* y = (const bf16*)(F.ws + WS_Y2) + (size_t)m * 2 * D;
#pragma unroll
            for (int j = 0; j < 4; ++j) { const u32x2 y0 = *((const u32x2*)y + lane + 64 * j), y1 = *((const u32x2*)(y + D) + lane + 64 * j);
                v[j][0] = ALPHA * v[j][0] + bflo(y0.x) + bflo(y1.x); v[j][1] = ALPHA * v[j][1] + bfhi(y0.x) + bfhi(y1.x);
                v[j][2] = ALPHA * v[j][2] + bflo(y0.y) + bflo(y1.y); v[j][3] = ALPHA * v[j][3] + bfhi(y0.y) + bfhi(y1.y); }
        }
#pragma unroll
        for (int j = 0; j < 4; ++j) s += (v[j][0] + v[j][1]) + (v[j][2] + v[j][3]);
        const float mean = wave_sum(s) * (1.f / D); float s2 = 0.f;
#pragma unroll
        for (int j = 0; j < 4; ++j) { v[j] = v[j] - mean; s2 += (v[j][0] * v[j][0] + v[j][1] * v[j][1]) + (v[j][2] * v[j][2] + v[j][3] * v[j][3]); }
        const float rstd = 1.f / sqrtf(wave_sum(s2) * (1.f / D) + LN_EPS);
#pragma unroll
        for (int j = 0; j < 4; ++j) { v[j] = v[j] * rstd * gg[j] + bb[j]; xr[64 * j] = v[j]; }
        if (MODE != 2) {
            unsigned long long* o8 = (unsigned long long*)(xb + (size_t)m * D) + lane;
#pragma unroll
            for (int j = 0; j < 4; ++j) o8[64 * j] = (unsigned long long)pk2(v[j][0], v[j][1]) | ((unsigned long long)pk2(v[j][2], v[j][3]) << 32);
        }
        if (MODE == 1) {
            const float* wr = a.in[I_RT]; float lg8[8];
#pragma unroll
            for (int e = 0; e < 8; ++e) lg8[e] = 0.f;
#pragma unroll
            for (int j = 0; j < 4; ++j)
#pragma unroll
                for (int i = 0; i < 4; ++i) { const float* w = wr + (size_t)(256 * j + 4 * lane + i) * 8; const f32x4 w0 = *(const f32x4*)w, w1 = *(const f32x4*)(w + 4); const float xv = v[j][i];
                    lg8[0] += xv * w0[0]; lg8[1] += xv * w0[1]; lg8[2] += xv * w0[2]; lg8[3] += xv * w0[3]; lg8[4] += xv * w1[0]; lg8[5] += xv * w1[1]; lg8[6] += xv * w1[2]; lg8[7] += xv * w1[3]; }
#pragma unroll
            for (int e = 0; e < 8; ++e) lg8[e] = wave_sum(lg8[e]);
            int e0 = 0; float v0 = lg8[0];
#pragma unroll
            for (int e = 1; e < 8; ++e) if (lg8[e] > v0) { v0 = lg8[e]; e0 = e; }
            int e1 = -1; float v1 = -__builtin_inff();
#pragma unroll
            for (int e = 0; e < 8; ++e) if (e != e0 && lg8[e] > v1) { v1 = lg8[e]; e1 = e; }
            const float g0 = 1.0f / (1.0f + __expf(v1 - v0)), g1 = 1.0f - g0;
            if (lane == 0) {
                int* rowtok = (int*)(F.ws + WS_ROWTOK); int* rowdst = (int*)(F.ws + WS_ROWDST); float* rowgate = (float*)(F.ws + WS_ROWGATE);
                const unsigned p0 = atomicAdd((unsigned*)(F.ctl + CW_CNT + 64 * e0), 1u), p1 = atomicAdd((unsigned*)(F.ctl + CW_CNT + 64 * e1), 1u);
                rowtok[e0 * CAP + p0] = m; rowdst[e0 * CAP + p0] = 2 * m; rowgate[e0 * CAP + p0] = g0;
                rowtok[e1 * CAP + p1] = m; rowdst[e1 * CAP + p1] = 2 * m + 1; rowgate[e1 * CAP + p1] = g1;
            }
        }
    }
}

__device__ __forceinline__ void p3_compress2(Frame& F, const Args& a) {
    const bf16* H1 = (const bf16*)(F.ws + WS_H1); float* KCC = (float*)(F.ws + WS_KCC);
    const int gt = blockIdx.x * NTHREADS + F.tid, NT = F.G * NTHREADS;
    for (int idx = gt; idx < 2 * 4096 * 64; idx += NT) {
        const int n = idx & 63, r = (idx >> 6) & 4095, kv = idx >> 18;
        const float* w2 = a.in[kv ? I_WV2 : I_WK2]; const bf16* h = H1 + (size_t)(kv * 4096 + r) * 256; float s = 0.f;
        for (int j8 = 0; j8 < 32; ++j8) { const u32x4 v = ((const u32x4*)h)[j8]; const float* w = w2 + (size_t)(8 * j8) * 64 + n;
            s += bflo(v.x) * w[0] + bfhi(v.x) * w[64] + bflo(v.y) * w[128] + bfhi(v.y) * w[192] + bflo(v.z) * w[256] + bfhi(v.z) * w[320] + bflo(v.w) * w[384] + bfhi(v.w) * w[448]; }
        KCC[idx] = s; ((bf16*)(F.ws + WS_KCCB))[idx] = (bf16)f2bf(s);
    }
}

__device__ __forceinline__ void p11_spatial(Frame& F, const Args& a) {
    const bf16* U = (const bf16*)(F.ws + WS_U); const bf16* V = (const bf16*)(F.ws + WS_V); bf16* Z = (bf16*)(F.ws + WS_Z);
    LAS float* Wl = (LAS float*)(F.lds); LAS float* vn = (LAS float*)(F.lds + 65536); LAS f32x2* st = (LAS f32x2*)(F.lds + LDS_STATS_OFF);
    const float* lng = a.in[I_GLNG]; const float* lnb = a.in[I_GLNB]; const float* ws_ = a.in[I_GWS]; const float* bs = a.in[I_GBS];
    const int tid = F.tid, lane = F.lane;
    for (int unit = blockIdx.x; unit < NB * 16; unit += F.G) {
        const int m0 = unit * 128;
        __syncthreads();
        for (int rr = 0; rr < 16; ++rr) { const int r = F.wave * 16 + rr; const bf16* vr = V + (size_t)(m0 + r) * D;
            const u32x4 p0 = ((const u32x4*)vr)[lane], p1 = ((const u32x4*)vr)[64 + lane]; float x[16];
            x[0] = bflo(p0.x); x[1] = bfhi(p0.x); x[2] = bflo(p0.y); x[3] = bfhi(p0.y); x[4] = bflo(p0.z); x[5] = bfhi(p0.z); x[6] = bflo(p0.w); x[7] = bfhi(p0.w);
            x[8] = bflo(p1.x); x[9] = bfhi(p1.x); x[10] = bflo(p1.y); x[11] = bfhi(p1.y); x[12] = bflo(p1.z); x[13] = bfhi(p1.z); x[14] = bflo(p1.w); x[15] = bfhi(p1.w);
            float s = 0.f;
#pragma unroll
            for (int i = 0; i < 16; ++i) s += x[i];
            const float mean = wave_sum(s) * (1.f / D); float s2 = 0.f;
#pragma unroll
            for (int i = 0; i < 16; ++i) { const float d = x[i] - mean; s2 += d * d; }
            const float rstd = 1.f / sqrtf(wave_sum(s2) * (1.f / D) + LN_EPS);
            if (lane == 0) st[r] = (f32x2){mean, rstd}; }
        __syncthreads();
        for (int g = 0; g < 8; ++g) {
            for (int i = tid; i < 128 * 32; i += NTHREADS) { const int t = i >> 5, s4 = (i & 31) * 4; f32x4 w = *(const f32x4*)(ws_ + (size_t)g * 16384 + t * 128 + s4);
                if (s4 + 0 > t) w[0] = 0.f; if (s4 + 1 > t) w[1] = 0.f; if (s4 + 2 > t) w[2] = 0.f; if (s4 + 3 > t) w[3] = 0.f; *(LAS f32x4*)(Wl + t * 128 + s4) = w; }
            { const int ch = tid & 127; const float gch = lng[g * 128 + ch], bch = lnb[g * 128 + ch];
              for (int s = tid >> 7; s < 128; s += 4) { const f32x2 ms = st[s]; vn[s * 128 + ch] = (bf2f(V[(size_t)(m0 + s) * D + g * 128 + ch]) - ms.x) * ms.y * gch + bch; } }
            __syncthreads();
            { const int ch = tid & 127, tq = tid >> 7; float acc[32];
#pragma unroll
              for (int i = 0; i < 32; ++i) acc[i] = 0.f;
              const int s4end = (tq * 32 + 32) / 4;
              for (int s4 = 0; s4 < s4end; ++s4) { const float v0 = vn[(4 * s4) * 128 + ch], v1 = vn[(4 * s4 + 1) * 128 + ch], v2 = vn[(4 * s4 + 2) * 128 + ch], v3 = vn[(4 * s4 + 3) * 128 + ch];
#pragma unroll
                  for (int i = 0; i < 32; ++i) { const f32x4 w = *(const LAS f32x4*)(Wl + (tq * 32 + i) * 128 + 4 * s4); acc[i] += w[0] * v0 + w[1] * v1 + w[2] * v2 + w[3] * v3; } }
#pragma unroll
              for (int i = 0; i < 32; ++i) { const int t = tq * 32 + i; const size_t o = (size_t)(m0 + t) * D + g * 128 + ch;
                  Z[o] = (bf16)f2bf(bf2f(U[o]) * (acc[i] + bs[g * 128 + t])); } }
            __syncthreads();
        }
    }
}

constexpr int N_PHASES = 25;
__global__ void __launch_bounds__(NTHREADS, 2) fwd(Args args) {
    extern __shared__ __attribute__((aligned(16))) unsigned char lds[];
    Frame F;
    F.lds = (LAS unsigned char*)lds; F.ws = args.ws; F.ctl = (gu32*)(args.ws + WS_CTL);
    F.tid = threadIdx.x; F.lane = F.tid & 63; F.wave = __builtin_amdgcn_readfirstlane(F.tid >> 6);
    F.G = gridDim.x; { const int bx = blockIdx.x; F.vcu = (F.G % 8 == 0) ? (bx % 8) * (F.G / 8) + bx / 8 : bx; }
    for (int u = F.tid; u < (LDS_BYTES - LDSCTL_OFF) / 4; u += NTHREADS) ((LAS unsigned*)(F.lds + LDSCTL_OFF))[u] = 0u;
    __syncthreads();
    unsigned char* ws = args.ws;
#if MK_ONE_LAUNCH
    XcdBarrier bar = xcd_barrier_post((unsigned*)(F.ctl + CW_BAR), (volatile LAS unsigned*)(F.lds + LDSCTL_OFF));
#define GRID_BAR() xcd_barrier(bar)
#else
#define GRID_BAR() do { } while (0)
#endif
    const int lo = args.ph_lo, hi = args.ph_hi;
#define IN(k) (lo <= (k) && (k) < hi)
#define SEAM(k) do { if (IN(k) && IN((k) + 1)) GRID_BAR(); } while (0)
    const int G = F.G, c = (int)blockIdx.x;
    const float* lng = args.in[I_LNG]; const float* lnb = args.in[I_LNB];

    if (IN(0)) { p0_prologue(F, args); } SEAM(0);
    if (IN(1)) { pg8::Gemm g{(const char*)(ws + WS_XB), (const char*)(ws + WS_WIN), D, 0}; pg8::StaticOrder S{M / 256, 8, G, c};
        pg8::EpiBf<0> E{(bf16*)(ws + WS_P), (bf16*)(ws + WS_KC), PW, nullptr, nullptr, nullptr}; pg8::ADense al{(unsigned)D * 2u};
        pg8::gemm_phase(F.lds, g, S, E, al); } SEAM(1);
    if (IN(2)) { pg8::Gemm g{(const char*)(ws + WS_KC), (const char*)(ws + WS_WC1), 2048, (size_t)256 * 2048 * 2}; pg8::CmpOrder S{c};
        pg8::EpiBf<1> E{(bf16*)(ws + WS_H1), nullptr, 256, (const float*)(ws + WS_SMALL), nullptr, nullptr}; pg8::ADense al{1024u * 2u};
        pg8::gemm_phase(F.lds, g, S, E, al); } SEAM(2);
    if (IN(3)) { p3_compress2(F, args); } SEAM(3);
    if (IN(4)) { p4_attention_mfma(F, args); } SEAM(4);
    if (IN(5)) { pg8::Gemm g{(const char*)(ws + WS_O), (const char*)(ws + WS_WO), D, 0}; pg8::StaticOrder S{M / 256, 4, G, c};
        pg8::EpiRes E{args.in[I_X], args.out, ALPHA}; pg8::ADense al{(unsigned)D * 2u};
        pg8::gemm_phase(F.lds, g, S, E, al); } SEAM(5);
    if (IN(6)) { ln_phase<0>(F, args, lng + 0 * D, lnb + 0 * D); } SEAM(6);
    if (IN(7)) { pg8::Gemm g{(const char*)(ws + WS_XB), (const char*)(ws + WS_FGU), D, 0}; pg8::StaticOrder S{M / 256, DFF / 128, G, c};
        pg8::EpiBf<3> E{(bf16*)(ws + WS_H), nullptr, DFF, nullptr, nullptr, nullptr}; pg8::ADense al{(unsigned)D * 2u};
        pg8::gemm_phase(F.lds, g, S, E, al); } SEAM(7);
    if (IN(8)) { pg8::Gemm g{(const char*)(ws + WS_H), (const char*)(ws + WS_FDN), DFF, 0}; pg8::StaticOrder S{M / 256, 4, G, c};
        pg8::EpiRes E{args.out, args.out, ALPHA}; pg8::ADense al{(unsigned)DFF * 2u};
        pg8::gemm_phase(F.lds, g, S, E, al); } SEAM(8);
    if (IN(9)) { ln_phase<0>(F, args, lng + 1 * D, lnb + 1 * D); } SEAM(9);
    if (IN(10)) { pg8::Gemm g{(const char*)(ws + WS_XB), (const char*)(ws + WS_GIN), D, 0}; pg8::StaticOrder S{M / 256, 8, G, c};
        pg8::EpiBf<2> E{(bf16*)(ws + WS_U), (bf16*)(ws + WS_V), D, nullptr, nullptr, nullptr}; pg8::ADense al{(unsigned)D * 2u};
        pg8::gemm_phase(F.lds, g, S, E, al); } SEAM(10);
    if (IN(11)) { p11_spatial(F, args); } SEAM(11);
    if (IN(12)) { pg8::Gemm g{(const char*)(ws + WS_Z), (const char*)(ws + WS_GOUT), D, 0}; pg8::StaticOrder S{M / 256, 4, G, c};
        pg8::EpiRes E{args.out, args.out, ALPHA}; pg8::ADense al{(unsigned)D * 2u};
        pg8::gemm_phase(F.lds, g, S, E, al); } SEAM(12);
    if (IN(13)) { ln_phase<1>(F, args, lng + 2 * D, lnb + 2 * D); } SEAM(13);
    {
        LAS int* tab = (LAS int*)(F.lds + LDS_MOE_OFF);
        if (hi > 14 && lo < 24) {
            __syncthreads();
            if (F.tid == 0) { int ts = 0;
                for (int e = 0; e < 8; ++e) { int n = (int)__hip_atomic_load(F.ctl + CW_CNT + 64 * e, __ATOMIC_RELAXED, __HIP_MEMORY_SCOPE_AGENT); if (n > CAP) n = CAP; tab[e] = n; tab[8 + e] = ts; ts += (n + 255) >> 8; }
                tab[16] = ts; }
            __syncthreads();
        }
        const int T = tab[16];
#pragma unroll 1
        for (int ch = 0; ch < 5; ++ch) {
            const int tile0 = 64 * ch; int nM = T - tile0; nM = nM < 0 ? 0 : (nM > 64 ? 64 : nM);
            nM = __builtin_amdgcn_readfirstlane(nM);
            if (IN(14 + 2 * ch)) { pg8::Gemm g{(const char*)(ws + WS_XB), (const char*)(ws + WS_MGU), D, (size_t)2 * DFE * D * 2}; pg8::MoeOrder S{nM, DFE / 128, G, c, tile0, tab};
                pg8::EpiBf<3> E{(bf16*)(ws + WS_HM), nullptr, DFE, nullptr, nullptr, nullptr}; pg8::AGather al{(const int*)(ws + WS_ROWTOK), (unsigned)D * 2u};
                pg8::gemm_phase(F.lds, g, S, E, al); }
            SEAM(14 + 2 * ch);
            if (IN(15 + 2 * ch)) { pg8::Gemm g{(const char*)(ws + WS_HM), (const char*)(ws + WS_MDN), DFE, (size_t)D * DFE * 2}; pg8::MoeOrder S{nM, 4, G, c, tile0, tab};
                pg8::EpiBf<4> E{(bf16*)(ws + WS_Y2), nullptr, D, nullptr, (const int*)(ws + WS_ROWDST), (const float*)(ws + WS_ROWGATE)}; pg8::ADense al{(unsigned)DFE * 2u};
                pg8::gemm_phase(F.lds, g, S, E, al); }
            SEAM(15 + 2 * ch);
        }
    }
    if (IN(24)) { ln_phase<2>(F, args, lng + 3 * D, lnb + 3 * D); }
#undef IN
#undef SEAM
}

extern "C" void kernel_launch(void* const* d_in, const int* in_sizes, int n_in, void* d_out, int out_size, void* d_ws, size_t ws_size, hipStream_t stream) {
    static int grid = 0;
    if (grid == 0) {
        if (n_in != 25 || in_sizes[0] != M * D || out_size != M * D || ws_size < WS_END) { fprintf(stderr, "kernel_launch: unexpected shapes (n_in %d, in0 %d, out %d, ws %zu); nothing launched\n", n_in, n_in > 0 ? in_sizes[0] : -1, out_size, ws_size); grid = -1; return; }
        int dev = 0, cus = 0, per_cu = 0;
        if (hipGetDevice(&dev) != hipSuccess || hipDeviceGetAttribute(&cus, hipDeviceAttributeMultiprocessorCount, dev) != hipSuccess) { grid = -1; return; }
        if (hipFuncSetAttribute((const void*)fwd, hipFuncAttributeMaxDynamicSharedMemorySize, LDS_BYTES) != hipSuccess) { fprintf(stderr, "kernel_launch: hipFuncSetAttribute failed\n"); grid = -1; return; }
        if (hipOccupancyMaxActiveBlocksPerMultiprocessor(&per_cu, (const void*)fwd, NTHREADS, LDS_BYTES) != hipSuccess || per_cu < 1) fprintf(stderr, "kernel_launch: occupancy query reports %d\n", per_cu);
        (void)hipGetLastError();
        grid = cus;
    }
    if (grid < 0) return;
    if (hipMemsetAsync((char*)d_ws + WS_CTL, 0, CTL_ZERO_BYTES, stream) != hipSuccess) return;
    Args a{};
    for (int i = 0; i < 25; ++i) a.in[i] = (const float*)d_in[i];
    a.out = (float*)d_out; a.ws = (unsigned char*)d_ws;
#if MK_ONE_LAUNCH
    a.ph_lo = 0; a.ph_hi = N_PHASES;
    hipLaunchKernelGGL(fwd, dim3(grid), dim3(NTHREADS), LDS_BYTES, stream, a);
#else
    for (int p = 0; p < N_PHASES; ++p) { a.ph_lo = p; a.ph_hi = p + 1; hipLaunchKernelGGL(fwd, dim3(grid), dim3(NTHREADS), LDS_BYTES, stream, a); }
#endif
}
```

```cpp
#include <hip/hip_runtime.h>
#include <cstdio>
#include <cstdint>

#ifndef REP_ATT
#define REP_ATT 1
#endif
#ifndef REP_SPA
#define REP_SPA 1
#endif
#ifndef REP_PRO
#define REP_PRO 1
#endif
#ifndef MK_ONE_LAUNCH
#define MK_ONE_LAUNCH 1
#endif

#define LAS __attribute__((address_space(3)))
#define GAS __attribute__((address_space(1)))
typedef unsigned short bf16;
typedef short bf16x8 __attribute__((ext_vector_type(8)));
typedef float f32x4 __attribute__((ext_vector_type(4)));
typedef float f32x2 __attribute__((ext_vector_type(2)));
typedef unsigned u32x4 __attribute__((ext_vector_type(4)));
typedef unsigned u32x2 __attribute__((ext_vector_type(2)));
typedef GAS unsigned gu32;

constexpr int NB = 16, SEQ = 2048, D = 1024, M = NB * SEQ;
constexpr int PW = 2048;
constexpr int INW = 2072;
constexpr int DFF = 2816, DFE = 3584, NEXP = 8, CAP = 32768;
constexpr int NCMP = 127;
constexpr float ALPHA = 1.4142135623730951f;
constexpr float LN_EPS = 1e-5f;
constexpr int NWAVES = 8, NTHREADS = 512;

constexpr size_t MiB = 1u << 20;
constexpr size_t WS_CTL = 0, CTL_ZERO_BYTES = 1 * MiB;
constexpr size_t WS_SMALL = 1 * MiB;
constexpr size_t WS_ROWTOK = 2 * MiB, WS_ROWDST = 3 * MiB, WS_ROWGATE = 4 * MiB;
constexpr size_t WS_WIN = 5 * MiB;
constexpr size_t WS_WC1 = 9 * MiB;
constexpr size_t WS_WO = 11 * MiB;
constexpr size_t WS_FGU = 13 * MiB;
constexpr size_t WS_FDN = 24 * MiB;
constexpr size_t WS_GIN = 30 * MiB;
constexpr size_t WS_GOUT = 34 * MiB;
constexpr size_t WS_MGU = 36 * MiB;
constexpr size_t WS_MDN = 148 * MiB;
constexpr size_t WS_XB = 204 * MiB;
constexpr size_t WS_BIG = 268 * MiB;
constexpr size_t WS_P = WS_BIG;
constexpr size_t WS_O = WS_BIG + 128 * MiB;
constexpr size_t WS_H = WS_BIG;
constexpr size_t WS_U = WS_BIG, WS_V = WS_BIG + 64 * MiB, WS_Z = WS_BIG + 128 * MiB;
constexpr size_t WS_HM = WS_BIG;
constexpr size_t WS_Y2 = WS_BIG + 112 * MiB;
constexpr size_t WS_GATES = 460 * MiB;
constexpr size_t WS_KC = 463 * MiB;
constexpr size_t WS_H1 = 480 * MiB;
constexpr size_t WS_KCC = 484 * MiB;
constexpr size_t WS_KCCB = 486 * MiB;
constexpr size_t WS_END = 508 * MiB;
static_assert(WS_Y2 + 128 * MiB <= WS_END && WS_H + (size_t)M * DFF * 2 <= WS_GATES && WS_KC + 17 * MiB <= WS_H1, "ws map");
constexpr int CW_BAR = 4096;
constexpr int CW_CNT = 16384;

constexpr int RING_BYTES = 131072;
constexpr int LDSCTL_OFF = RING_BYTES;
constexpr int LDS_STATS_OFF = RING_BYTES + 1024;
constexpr int LDS_MOE_OFF = RING_BYTES + 4096;
constexpr int LDS_BYTES = 147456;

#define LDS_WAIT() asm volatile("s_waitcnt lgkmcnt(0)" ::: "memory")
#define VM_WAIT() asm volatile("s_waitcnt vmcnt(0)" ::: "memory")
__device__ __forceinline__ unsigned f2bf(float f) { unsigned u = __builtin_bit_cast(unsigned, f); return (u + 0x7fffu + ((u >> 16) & 1u)) >> 16; }
__device__ __forceinline__ unsigned pk2(float lo, float hi) { return f2bf(lo) | (f2bf(hi) << 16); }
__device__ __forceinline__ float bflo(unsigned u) { return __builtin_bit_cast(float, u << 16); }
__device__ __forceinline__ float bfhi(unsigned u) { return __builtin_bit_cast(float, u & 0xffff0000u); }
__device__ __forceinline__ float bf2f(bf16 b) { return __builtin_bit_cast(float, (unsigned)b << 16); }
__device__ __forceinline__ float wave_sum(float v) {
#pragma unroll
    for (int o = 1; o < 64; o <<= 1) v += __shfl_xor(v, o);
    return v;
}
__device__ __forceinline__ float wave_max(float v) {
#pragma unroll
    for (int o = 1; o < 64; o <<= 1) v = fmaxf(v, __shfl_xor(v, o));
    return v;
}
__device__ __forceinline__ float gelu_tanh(float x) {
    const float u = 0.7978845608028654f * (x + 0.044715f * x * x * x);
    return x / (1.0f + __expf(-2.0f * u));
}
__device__ __forceinline__ float silu(float x) { return x / (1.0f + __expf(-x)); }
__device__ __forceinline__ float sigmoidf(float x) { return 1.0f / (1.0f + __expf(-x)); }

namespace pg8 {
constexpr int BM = 256, BK = 64, HALF = 128, HTB = HALF * BK * 2, STAGE_BYTES = 8 * HTB, NXCD = 8, WGM = 8;
__host__ __device__ __forceinline__ int lds_byte(int r, int c) { const int st = (r >> 4) * 2 + (c >> 5), rr = r & 15, cc = c & 31, ob = rr * 64 + cc * 2; return st * 1024 + (ob ^ (((ob >> 9) & 1) << 5)); }
__host__ __device__ __forceinline__ void stage_rc(int b, int& R, int& C) { const int st = b / 1024, sb = b % 1024, swz = sb ^ (((sb >> 9) & 1) << 5); R = (st >> 1) * 16 + swz / 64; C = (st & 1) * 32 + (swz % 64) / 2; }
__host__ __device__ __forceinline__ int perm32(int rho) { const int n = rho >> 4, i = rho & 15; return 8 * (i >> 2) + 4 * n + (i & 3); }

struct Unit { int pm, pn, e, te, ne; };
struct Gemm { const char* A; const char* Bt; int K; size_t eStrideB; };

struct ADense { unsigned pitchB; __device__ __forceinline__ unsigned operator()(const Unit& u, int R) const { return (unsigned)(u.pm * 256 + R) * pitchB; } };
struct AGather { const int* rowtok; unsigned pitchB;
    __device__ __forceinline__ unsigned operator()(const Unit& u, int R) const { const int ri = u.te * 256 + R; const int tok = ri < u.ne ? rowtok[u.e * CAP + ri] : 0; return (unsigned)tok * pitchB; } };

__device__ __forceinline__ bool static_unit(int i, int G, int c, int nM, int nN, int& pm, int& pn) {
    const int nwg = nM * nN; const long L = (long)i * G + c; if (L >= nwg) return false;
    int wgid = (int)L; { const int q = nwg / NXCD, r = nwg % NXCD, xcd = wgid % NXCD, off = wgid / NXCD; wgid = (xcd < r ? xcd * (q + 1) : r * (q + 1) + (xcd - r) * q) + off; }
    const int nig = WGM * nN, gid = wgid / nig, fm = gid * WGM, gsz = (nM - fm) < WGM ? (nM - fm) : WGM;
    pm = fm + ((wgid % nig) % gsz); pn = (wgid % nig) / gsz; return true;
}
struct StaticOrder { int nM, nN, G, c;
    __device__ __forceinline__ bool next(int i, Unit& u) const { u.e = 0; u.te = 0; u.ne = 0; return static_unit(i, G, c, nM, nN, u.pm, u.pn); } };
struct CmpOrder { int c;
    __device__ __forceinline__ bool next(int i, Unit& u) const { if (i > 0 || c >= 32) return false; u.pm = c; u.pn = 0; u.e = c >> 4; u.te = 0; u.ne = 0; return true; } };
struct MoeOrder { int nM, nN, G, c, tile0; const LAS int* tab;
    __device__ __forceinline__ bool next(int i, Unit& u) const {
        int pm, pn; if (!static_unit(i, G, c, nM, nN, pm, pn)) return false;
        const int ct = tile0 + pm; int e = 0;
#pragma unroll
        for (int k = 1; k < 8; ++k) e += (ct >= tab[8 + k]) ? 1 : 0;
        e = __builtin_amdgcn_readfirstlane(e);
        u.pm = pm; u.pn = pn; u.e = e; u.te = __builtin_amdgcn_readfirstlane(ct - tab[8 + e]); u.ne = __builtin_amdgcn_readfirstlane(tab[e]); return true; } };

__device__ __forceinline__ u32x4 pack8(const f32x4& a, const f32x4& b) { u32x4 w; w.x = pk2(a[0], a[1]); w.y = pk2(a[2], a[3]); w.z = pk2(b[0], b[1]); w.w = pk2(b[2], b[3]); return w; }

struct EpiRes {
    static constexpr bool PERM = false;
    const float* res; float* out; float alpha;
    __device__ __forceinline__ void operator()(const f32x4 (&acc)[2][2][4][2], const Unit& u, int wr, int wc, int fr, int fq) const {
        const int row0 = u.pm * BM + wr * 64 + fr, col0 = u.pn * BM + wc * 32 + 4 * fq;
#pragma unroll
        for (int ai = 0; ai < 2; ++ai)
#pragma unroll
            for (int m = 0; m < 4; ++m) { const size_t off = (size_t)(row0 + ai * HALF + m * 16) * D + col0;
#pragma unroll
                for (int bj = 0; bj < 2; ++bj)
#pragma unroll
                    for (int n = 0; n < 2; ++n) { const size_t o = off + bj * HALF + n * 16; const f32x4 r = *(const f32x4*)(res + o); *(f32x4*)(out + o) = acc[ai][bj][m][n] + alpha * r; } }
    }
};
template <int MODE> struct EpiBf {
    static constexpr bool PERM = true;
    bf16* O; bf16* O2; int ldc; const float* bias; const int* rowdst; const float* rowgate;
    __device__ __forceinline__ void operator()(const f32x4 (&acc)[2][2][4][2], const Unit& u, int wr, int wc, int fr, int fq) const {
        const int lr0 = wr * 64 + fr, ct = wc * 32 + 8 * fq;
#pragma unroll
        for (int ai = 0; ai < 2; ++ai)
#pragma unroll
            for (int m = 0; m < 4; ++m) {
                const int lr = lr0 + ai * HALF + m * 16; const int row = u.pm * BM + lr;
                if (MODE == 0) {
#pragma unroll
                    for (int bj = 0; bj < 2; ++bj) { const u32x4 w = pack8(acc[ai][bj][m][0], acc[ai][bj][m][1]);
                        *(u32x4*)(O + (size_t)row * PW + u.pn * BM + bj * HALF + ct) = w;
                        if (u.pn == 5) { const int b = row >> 11, t = row & 2047, hh = wc >> 1, d = (wc & 1) * 32 + 8 * fq;
                            *(u32x4*)(O2 + ((size_t)((bj * 32 + b * 2 + hh) * 2048 + t)) * 64 + d) = w; } }
                } else if (MODE == 1) {
#pragma unroll
                    for (int bj = 0; bj < 2; ++bj) { const int col = bj * HALF + ct; const float* bp = bias + u.e * 256 + col;
                        const f32x4 b0 = *(const f32x4*)bp, b1 = *(const f32x4*)(bp + 4); f32x4 v0 = acc[ai][bj][m][0] + b0, v1 = acc[ai][bj][m][1] + b1;
#pragma unroll
                        for (int j = 0; j < 4; ++j) { v0[j] = gelu_tanh(v0[j]); v1[j] = gelu_tanh(v1[j]); }
                        *(u32x4*)(O + (size_t)row * 256 + col) = pack8(v0, v1); }
                } else if (MODE == 2) {
                    bf16* dst = (u.pn < 4) ? O : O2;
#pragma unroll
                    for (int bj = 0; bj < 2; ++bj) { f32x4 v0 = acc[ai][bj][m][0], v1 = acc[ai][bj][m][1];
#pragma unroll
                        for (int j = 0; j < 4; ++j) { v0[j] = gelu_tanh(v0[j]); v1[j] = gelu_tanh(v1[j]); }
                        *(u32x4*)(dst + (size_t)row * D + (u.pn & 3) * BM + bj * HALF + ct) = pack8(v0, v1); }
                } else if (MODE == 3) {
                    f32x4 v0, v1;
#pragma unroll
                    for (int j = 0; j < 4; ++j) { v0[j] = silu(acc[ai][0][m][0][j]) * acc[ai][1][m][0][j]; v1[j] = silu(acc[ai][0][m][1][j]) * acc[ai][1][m][1][j]; }
                    *(u32x4*)(O + (size_t)row * ldc + u.pn * HALF + ct) = pack8(v0, v1);
                } else {
                    const int gi = u.te * 256 + lr;
                    if (gi < u.ne) { const int dst = rowdst[u.e * CAP + gi]; const float gt = rowgate[u.e * CAP + gi];
#pragma unroll
                        for (int bj = 0; bj < 2; ++bj) { const f32x4 v0 = acc[ai][bj][m][0] * gt, v1 = acc[ai][bj][m][1] * gt;
                            *(u32x4*)(O + (size_t)dst * D + u.pn * BM + bj * HALF + ct) = pack8(v0, v1); } }
                }
            }
    }
};

template <class Epi, class Sched, class AL>
__device__ __forceinline__ void gemm_phase(LAS unsigned char* lds, const Gemm g, const Sched& S, const Epi& E, const AL& al) {
    const int tid = threadIdx.x, wid = __builtin_amdgcn_readfirstlane(tid >> 6), lane = tid & 63, wr = wid >> 2, wc = wid & 3, fr = lane & 15, fq = lane >> 4;
    const int K = g.K, nt = K / BK;
    int Rs[2]; unsigned Cb[2], voffB[2];
#pragma unroll
    for (int i = 0; i < 2; ++i) { int R, C; stage_rc(tid * 16 + i * 8192, R, C); const int Rb = Epi::PERM ? ((R & ~31) + perm32(R & 31)) : R;
        Rs[i] = R; Cb[i] = (unsigned)C * 2u; voffB[i] = (unsigned)(Rb * K + C) * 2u; }
    const size_t kstep = (size_t)(BK * 2);
    const size_t hstepB = (size_t)HALF * K * 2;
    const size_t tstepB = 2 * hstepB;
    const unsigned ldsw = (unsigned)wid * 1024u;
    const int aoff = lds_byte(wr * 64 + fr, fq * 8), boff = lds_byte(wc * 32 + fr, fq * 8);
#define PG8_SA(b, h) (((b) * 2 + (h)) * HTB)
#define PG8_SB(b, h) ((4 + (b) * 2 + (h)) * HTB)
#define PG8_STAGE(bufoff, gbase, voff) do { _Pragma("unroll") for (int _i = 0; _i < 2; ++_i) \
        __builtin_amdgcn_global_load_lds((const unsigned*)((const char*)(gbase) + (voff)[_i]), (LAS unsigned*)(lds + (bufoff) + ldsw + _i * 8192), 16, 0, 0); } while (0)
#define PG8_LDA(dst, b, h) do { _Pragma("unroll") for (int m = 0; m < 4; ++m) _Pragma("unroll") for (int k = 0; k < 2; ++k) dst[m][k] = *(const LAS bf16x8*)(lds + PG8_SA(b, h) + aoff + m * 2048 + k * 1024); } while (0)
#define PG8_LDB(dst, b, h) do { _Pragma("unroll") for (int n = 0; n < 2; ++n) _Pragma("unroll") for (int k = 0; k < 2; ++k) dst[n][k] = *(const LAS bf16x8*)(lds + PG8_SB(b, h) + boff + n * 2048 + k * 1024); } while (0)
#define PG8_MMA(ai, bj, At, Bt) do { __builtin_amdgcn_s_setprio(1); _Pragma("unroll") for (int m = 0; m < 4; ++m) _Pragma("unroll") for (int n = 0; n < 2; ++n) _Pragma("unroll") for (int k = 0; k < 2; ++k) \
        acc[ai][bj][m][n] = __builtin_amdgcn_mfma_f32_16x16x32_bf16(Bt[n][k], At[m][k], acc[ai][bj][m][n], 0, 0, 0); __builtin_amdgcn_s_setprio(0); } while (0)
#define PG8_WAIT_V(n) asm volatile("s_waitcnt vmcnt(" #n ")" ::: "memory")
#define PG8_WAIT_L(n) asm volatile("s_waitcnt lgkmcnt(" #n ")" ::: "memory")
#define PG8_BAR __builtin_amdgcn_s_barrier()
#define PG8_SCHED __builtin_amdgcn_sched_barrier(0)
#define PG8_VOFF(dst, u) do { _Pragma("unroll") for (int _h = 0; _h < 2; ++_h) _Pragma("unroll") for (int _i = 0; _i < 2; ++_i) dst[_h][_i] = al(u, _h * HALF + Rs[_i]) + Cb[_i]; } while (0)
    Unit cur, nxt; int ui = 0;
    if (!S.next(0, cur)) return;
    f32x4 acc[2][2][4][2];
#pragma unroll
    for (int a = 0; a < 2; ++a)
#pragma unroll
        for (int b = 0; b < 2; ++b)
#pragma unroll
            for (int m = 0; m < 4; ++m)
#pragma unroll
                for (int n = 0; n < 2; ++n) acc[a][b][m][n] = (f32x4){0.f, 0.f, 0.f, 0.f};
    bf16x8 At[4][2], B0[2][2], B1[2][2];
    unsigned vC[2][2], vP[2][2], vN[2][2];
    PG8_VOFF(vC, cur);
#pragma unroll
    for (int h = 0; h < 2; ++h)
#pragma unroll
        for (int i = 0; i < 2; ++i) vP[h][i] = vC[h][i];
    const char* const A0 = g.A;
    const char* cB = g.Bt + (size_t)cur.e * g.eStrideB + (size_t)cur.pn * tstepB;
    PG8_STAGE(PG8_SB(0, 0), cB, voffB); PG8_STAGE(PG8_SB(0, 1), cB + hstepB, voffB); PG8_STAGE(PG8_SA(0, 0), A0, vC[0]); PG8_STAGE(PG8_SA(0, 1), A0, vC[1]);
    if (wr == 1) PG8_BAR;
    PG8_WAIT_V(2); PG8_BAR;
    PG8_STAGE(PG8_SB(1, 0), cB + kstep, voffB); PG8_STAGE(PG8_SA(1, 0), A0 + kstep, vC[0]); PG8_STAGE(PG8_SB(1, 1), cB + hstepB + kstep, voffB);
    PG8_WAIT_V(6); PG8_BAR;
    for (;;) {
        const bool has_next = S.next(ui + 1, nxt);
        const char* nB = cB;
        if (has_next) { PG8_VOFF(vN, nxt); nB = g.Bt + (size_t)nxt.e * g.eStrideB + (size_t)nxt.pn * tstepB; }
        else {
#pragma unroll
            for (int h = 0; h < 2; ++h)
#pragma unroll
                for (int i = 0; i < 2; ++i) vN[h][i] = vC[h][i]; }
        for (int t = 0; t < nt; t += 2) {
            const bool last = (t == nt - 2);
            if (last) {
#pragma unroll
                for (int h = 0; h < 2; ++h)
#pragma unroll
                    for (int i = 0; i < 2; ++i) vP[h][i] = vN[h][i]; }
            const char* a1 = A0 + (size_t)(t + 1) * kstep;
            const char* a2 = last ? A0 : A0 + (size_t)(t + 2) * kstep; const char* b2 = last ? nB : cB + (size_t)(t + 2) * kstep;
            const char* a3 = a2 + kstep; const char* b3 = b2 + kstep;
            PG8_LDB(B0, 0, 0); PG8_LDB(B1, 0, 1); PG8_SCHED; PG8_LDA(At, 0, 0); PG8_STAGE(PG8_SA(1, 1), a1, vC[1]);
            PG8_WAIT_V(8); PG8_WAIT_L(0); PG8_BAR; PG8_MMA(0, 0, At, B0); PG8_MMA(0, 1, At, B1); PG8_BAR; PG8_SCHED;
            PG8_LDA(At, 0, 1); PG8_STAGE(PG8_SB(0, 0), b2, voffB); PG8_STAGE(PG8_SB(0, 1), b2 + hstepB, voffB); PG8_STAGE(PG8_SA(0, 0), a2, vP[0]);
            PG8_WAIT_V(8); PG8_WAIT_L(0); PG8_BAR; PG8_MMA(1, 0, At, B0); PG8_MMA(1, 1, At, B1); PG8_BAR; PG8_SCHED;
            PG8_LDB(B0, 1, 0); PG8_LDB(B1, 1, 1); PG8_SCHED; PG8_LDA(At, 1, 0); PG8_STAGE(PG8_SA(0, 1), a2, vP[1]);
            PG8_WAIT_V(8); PG8_WAIT_L(0); PG8_BAR; PG8_MMA(0, 0, At, B0); PG8_MMA(0, 1, At, B1); PG8_BAR; PG8_SCHED;
            PG8_LDA(At, 1, 1); PG8_STAGE(PG8_SB(1, 0), b3, voffB); PG8_STAGE(PG8_SB(1, 1), b3 + hstepB, voffB); PG8_STAGE(PG8_SA(1, 0), a3, vP[0]);
            PG8_WAIT_V(8); PG8_WAIT_L(0); PG8_BAR; PG8_MMA(1, 0, At, B0); PG8_MMA(1, 1, At, B1); PG8_BAR; PG8_SCHED;
        }
        if (wr == 0) PG8_BAR;
        E(acc, cur, wr, wc, fr, fq);
        if (!has_next) break;
#pragma unroll
        for (int a = 0; a < 2; ++a)
#pragma unroll
            for (int b = 0; b < 2; ++b)
#pragma unroll
                for (int m = 0; m < 4; ++m)
#pragma unroll
                    for (int n = 0; n < 2; ++n) acc[a][b][m][n] = (f32x4){0.f, 0.f, 0.f, 0.f};
        cur = nxt; cB = nB; ++ui;
#pragma unroll
        for (int h = 0; h < 2; ++h)
#pragma unroll
            for (int i = 0; i < 2; ++i) vC[h][i] = vP[h][i];
        if (wr == 1) PG8_BAR;
    }
    PG8_WAIT_V(0);
    PG8_BAR;
#undef PG8_SA
#undef PG8_SB
#undef PG8_STAGE
#undef PG8_LDA
#undef PG8_LDB
#undef PG8_MMA
#undef PG8_WAIT_V
#undef PG8_WAIT_L
#undef PG8_BAR
#undef PG8_SCHED
#undef PG8_VOFF
}
}

#define XB_TMO      128
#define XB_XCNT(j)  (256  + 64 * (j))
#define XB_XSUB(j)  (1280 + 64 * (j))
#define XB_XGEN(j)  (2304 + 64 * (j))
#define XB_TOP      3328
#define XB_TOPGEN   3392
#define XCD_BAR_WORDS 3456
#define XB_SPIN_CAP (1u << 18)
__device__ __forceinline__ unsigned xb_ld(unsigned* p)              { return __hip_atomic_load(p, __ATOMIC_RELAXED, __HIP_MEMORY_SCOPE_AGENT); }
__device__ __forceinline__ unsigned xb_add(unsigned* p, unsigned v) { return __hip_atomic_fetch_add(p, v, __ATOMIC_RELAXED, __HIP_MEMORY_SCOPE_AGENT); }
__device__ __forceinline__ unsigned xb_xcc_id() { return (unsigned)__builtin_amdgcn_s_getreg((3 << 11) | 20) & 0xFu; }
#define XB_SPIN(cond, bar) do { unsigned _sp = 0; while (cond) { __builtin_amdgcn_s_sleep(1); \
    if ((++_sp & 255u) == 0u) { if (xb_ld(&(bar)[XB_TMO])) break; if (_sp > XB_SPIN_CAP) { atomicAdd(&(bar)[XB_TMO], 1u); break; } } } } while (0)
struct XcdBarrier { unsigned* bar; unsigned x; volatile LAS unsigned* st; };
__device__ __forceinline__ XcdBarrier xcd_barrier_post(unsigned* bar, volatile LAS unsigned* st) {
    XcdBarrier b; b.bar = bar; b.x = xb_xcc_id(); b.st = st;
    if (threadIdx.x == 0) (void)xb_add(&bar[XB_XCNT(b.x)], 1u);
    return b;
}
__device__ __forceinline__ void xcd_barrier_complete(unsigned* bar, unsigned x, unsigned& nloc, unsigned& nx) {
    const unsigned G = gridDim.x * gridDim.y * gridDim.z;
    unsigned sum, cnt, mine, sp = 0u;
    for (;;) {
        sum = 0u; cnt = 0u; mine = 0u;
#pragma unroll
        for (unsigned j = 0; j < 16; ++j) { const unsigned c = xb_ld(&bar[XB_XCNT(j)]); sum += c; cnt += (c > 0u) ? 1u : 0u; mine = (j == x) ? c : mine; }
        if (sum == G) break;
        __builtin_amdgcn_s_sleep(1);
        if ((++sp & 255u) == 0u) { if (xb_ld(&bar[XB_TMO])) break; if (sp > XB_SPIN_CAP) { atomicAdd(&bar[XB_TMO], 1u); break; } }
    }
    nloc = mine > 0u ? mine : 1u; nx = cnt > 0u ? cnt : 1u;
}
__device__ __forceinline__ void xcd_barrier(const XcdBarrier& b) {
    asm volatile("s_waitcnt vmcnt(0)" ::: "memory");
    __syncthreads();
    if (threadIdx.x == 0) {
        unsigned* bar = b.bar;
        __builtin_amdgcn_s_waitcnt(0);
        unsigned nloc = b.st[0], nx = b.st[1];
        if (nloc == 0u) { xcd_barrier_complete(bar, b.x, nloc, nx); b.st[0] = nloc; b.st[1] = nx; }
        const unsigned old = xb_add(&bar[XB_XSUB(b.x)], 1u);
        const unsigned gen = old / nloc;
        if (old + 1u == (gen + 1u) * nloc) {
            __builtin_amdgcn_fence(__ATOMIC_RELEASE, "agent");
            asm volatile("s_waitcnt vmcnt(0)" ::: "memory");
            const unsigned og = xb_add(&bar[XB_TOP], 1u);
            const unsigned tg = og / nx;
            if (og + 1u == (tg + 1u) * nx) xb_add(&bar[XB_TOPGEN], 1u);
            else XB_SPIN(xb_ld(&bar[XB_TOPGEN]) == tg, bar);
            __builtin_amdgcn_fence(__ATOMIC_ACQUIRE, "agent");
            xb_add(&bar[XB_XGEN(b.x)], 1u);
            asm volatile("s_waitcnt vmcnt(0)" ::: "memory");
        } else {
            XB_SPIN(xb_ld(&bar[XB_XGEN(b.x)]) == gen, bar);
            __builtin_amdgcn_fence(__ATOMIC_ACQUIRE, "agent");
            asm volatile("s_waitcnt vmcnt(0)" ::: "memory");
        }
    }
    __syncthreads();
}

struct Args {
    const float* in[25]; float* out; unsigned char* ws; int ph_lo, ph_hi;
};
struct Frame {
    LAS unsigned char* lds; gu32* ctl; unsigned char* ws;
    int tid, lane, wave, vcu, G;
};
enum { I_X = 0, I_WIN, I_SINK, I_PEK, I_WK1, I_WK2, I_PEV, I_WV1, I_WV2, I_WO, I_FG, I_FU, I_FD, I_GIN, I_GLNG, I_GLNB, I_GWS, I_GBS, I_GOUT, I_RT, I_MG, I_MU, I_MD, I_LNG, I_LNB };

__device__ __forceinline__ void tr_item(const float* W, int pitch, int k0, int n0, bf16* dst, int ldk, LAS float* scr, int lane) {
#pragma unroll 8
    for (int i = 0; i < 32; ++i) { const int kk = 2 * i + (lane >> 5); scr[kk * 33 + (lane & 31)] = W[(size_t)(k0 + kk) * pitch + n0 + (lane & 31)]; }
    LDS_WAIT(); asm volatile("" ::: "memory");
    const int c = lane & 7;
#pragma unroll
    for (int j = 0; j < 4; ++j) { const int n = (lane >> 3) + 8 * j; const LAS float* s = scr + (8 * c) * 33 + n;
        u32x4 o; o.x = pk2(s[0 * 33], s[1 * 33]); o.y = pk2(s[2 * 33], s[3 * 33]); o.z = pk2(s[4 * 33], s[5 * 33]); o.w = pk2(s[6 * 33], s[7 * 33]);
        *(u32x4*)(dst + (size_t)n * ldk + 8 * c) = o; }
    LDS_WAIT(); asm volatile("" ::: "memory");
}
__device__ __forceinline__ void tr_matrix_item(const float* W, int pitch, int K, int N, bf16* WT, int inter_up  , LAS float* scr, int item, int lane) {
    const int nblk = N / 32, kb = item / nblk, nb = item % nblk, k0 = 64 * kb, n0 = 32 * nb;
    const int drow = inter_up < 0 ? n0 : ((n0 >> 7) * 256 + (n0 & 127) + inter_up * 128);
    tr_item(W, pitch, k0, n0, WT + (size_t)drow * K + k0, K, scr, lane);
}

__device__ __forceinline__ void p0_prologue(Frame& F, const Args& a) {
    LAS float* scr = (LAS float*)(F.lds + F.wave * 16384);
    const int gw = F.vcu * NWAVES + F.wave, NGW = F.G * NWAVES;
    unsigned char* ws = F.ws;
    constexpr int IT_WIN = (D / 64) * (2048 / 32), IT_C1 = (2048 / 64) * (256 / 32), IT_SQ = (D / 64) * (D / 32), IT_FG = (D / 64) * (DFF / 32), IT_FD = (DFF / 64) * (D / 32),
                  IT_GIN = (D / 64) * (2048 / 32), IT_MG = (D / 64) * (DFE / 32), IT_MD = (DFE / 64) * (D / 32);
    constexpr int NITEMS = IT_WIN + 2 * IT_C1 + IT_SQ + 2 * IT_FG + IT_FD + IT_GIN + IT_SQ + NEXP * (2 * IT_MG + IT_MD);
    for (int it = gw; it < NITEMS; it += NGW) {
        int r = it;
        if (r < IT_WIN) { tr_matrix_item(a.in[I_WIN], INW, D, 2048, (bf16*)(ws + WS_WIN), -1, scr, r, F.lane); continue; } r -= IT_WIN;
        if (r < IT_C1) { tr_matrix_item(a.in[I_WK1], 256, 2048, 256, (bf16*)(ws + WS_WC1), -1, scr, r, F.lane); continue; } r -= IT_C1;
        if (r < IT_C1) { tr_matrix_item(a.in[I_WV1], 256, 2048, 256, (bf16*)(ws + WS_WC1) + 256 * 2048, -1, scr, r, F.lane); continue; } r -= IT_C1;
        if (r < IT_SQ) { tr_matrix_item(a.in[I_WO], D, D, D, (bf16*)(ws + WS_WO), -1, scr, r, F.lane); continue; } r -= IT_SQ;
        if (r < IT_FG) { tr_matrix_item(a.in[I_FG], DFF, D, DFF, (bf16*)(ws + WS_FGU), 0, scr, r, F.lane); continue; } r -= IT_FG;
        if (r < IT_FG) { tr_matrix_item(a.in[I_FU], DFF, D, DFF, (bf16*)(ws + WS_FGU), 1, scr, r, F.lane); continue; } r -= IT_FG;
        if (r < IT_FD) { tr_matrix_item(a.in[I_FD], D, DFF, D, (bf16*)(ws + WS_FDN), -1, scr, r, F.lane); continue; } r -= IT_FD;
        if (r < IT_GIN) { tr_matrix_item(a.in[I_GIN], 2048, D, 2048, (bf16*)(ws + WS_GIN), -1, scr, r, F.lane); continue; } r -= IT_GIN;
        if (r < IT_SQ) { tr_matrix_item(a.in[I_GOUT], D, D, D, (bf16*)(ws + WS_GOUT), -1, scr, r, F.lane); continue; } r -= IT_SQ;
        { const int per_e = 2 * IT_MG + IT_MD; const int e = r / per_e; int q = r % per_e;
          if (q < IT_MG) { tr_matrix_item(a.in[I_MG] + (size_t)e * D * DFE, DFE, D, DFE, (bf16*)(ws + WS_MGU) + (size_t)e * 2 * DFE * D, 0, scr, q, F.lane); continue; } q -= IT_MG;
          if (q < IT_MG) { tr_matrix_item(a.in[I_MU] + (size_t)e * D * DFE, DFE, D, DFE, (bf16*)(ws + WS_MGU) + (size_t)e * 2 * DFE * D, 1, scr, q, F.lane); continue; } q -= IT_MG;
          tr_matrix_item(a.in[I_MD] + (size_t)e * DFE * D, D, DFE, D, (bf16*)(ws + WS_MDN) + (size_t)e * D * DFE, -1, scr, q, F.lane); }
    }
    if (blockIdx.x < 16) {
        const int kv = blockIdx.x >> 3, n = (blockIdx.x & 7) * 32 + (F.tid & 31), ks = F.tid >> 5;
        const float* pe = a.in[kv ? I_PEV : I_PEK]; const float* w1 = a.in[kv ? I_WV1 : I_WK1]; float* b1 = (float*)(ws + WS_SMALL) + kv * 256;
        float sacc = 0.f;
#pragma unroll 8
        for (int k = ks * 128; k < ks * 128 + 128; ++k) sacc += pe[k] * w1[(size_t)k * 256 + n];
        LAS float* red = (LAS float*)(F.lds + 124 * 1024);
        red[F.tid] = sacc; __syncthreads();
        if (F.tid < 32) { float t = 0.f; for (int q = 0; q < 16; ++q) t += red[q * 32 + F.tid]; b1[n] = t; }
        __syncthreads();
    }
    {
        const float* x = a.in[I_X]; const float* win = a.in[I_WIN]; bf16* xb = (bf16*)(ws + WS_XB); float* gates = (float*)(ws + WS_GATES);
        LAS float* wg = (LAS float*)F.lds;
        __syncthreads();
        for (int i = F.tid; i < 24 * 1024; i += NTHREADS) { const int ch = i / 24, q = i % 24; wg[q * 1024 + ch] = win[(size_t)ch * INW + 2048 + q]; }
        __syncthreads();
        for (int m = gw; m < M; m += NGW) {
            const f32x4* xr = (const f32x4*)(x + (size_t)m * D) + F.lane; f32x4 v[4];
#pragma unroll
            for (int j = 0; j < 4; ++j) v[j] = xr[64 * j];
            unsigned long long* o8 = (unsigned long long*)(xb + (size_t)m * D) + F.lane;
#pragma unroll
            for (int j = 0; j < 4; ++j) o8[64 * j] = (unsigned long long)pk2(v[j][0], v[j][1]) | ((unsigned long long)pk2(v[j][2], v[j][3]) << 32);
            float mine = 0.f;
#pragma unroll 2
            for (int q = 0; q < 24; ++q) { float gq = 0.f;
#pragma unroll
                for (int j = 0; j < 4; ++j) { const f32x4 wv = *(const LAS f32x4*)(wg + q * 1024 + 256 * j + 4 * F.lane); gq += v[j][0] * wv[0] + v[j][1] * wv[1] + v[j][2] * wv[2] + v[j][3] * wv[3]; }
                gq = wave_sum(gq); mine = (F.lane == q) ? gq : mine; }
            if (F.lane < 24) gates[(size_t)m * 24 + F.lane] = mine;
        }
        __syncthreads();
    }
    if (blockIdx.x == 2 && F.tid < 256) ((u32x4*)(ws + WS_KC + (size_t)2 * 32 * 2048 * 64 * 2))[F.tid] = (u32x4){0u, 0u, 0u, 0u};
}

__device__ __forceinline__ void load_q(float (&q)[64], const bf16* qp, float scale) {
#pragma unroll
    for (int i = 0; i < 8; ++i) { const u32x4 v = ((const u32x4*)qp)[i];
        q[8 * i + 0] = bflo(v.x) * scale; q[8 * i + 1] = bfhi(v.x) * scale; q[8 * i + 2] = bflo(v.y) * scale; q[8 * i + 3] = bfhi(v.y) * scale;
        q[8 * i + 4] = bflo(v.z) * scale; q[8 * i + 5] = bfhi(v.z) * scale; q[8 * i + 6] = bflo(v.w) * scale; q[8 * i + 7] = bfhi(v.w) * scale; }
}
__device__ __forceinline__ float dot_bf(const float (&q)[64], const bf16* kp) {
    float s = 0.f;
#pragma unroll
    for (int i = 0; i < 8; ++i) { const u32x4 v = ((const u32x4*)kp)[i];
        s += q[8 * i + 0] * bflo(v.x) + q[8 * i + 1] * bfhi(v.x) + q[8 * i + 2] * bflo(v.y) + q[8 * i + 3] * bfhi(v.y)
           + q[8 * i + 4] * bflo(v.z) + q[8 * i + 5] * bfhi(v.z) + q[8 * i + 6] * bflo(v.w) + q[8 * i + 7] * bfhi(v.w); }
    return s;
}
__device__ __forceinline__ float dot_f32(const float (&q)[64], const float* kp) {
    float s = 0.f;
#pragma unroll
    for (int i = 0; i < 16; ++i) { const f32x4 v = ((const f32x4*)kp)[i]; s += q[4 * i] * v[0] + q[4 * i + 1] * v[1] + q[4 * i + 2] * v[2] + q[4 * i + 3] * v[3]; }
    return s;
}
__device__ __forceinline__ float pv_bf(float o, float e, const bf16* vbase, size_t pitch, int j0, int j1, int lane) {
    for (int j = j0; j < j1; ++j) { const float p = __builtin_bit_cast(float, __builtin_amdgcn_readlane(__builtin_bit_cast(int, e), j)); o += p * bf2f(vbase[(size_t)j * pitch + lane]); }
    return o;
}
__device__ __forceinline__ float pv_f32(float o, float e, const float* vbase, size_t pitch, int j0, int j1, int lane) {
    for (int j = j0; j < j1; ++j) { const float p = __builtin_bit_cast(float, __builtin_amdgcn_readlane(__builtin_bit_cast(int, e), j)); o += p * vbase[(size_t)j * pitch + lane]; }
    return o;
}
__device__ __forceinline__ float alibi_slope(int h) { return exp2f(-0.5f * (float)(h + 1)); }

__device__ __forceinline__ void p4_attention(Frame& F, const Args& a) {
    const int gw = F.vcu * NWAVES + F.wave, NGW = F.G * NWAVES, lane = F.lane;
    const bf16* P = (const bf16*)(F.ws + WS_P); bf16* O = (bf16*)(F.ws + WS_O);
    const float NINF = -__builtin_inff();
    for (int task = gw; task < M * 8; task += NGW) {
        const int m = task >> 3, h = task & 7, b = m >> 11, t = m & 2047, kvh = h >> 2;
        const float slope = alibi_slope(h), sink = a.in[I_SINK][h];
        float q[64]; load_q(q, P + (size_t)m * PW + h * 64, 0.125f);
        const bf16* Kb = P + (size_t)b * SEQ * PW + 512 + kvh * 64; const bf16* Vb = P + (size_t)b * SEQ * PW + 640 + kvh * 64;
        float s[2];
#pragma unroll
        for (int c = 0; c < 2; ++c) { const int kp = t - 127 + 64 * c + lane; const bool valid = kp >= 0; const int kc = valid ? kp : 0;
            const float d = dot_bf(q, Kb + (size_t)kc * PW); s[c] = valid ? d - slope * (float)(t - kp) : NINF; }
        float mx = fmaxf(wave_max(fmaxf(s[0], s[1])), sink);
        float e0 = __expf(s[0] - mx), e1 = __expf(s[1] - mx);
        const float den = wave_sum(e0 + e1) + __expf(sink - mx);
        float o = 0.f;
#pragma unroll
        for (int c = 0; c < 2; ++c) { const int base = t - 127 + 64 * c; const int j0 = base < 0 ? (-base < 64 ? -base : 64) : 0;
            o = pv_bf(o, c ? e1 : e0, Vb + (long)base * PW, PW, j0, 64, lane); }
        O[(size_t)m * D + h * 64 + lane] = (bf16)f2bf(o / den);
    }
    const float* KCC = (const float*)(F.ws + WS_KCC); const float* gates = (const float*)(F.ws + WS_GATES);
    LAS float* sc = (LAS float*)(F.lds + F.wave * 1024);
    for (int task = gw; task < M * 2; task += NGW) {
        const int m = task >> 1, hkv = task & 1, b = m >> 11, t = m & 2047, tb = t >> 6;
        const int nvc = t >= 31 ? ((t - 31) / 16 + 1 < NCMP ? (t - 31) / 16 + 1 : NCMP) : 0;
        const float* kcc = KCC + (size_t)((b * 2 + hkv) * 128) * 64; const float* vcc = KCC + (size_t)4096 * 64 + (size_t)((b * 2 + hkv) * 128) * 64;
        float oc0 = 0.f, oc1 = 0.f, oc2 = 0.f, oc3 = 0.f, ps0 = 0.f, ps1 = 0.f;
#pragma unroll 1
        for (int g = 0; g < 4; ++g) {
            const int hb = hkv * 4 + g; const float slope = alibi_slope(8 + hb);
            float q[64]; load_q(q, P + (size_t)m * PW + 768 + hb * 64, 0.125f);
            float s[2];
#pragma unroll
            for (int c = 0; c < 2; ++c) { const int cb = 64 * c + lane; const bool valid = cb < nvc;
                const float d = dot_f32(q, kcc + (size_t)cb * 64); s[c] = valid ? d - slope * (float)(t - (16 * cb + 31)) : NINF; }
            float mx = wave_max(fmaxf(s[0], s[1])); if (!(mx > NINF)) mx = 0.f;
            float e0 = (lane < nvc) ? __expf(s[0] - mx) : 0.f, e1 = (64 + lane < nvc) ? __expf(s[1] - mx) : 0.f;
            const float den = wave_sum(e0 + e1); const float inv = den > 0.f ? 1.0f / den : 1.0f;
            e0 *= inv; e1 *= inv; ps0 += e0; ps1 += e1;
            float o = 0.f;
            o = pv_f32(o, e0, vcc, 64, 0, nvc < 64 ? nvc : 64, lane);
            o = pv_f32(o, e1, vcc + 64 * 64, 64, 0, nvc > 64 ? nvc - 64 : 0, lane);
            oc0 = (g == 0) ? o : oc0; oc1 = (g == 1) ? o : oc1; oc2 = (g == 2) ? o : oc2; oc3 = (g == 3) ? o : oc3;
        }
        sc[lane] = ps0; sc[64 + lane] = ps1; LDS_WAIT(); asm volatile("" ::: "memory");
        float imp = 0.f;
        if (lane < 32) {
#pragma unroll
            for (int k = -1; k <= 3; ++k) { const int c = 4 * lane + k; if (c >= 0 && c < NCMP) imp += sc[c]; } }
        LDS_WAIT(); asm volatile("" ::: "memory");
        const bool validj = lane <= tb, forced = (lane == 0) || (lane == tb) || (lane == tb - 1);
        const float rank = (lane >= 32) ? NINF : (forced ? __builtin_inff() : (validj ? imp : NINF));
        int cnt = 0;
        for (int jj = 0; jj < 32; ++jj) { const float rj = __builtin_bit_cast(float, __builtin_amdgcn_readlane(__builtin_bit_cast(int, rank), jj)); cnt += (rj > rank || (rj == rank && jj < lane)) ? 1 : 0; }
        const unsigned selmask = (unsigned)__ballot(lane < 32 && cnt < 8 && validj);
#pragma unroll 1
        for (int g = 0; g < 4; ++g) {
            const int hb = hkv * 4 + g; const float slope = alibi_slope(8 + hb);
            float q[64]; load_q(q, P + (size_t)m * PW + 768 + hb * 64, 0.125f);
            float oslc = 0.f;
            {
                const bf16* Kb = P + (size_t)b * SEQ * PW + 1536 + hkv * 64; const bf16* Vb = P + (size_t)b * SEQ * PW + 1664 + hkv * 64;
                float s[8]; unsigned mm = selmask; float mx = NINF;
#pragma unroll
                for (int i = 0; i < 8; ++i) { s[i] = NINF;
                    if (mm) { const int j = __builtin_ctz(mm); mm &= mm - 1; const int kp = 64 * j + lane; const bool valid = kp <= t; const int kc = valid ? kp : t;
                        const float d = dot_bf(q, Kb + (size_t)kc * PW); s[i] = valid ? d - slope * (float)(t - kp) : NINF; }
                    mx = fmaxf(mx, s[i]); }
                mx = wave_max(mx);
                float den = 0.f;
#pragma unroll
                for (int i = 0; i < 8; ++i) { s[i] = __expf(s[i] - mx); den += s[i]; }
                den = wave_sum(den);
                mm = selmask;
#pragma unroll
                for (int i = 0; i < 8; ++i) { if (mm) { const int j = __builtin_ctz(mm); mm &= mm - 1; const int nk = (t - 64 * j + 1) < 64 ? (t - 64 * j + 1) : 64;
                        oslc = pv_bf(oslc, s[i], Vb + (size_t)(64 * j) * PW, PW, 0, nk, lane); } }
                oslc /= den;
            }
            float owin = 0.f;
            {
                const bf16* Kb = P + (size_t)b * SEQ * PW + 1792 + hkv * 64; const bf16* Vb = P + (size_t)b * SEQ * PW + 1920 + hkv * 64;
                float s[4]; float mx = NINF;
#pragma unroll
                for (int c = 0; c < 4; ++c) { const int kp = t - 255 + 64 * c + lane; const bool valid = kp >= 0; const int kc = valid ? kp : 0;
                    const float d = dot_bf(q, Kb + (size_t)kc * PW); s[c] = valid ? d - slope * (float)(t - kp) : NINF; mx = fmaxf(mx, s[c]); }
                mx = wave_max(mx);
                float den = 0.f;
#pragma unroll
                for (int c = 0; c < 4; ++c) { s[c] = __expf(s[c] - mx); den += s[c]; }
                den = wave_sum(den);
#pragma unroll
                for (int c = 0; c < 4; ++c) { const int base = t - 255 + 64 * c; const int j0 = base < 0 ? (-base < 64 ? -base : 64) : 0;
                    owin = pv_bf(owin, s[c], Vb + (long)base * PW, PW, j0, 64, lane); }
                owin /= den;
            }
            const float* gp = gates + (size_t)m * 24 + hb * 3;
            const float oc = (g == 0) ? oc0 : (g == 1) ? oc1 : (g == 2) ? oc2 : oc3;
            const float r = sigmoidf(gp[0]) * oc + sigmoidf(gp[1]) * oslc + sigmoidf(gp[2]) * owin;
            O[(size_t)m * D + 512 + hb * 64 + lane] = (bf16)f2bf(r);
        }
    }
}


namespace att {
typedef float f32x16 __attribute__((ext_vector_type(16)));
typedef short s16x4 __attribute__((ext_vector_type(4)));
typedef __bf16 bf16x2_t __attribute__((ext_vector_type(2)));
constexpr int KP = 144;
constexpr int TILEB = 64 * KP;
constexpr int BUFB = 2 * TILEB;
constexpr float LOG2E = 1.4426950408889634f;
__device__ __forceinline__ unsigned cvtpk(float lo, float hi) { f32x2 v = {lo, hi}; bf16x2_t b = __builtin_convertvector(v, bf16x2_t); return __builtin_bit_cast(unsigned, b); }
__device__ __forceinline__ f32x16 zero16() { f32x16 z;
#pragma unroll
    for (int i = 0; i < 16; ++i) z[i] = 0.f; return z; }
struct Stage { u32x4 k, v; };
__device__ __forceinline__ void stage_load(Stage& s, const bf16* Kg, const bf16* Vg, size_t pitch, int row0, int tid) {
    const int key = tid >> 3, ch = tid & 7; s.k = *(const u32x4*)(Kg + (size_t)(row0 + key) * pitch + ch * 8); s.v = *(const u32x4*)(Vg + (size_t)(row0 + key) * pitch + ch * 8); }
__device__ __forceinline__ void stage_store(const Stage& s, LAS unsigned char* buf, int tid) {
    const int key = tid >> 3, ch = tid & 7; *(LAS u32x4*)(buf + key * KP + ch * 16) = s.k; *(LAS u32x4*)(buf + TILEB + key * KP + ch * 16) = s.v; }
__device__ __forceinline__ bf16x8 pack_frag(const f32x16& x, int s) {
    u32x4 w; w.x = cvtpk(x[8 * s], x[8 * s + 1]); w.y = cvtpk(x[8 * s + 2], x[8 * s + 3]); w.z = cvtpk(x[8 * s + 4], x[8 * s + 5]); w.w = cvtpk(x[8 * s + 6], x[8 * s + 7]); return __builtin_bit_cast(bf16x8, w); }

template <int MODE>
__device__ __forceinline__ void stream(f32x16 (&oT)[2], f32x16& imp, float& m_run, float& l_run, const bf16x8 (&qf)[4], const bf16* Kg, const bf16* Vg, size_t pitch,
                                       int first, int ntile, unsigned umask, int tq, float slope, unsigned selmask, int W, LAS unsigned char* lds, int tid, int lane) {
    const int r = lane & 31, h = lane >> 5;
    const float NINF = -__builtin_inff();
    if (ntile <= 0) return;
    __syncthreads();
    Stage st; unsigned mm = umask;
    int kt = (MODE == 1) ? __builtin_ctz(mm) : first; if (MODE == 1) mm &= mm - 1;
    stage_load(st, Kg, Vg, pitch, 64 * kt, tid);
    for (int i = 0; i < ntile; ++i) {
        LAS unsigned char* buf = lds + (i & 1) * BUFB;
        stage_store(st, buf, tid);
        __syncthreads();
        const int ktc = kt;
        if (i + 1 < ntile) { kt = (MODE == 1) ? __builtin_ctz(mm) : kt + 1; if (MODE == 1) mm &= mm - 1; stage_load(st, Kg, Vg, pitch, 64 * kt, tid); }
        f32x16 p[2];
#pragma unroll
        for (int blk = 0; blk < 2; ++blk) { p[blk] = zero16();
#pragma unroll
            for (int d0 = 0; d0 < 4; ++d0) { const bf16x8 ka = *(const LAS bf16x8*)(buf + (32 * blk + r) * KP + (16 * d0 + 8 * h) * 2);
                p[blk] = __builtin_amdgcn_mfma_f32_32x32x16_bf16(ka, qf[d0], p[blk], 0, 0, 0); } }
        float fb, step;
        if (MODE == 2) { fb = (float)(tq - 31 - 16 * (64 * ktc + 4 * h)); step = 16.f; } else { fb = (float)(tq - 64 * ktc - 4 * h); step = 1.f; }
        const bool lane_on = (MODE == 1) ? ((selmask >> ktc) & 1u) != 0u : true;
        float tmax = NINF;
#pragma unroll
        for (int blk = 0; blk < 2; ++blk)
#pragma unroll
            for (int i2 = 0; i2 < 16; ++i2) { const float dist = fb - step * (float)(32 * blk + (i2 & 3) + 8 * (i2 >> 2));
                bool valid = dist >= 0.f && lane_on; if (MODE == 0) valid = valid && dist < (float)W;
                const float sv = valid ? p[blk][i2] - slope * dist : NINF; p[blk][i2] = sv; tmax = fmaxf(tmax, sv); }
        tmax = fmaxf(tmax, __shfl_xor(tmax, 32));
        const float m_new = fmaxf(m_run, tmax), m_use = (m_new == NINF) ? 0.f : m_new;
        const float alpha = __builtin_amdgcn_exp2f((m_run - m_use) * LOG2E), mb = -m_use * LOG2E;
        float rs = 0.f;
#pragma unroll
        for (int blk = 0; blk < 2; ++blk)
#pragma unroll
            for (int i2 = 0; i2 < 16; ++i2) { const float e = __builtin_amdgcn_exp2f(fmaf(p[blk][i2], LOG2E, mb)); p[blk][i2] = e; rs += e; }
        l_run = l_run * alpha + rs; m_run = m_new;
#pragma unroll
        for (int i2 = 0; i2 < 16; ++i2) { oT[0][i2] *= alpha; oT[1][i2] *= alpha; if (MODE == 2) imp[i2] *= alpha; }
        const LAS unsigned char* vb = buf + TILEB + (4 * h + ((lane >> 2) & 3)) * KP + (16 * ((lane >> 4) & 1) + 4 * (lane & 3)) * 2;
#pragma unroll
        for (int blk = 0; blk < 2; ++blk)
#pragma unroll
            for (int s = 0; s < 2; ++s) { const int ks = 2 * blk + s; const bf16x8 pf = pack_frag(p[blk], s);
#pragma unroll
                for (int db = 0; db < 2; ++db) { const LAS unsigned char* ad = vb + (16 * ks) * KP + (32 * db) * 2;
                    const s16x4 lo = __builtin_bit_cast(s16x4, __builtin_amdgcn_ds_read_tr16_b64_v4i16((LAS s16x4*)ad));
                    const s16x4 hi = __builtin_bit_cast(s16x4, __builtin_amdgcn_ds_read_tr16_b64_v4i16((LAS s16x4*)(ad + 8 * KP)));
                    const bf16x8 vf = (bf16x8){lo[0], lo[1], lo[2], lo[3], hi[0], hi[1], hi[2], hi[3]};
                    oT[db] = __builtin_amdgcn_mfma_f32_32x32x16_bf16(vf, pf, oT[db], 0, 0, 0); }
                if (MODE == 2) {
                    u32x4 w;
#pragma unroll
                    for (int e2 = 0; e2 < 4; ++e2) { const int c0 = 64 * ktc + 16 * ks + 8 * (e2 >> 1) + 4 * h + 2 * (e2 & 1), c1 = c0 + 1;
                        const unsigned b0 = (c0 >= 4 * r - 1 && c0 <= 4 * r + 3) ? 0x3F80u : 0u, b1 = (c1 >= 4 * r - 1 && c1 <= 4 * r + 3) ? 0x3F80u : 0u; w[e2] = b0 | (b1 << 16); }
                    imp = __builtin_amdgcn_mfma_f32_32x32x16_bf16(__builtin_bit_cast(bf16x8, w), pf, imp, 0, 0, 0); } }
    }
}
__device__ __forceinline__ void load_qfrag(bf16x8 (&qf)[4], const bf16* qrow, int h) {
#pragma unroll
    for (int d0 = 0; d0 < 4; ++d0) { const u32x4 v = *(const u32x4*)(qrow + 16 * d0 + 8 * h); u32x4 w;
        w.x = cvtpk(bflo(v.x) * 0.125f, bfhi(v.x) * 0.125f); w.y = cvtpk(bflo(v.y) * 0.125f, bfhi(v.y) * 0.125f); w.z = cvtpk(bflo(v.z) * 0.125f, bfhi(v.z) * 0.125f); w.w = cvtpk(bflo(v.w) * 0.125f, bfhi(v.w) * 0.125f);
        qf[d0] = __builtin_bit_cast(bf16x8, w); }
}
__device__ __forceinline__ void fold(f32x16 (&res)[2], const f32x16 (&oT)[2], float sc) {
#pragma unroll
    for (int i = 0; i < 16; ++i) { res[0][i] += sc * oT[0][i]; res[1][i] += sc * oT[1][i]; } }
__device__ __forceinline__ void store_o(bf16* orow, const f32x16 (&res)[2], int h) {
#pragma unroll
    for (int db = 0; db < 2; ++db)
#pragma unroll
        for (int a4 = 0; a4 < 4; ++a4) { u32x2 w; w.x = cvtpk(res[db][4 * a4], res[db][4 * a4 + 1]); w.y = cvtpk(res[db][4 * a4 + 2], res[db][4 * a4 + 3]);
            *(u32x2*)(orow + 32 * db + 8 * a4 + 4 * h) = w; }
}
}

__device__ __forceinline__ void p4_attention_mfma(Frame& F, const Args& a) {
    using namespace att;
    const int lane = F.lane, tid = F.tid, w = F.wave, r = lane & 31, h = lane >> 5, g = r >> 3, qi = r & 7;
    const bf16* P = (const bf16*)(F.ws + WS_P); bf16* O = (bf16*)(F.ws + WS_O);
    const bf16* KCB = (const bf16*)(F.ws + WS_KCCB); const float* gates = (const float*)(F.ws + WS_GATES);
    LAS unsigned* ubuf = (LAS unsigned*)(F.lds + 4 * BUFB);
    const float NINF = -__builtin_inff();
    const int x = F.vcu, bh = x >> 3, qslot = x & 7, b = bh >> 1, hkv = bh & 1;
    if (x >= 256) return;
    for (int rr = 0; rr < 4; ++rr) {
        const int qt = (rr & 1) ? 8 * rr + 7 - qslot : 8 * rr + qslot;
        const int tq = 64 * qt + 8 * w + qi; const size_t m = (size_t)b * SEQ + tq;
        const bf16* Pb = P + (size_t)b * SEQ * PW;
        {
            const int hd = hkv * 4 + g; const float slope = alibi_slope(hd);
            bf16x8 qf[4]; load_qfrag(qf, P + m * PW + hd * 64, h);
            f32x16 oT[2] = {zero16(), zero16()}, dummy = zero16(); float m_run = NINF, l_run = 0.f;
            const int first = qt >= 2 ? qt - 2 : 0;
            stream<0>(oT, dummy, m_run, l_run, qf, Pb + 512 + hkv * 64, Pb + 640 + hkv * 64, PW, first, qt - first + 1, 0u, tq, slope, 0u, 128, F.lds, tid, lane);
            float l_tot = l_run + __shfl_xor(l_run, 32); l_tot += __expf(a.in[I_SINK][hd] - m_run);
            f32x16 res[2] = {zero16(), zero16()}; fold(res, oT, 1.0f / l_tot);
            store_o(O + m * D + hd * 64, res, h);
        }
        {
            const int hb = hkv * 4 + g; const float slope = alibi_slope(8 + hb);
            bf16x8 qf[4]; load_qfrag(qf, P + m * PW + 768 + hb * 64, h);
            const float* gp = gates + m * 24 + hb * 3;
            const float g0 = sigmoidf(gp[0]), g1 = sigmoidf(gp[1]), g2 = sigmoidf(gp[2]);
            f32x16 res[2] = {zero16(), zero16()};
            unsigned selmask = 0u;
            {
                f32x16 oT[2] = {zero16(), zero16()}, imp = zero16(); float m_run = NINF, l_run = 0.f;
                const int nvc_max = (64 * qt + 63 >= 31) ? ((64 * qt + 63 - 31) / 16 + 1) : 0;
                const int ntile = nvc_max > 64 ? 2 : (nvc_max > 0 ? 1 : 0);
                stream<2>(oT, imp, m_run, l_run, qf, KCB + (size_t)(bh * 128) * 64, KCB + (size_t)4096 * 64 + (size_t)(bh * 128) * 64, 64, 0, ntile, 0u, tq, slope, 0u, 0, F.lds, tid, lane);
                const float l_tot = l_run + __shfl_xor(l_run, 32); const float inv = l_tot > 0.f ? 1.0f / l_tot : 0.f;
                fold(res, oT, g0 * inv);
                float R[32];
#pragma unroll
                for (int i = 0; i < 16; ++i) { float v = imp[i] * inv; v += __shfl_xor(v, 8); v += __shfl_xor(v, 16); const float o = __shfl_xor(v, 32);
                    const int j0 = (i & 3) + 8 * (i >> 2); R[j0] = h ? o : v; R[j0 + 4] = h ? v : o; }
                const int tb = tq >> 6;
#pragma unroll
                for (int j = 0; j < 32; ++j) R[j] = (j == 0 || j == tb || j == tb - 1) ? __builtin_inff() : (j <= tb ? R[j] : NINF);
#pragma unroll 1
                for (int rd = 0; rd < 8; ++rd) { float best = NINF; int bj = -1;
#pragma unroll
                    for (int j = 0; j < 32; ++j) { if (R[j] > best) { best = R[j]; bj = j; } }
                    if (bj >= 0) selmask |= 1u << bj;
#pragma unroll
                    for (int j = 0; j < 32; ++j) R[j] = (j == bj) ? NINF : R[j]; }
            }
            unsigned um = selmask;
#pragma unroll
            for (int o2 = 1; o2 < 64; o2 <<= 1) um |= (unsigned)__shfl_xor((int)um, o2);
            __syncthreads();
            if (lane == 0) ubuf[w] = um;
            __syncthreads();
            um = ubuf[0] | ubuf[1] | ubuf[2] | ubuf[3] | ubuf[4] | ubuf[5] | ubuf[6] | ubuf[7];
            um = (unsigned)__builtin_amdgcn_readfirstlane((int)um);
            {
                f32x16 oT[2] = {zero16(), zero16()}, dummy = zero16(); float m_run = NINF, l_run = 0.f;
                stream<1>(oT, dummy, m_run, l_run, qf, Pb + 1536 + hkv * 64, Pb + 1664 + hkv * 64, PW, 0, __builtin_popcount(um), um, tq, slope, selmask, 0, F.lds, tid, lane);
                const float l_tot = l_run + __shfl_xor(l_run, 32); fold(res, oT, g1 / l_tot);
            }
            {
                f32x16 oT[2] = {zero16(), zero16()}, dummy = zero16(); float m_run = NINF, l_run = 0.f;
                const int first = qt >= 4 ? qt - 4 : 0;
                stream<0>(oT, dummy, m_run, l_run, qf, Pb + 1792 + hkv * 64, Pb + 1920 + hkv * 64, PW, first, qt - first + 1, 0u, tq, slope, 0u, 256, F.lds, tid, lane);
                const float l_tot = l_run + __shfl_xor(l_run, 32); fold(res, oT, g2 / l_tot);
            }
            store_o(O + m * D + 512 + hb * 64, res, h);
        }
    }
}

template <int MODE>
__device__ __forceinline__ void ln_phase(Frame& F, const Args& a, const float* lg, const float* lb) {
    const int gw = F.vcu * NWAVES + F.wave, NGW = F.G * NWAVES, lane = F.lane;
    float* out = a.out; bf16* xb = (bf16*)(F.ws + WS_XB);
    f32x4 gg[4], bb[4];
#pragma unroll
    for (int j = 0; j < 4; ++j) { gg[j] = *((const f32x4*)lg + lane + 64 * j); bb[j] = *((const f32x4*)lb + lane + 64 * j); }
    for (int m = gw; m < M; m += NGW) {
        f32x4* xr = (f32x4*)(out + (size_t)m * D) + lane; f32x4 v[4]; float s = 0.f;
#pragma unroll
        for (int j = 0; j < 4; ++j) v[j] = xr[64 * j];
        if (MODE == 2) {
            const bf16* y = (const bf16*)(F.ws + WS_Y2) + (size_t)m * 2 * D;
#pragma unroll
            for (int j = 0; j < 4; ++j) { const u32x2 y0 = *((const u32x2*)y + lane + 64 * j), y1 = *((const u32x2*)(y + D) + lane + 64 * j);
                v[j][0] = ALPHA * v[j][0] + bflo(y0.x) + bflo(y1.x); v[j][1] = ALPHA * v[j][1] + bfhi(y0.x) + bfhi(y1.x);
                v[j][2] = ALPHA * v[j][2] + bflo(y0.y) + bflo(y1.y); v[j][3] = ALPHA * v[j][3] + bfhi(y0.y) + bfhi(y1.y); }
        }
#pragma unroll
        for (int j = 0; j < 4; ++j) s += (v[j][0] + v[j][1]) + (v[j][2] + v[j][3]);
        const float mean = wave_sum(s) * (1.f / D); float s2 = 0.f;
#pragma unroll
        for (int j = 0; j < 4; ++j) { v[j] = v[j] - mean; s2 += (v[j][0] * v[j][0] + v[j][1] * v[j][1]) + (v[j][2] * v[j][2] + v[j][3] * v[j][3]); }
        const float rstd = 1.f / sqrtf(wave_sum(s2) * (1.f / D) + LN_EPS);
#pragma unroll
        for (int j = 0; j < 4; ++j) { v[j] = v[j] * rstd * gg[j] + bb[j]; xr[64 * j] = v[j]; }
        if (MODE != 2) {
            unsigned long long* o8 = (unsigned long long*)(xb + (size_t)m * D) + lane;
#pragma unroll
            for (int j = 0; j < 4; ++j) o8[64 * j] = (unsigned long long)pk2(v[j][0], v[j][1]) | ((unsigned long long)pk2(v[j][2], v[j][3]) << 32);
        }
        if (MODE == 1) {
            const float* wr = a.in[I_RT]; float lg8[8];
#pragma unroll
            for (int e = 0; e < 8; ++e) lg8[e] = 0.f;
#pragma unroll
            for (int j = 0; j < 4; ++j)
#pragma unroll
                for (int i = 0; i < 4; ++i) { const float* w = wr + (size_t)(256 * j + 4 * lane + i) * 8; const f32x4 w0 = *(const f32x4*)w, w1 = *(const f32x4*)(w + 4); const float xv = v[j][i];
                    lg8[0] += xv * w0[0]; lg8[1] += xv * w0[1]; lg8[2] += xv * w0[2]; lg8[3] += xv * w0[3]; lg8[4] += xv * w1[0]; lg8[5] += xv * w1[1]; lg8[6] += xv * w1[2]; lg8[7] += xv * w1[3]; }
#pragma unroll
            for (int e = 0; e < 8; ++e) lg8[e] = wave_sum(lg8[e]);
            int e0 = 0; float v0 = lg8[0];
#pragma unroll
            for (int e = 1; e < 8; ++e) if (lg8[e] > v0) { v0 = lg8[e]; e0 = e; }
            int e1 = -1; float v1 = -__builtin_inff();
#pragma unroll
            for (int e = 0; e < 8; ++e) if (e != e0 && lg8[e] > v1) { v1 = lg8[e]; e1 = e; }
            const float g0 = 1.0f / (1.0f + __expf(v1 - v0)), g1 = 1.0f - g0;
            if (lane == 0) {
                int* rowtok = (int*)(F.ws + WS_ROWTOK); int* rowdst = (int*)(F.ws + WS_ROWDST); float* rowgate = (float*)(F.ws + WS_ROWGATE);
                const unsigned p0 = atomicAdd((unsigned*)(F.ctl + CW_CNT + 64 * e0), 1u), p1 = atomicAdd((unsigned*)(F.ctl + CW_CNT + 64 * e1), 1u);
                rowtok[e0 * CAP + p0] = m; rowdst[e0 * CAP + p0] = 2 * m; rowgate[e0 * CAP + p0] = g0;
                rowtok[e1 * CAP + p1] = m; rowdst[e1 * CAP + p1] = 2 * m + 1; rowgate[e1 * CAP + p1] = g1;
            }
        }
    }
}

__device__ __forceinline__ void p3_compress2(Frame& F, const Args& a) {
    const bf16* H1 = (const bf16*)(F.ws + WS_H1); float* KCC = (float*)(F.ws + WS_KCC);
    const int gt = blockIdx.x * NTHREADS + F.tid, NT = F.G * NTHREADS;
    for (int idx = gt; idx < 2 * 4096 * 64; idx += NT) {
        const int n = idx & 63, r = (idx >> 6) & 4095, kv = idx >> 18;
        const float* w2 = a.in[kv ? I_WV2 : I_WK2]; const bf16* h = H1 + (size_t)(kv * 4096 + r) * 256; float s = 0.f;
        for (int j8 = 0; j8 < 32; ++j8) { const u32x4 v = ((const u32x4*)h)[j8]; const float* w = w2 + (size_t)(8 * j8) * 64 + n;
            s += bflo(v.x) * w[0] + bfhi(v.x) * w[64] + bflo(v.y) * w[128] + bfhi(v.y) * w[192] + bflo(v.z) * w[256] + bfhi(v.z) * w[320] + bflo(v.w) * w[384] + bfhi(v.w) * w[448]; }
        KCC[idx] = s; ((bf16*)(F.ws + WS_KCCB))[idx] = (bf16)f2bf(s);
    }
}

__device__ __forceinline__ void p11_spatial(Frame& F, const Args& a) {
    const bf16* U = (const bf16*)(F.ws + WS_U); const bf16* V = (const bf16*)(F.ws + WS_V); bf16* Z = (bf16*)(F.ws + WS_Z);
    LAS float* Wl = (LAS float*)(F.lds); LAS float* vn = (LAS float*)(F.lds + 65536); LAS f32x2* st = (LAS f32x2*)(F.lds + LDS_STATS_OFF);
    const float* lng = a.in[I_GLNG]; const float* lnb = a.in[I_GLNB]; const float* ws_ = a.in[I_GWS]; const float* bs = a.in[I_GBS];
    const int tid = F.tid, lane = F.lane;
    for (int unit = blockIdx.x; unit < NB * 16; unit += F.G) {
        const int m0 = unit * 128;
        __syncthreads();
        for (int rr = 0; rr < 16; ++rr) { const int r = F.wave * 16 + rr; const bf16* vr = V + (size_t)(m0 + r) * D;
            const u32x4 p0 = ((const u32x4*)vr)[lane], p1 = ((const u32x4*)vr)[64 + lane]; float x[16];
            x[0] = bflo(p0.x); x[1] = bfhi(p0.x); x[2] = bflo(p0.y); x[3] = bfhi(p0.y); x[4] = bflo(p0.z); x[5] = bfhi(p0.z); x[6] = bflo(p0.w); x[7] = bfhi(p0.w);
            x[8] = bflo(p1.x); x[9] = bfhi(p1.x); x[10] = bflo(p1.y); x[11] = bfhi(p1.y); x[12] = bflo(p1.z); x[13] = bfhi(p1.z); x[14] = bflo(p1.w); x[15] = bfhi(p1.w);
            float s = 0.f;
#pragma unroll
            for (int i = 0; i < 16; ++i) s += x[i];
            const float mean = wave_sum(s) * (1.f / D); float s2 = 0.f;
#pragma unroll
            for (int i = 0; i < 16; ++i) { const float d = x[i] - mean; s2 += d * d; }
            const float rstd = 1.f / sqrtf(wave_sum(s2) * (1.f / D) + LN_EPS);
            if (lane == 0) st[r] = (f32x2){mean, rstd}; }
        __syncthreads();
        for (int g = 0; g < 8; ++g) {
            for (int i = tid; i < 128 * 32; i += NTHREADS) { const int t = i >> 5, s4 = (i & 31) * 4; f32x4 w = *(const f32x4*)(ws_ + (size_t)g * 16384 + t * 128 + s4);
                if (s4 + 0 > t) w[0] = 0.f; if (s4 + 1 > t) w[1] = 0.f; if (s4 + 2 > t) w[2] = 0.f; if (s4 + 3 > t) w[3] = 0.f; *(LAS f32x4*)(Wl + t * 128 + s4) = w; }
            { const int ch = tid & 127; const float gch = lng[g * 128 + ch], bch = lnb[g * 128 + ch];
              for (int s = tid >> 7; s < 128; s += 4) { const f32x2 ms = st[s]; vn[s * 128 + ch] = (bf2f(V[(size_t)(m0 + s) * D + g * 128 + ch]) - ms.x) * ms.y * gch + bch; } }
            __syncthreads();
            { const int ch = tid & 127, tq = tid >> 7; float acc[32];
#pragma unroll
              for (int i = 0; i < 32; ++i) acc[i] = 0.f;
              const int s4end = (tq * 32 + 32) / 4;
              for (int s4 = 0; s4 < s4end; ++s4) { const float v0 = vn[(4 * s4) * 128 + ch], v1 = vn[(4 * s4 + 1) * 128 + ch], v2 = vn[(4 * s4 + 2) * 128 + ch], v3 = vn[(4 * s4 + 3) * 128 + ch];
#pragma unroll
                  for (int i = 0; i < 32; ++i) { const f32x4 w = *(const LAS f32x4*)(Wl + (tq * 32 + i) * 128 + 4 * s4); acc[i] += w[0] * v0 + w[1] * v1 + w[2] * v2 + w[3] * v3; } }
#pragma unroll
              for (int i = 0; i < 32; ++i) { const int t = tq * 32 + i; const size_t o = (size_t)(m0 + t) * D + g * 128 + ch;
                  Z[o] = (bf16)f2bf(bf2f(U[o]) * (acc[i] + bs[g * 128 + t])); } }
            __syncthreads();
        }
    }
}

constexpr int N_PHASES = 25;
__global__ void __launch_bounds__(NTHREADS, 2) fwd(Args args) {
    extern __shared__ __attribute__((aligned(16))) unsigned char lds[];
    Frame F;
    F.lds = (LAS unsigned char*)lds; F.ws = args.ws; F.ctl = (gu32*)(args.ws + WS_CTL);
    F.tid = threadIdx.x; F.lane = F.tid & 63; F.wave = __builtin_amdgcn_readfirstlane(F.tid >> 6);
    F.G = gridDim.x; { const int bx = blockIdx.x; F.vcu = (F.G % 8 == 0) ? (bx % 8) * (F.G / 8) + bx / 8 : bx; }
    for (int u = F.tid; u < (LDS_BYTES - LDSCTL_OFF) / 4; u += NTHREADS) ((LAS unsigned*)(F.lds + LDSCTL_OFF))[u] = 0u;
    __syncthreads();
    unsigned char* ws = args.ws;
#if MK_ONE_LAUNCH
    XcdBarrier bar = xcd_barrier_post((unsigned*)(F.ctl + CW_BAR), (volatile LAS unsigned*)(F.lds + LDSCTL_OFF));
#define GRID_BAR() xcd_barrier(bar)
#else
#define GRID_BAR() do { } while (0)
#endif
    const int lo = args.ph_lo, hi = args.ph_hi;
#define IN(k) (lo <= (k) && (k) < hi)
#define SEAM(k) do { if (IN(k) && IN((k) + 1)) GRID_BAR(); } while (0)
    const int G = F.G, c = (int)blockIdx.x;
    const float* lng = args.in[I_LNG]; const float* lnb = args.in[I_LNB];

    if (IN(0)) { for (int rep = 0; rep < REP_PRO; ++rep) p0_prologue(F, args); } SEAM(0);
    if (IN(1)) { pg8::Gemm g{(const char*)(ws + WS_XB), (const char*)(ws + WS_WIN), D, 0}; pg8::StaticOrder S{M / 256, 8, G, c};
        pg8::EpiBf<0> E{(bf16*)(ws + WS_P), (bf16*)(ws + WS_KC), PW, nullptr, nullptr, nullptr}; pg8::ADense al{(unsigned)D * 2u};
        pg8::gemm_phase(F.lds, g, S, E, al); } SEAM(1);
    if (IN(2)) { pg8::Gemm g{(const char*)(ws + WS_KC), (const char*)(ws + WS_WC1), 2048, (size_t)256 * 2048 * 2}; pg8::CmpOrder S{c};
        pg8::EpiBf<1> E{(bf16*)(ws + WS_H1), nullptr, 256, (const float*)(ws + WS_SMALL), nullptr, nullptr}; pg8::ADense al{1024u * 2u};
        pg8::gemm_phase(F.lds, g, S, E, al); } SEAM(2);
    if (IN(3)) { p3_compress2(F, args); } SEAM(3);
    if (IN(4)) { for (int rep = 0; rep < REP_ATT; ++rep) p4_attention_mfma(F, args); } SEAM(4);
    if (IN(5)) { pg8::Gemm g{(const char*)(ws + WS_O), (const char*)(ws + WS_WO), D, 0}; pg8::StaticOrder S{M / 256, 4, G, c};
        pg8::EpiRes E{args.in[I_X], args.out, ALPHA}; pg8::ADense al{(unsigned)D * 2u};
        pg8::gemm_phase(F.lds, g, S, E, al); } SEAM(5);
    if (IN(6)) { ln_phase<0>(F, args, lng + 0 * D, lnb + 0 * D); } SEAM(6);
    if (IN(7)) { pg8::Gemm g{(const char*)(ws + WS_XB), (const char*)(ws + WS_FGU), D, 0}; pg8::StaticOrder S{M / 256, DFF / 128, G, c};
        pg8::EpiBf<3> E{(bf16*)(ws + WS_H), nullptr, DFF, nullptr, nullptr, nullptr}; pg8::ADense al{(unsigned)D * 2u};
        pg8::gemm_phase(F.lds, g, S, E, al); } SEAM(7);
    if (IN(8)) { pg8::Gemm g{(const char*)(ws + WS_H), (const char*)(ws + WS_FDN), DFF, 0}; pg8::StaticOrder S{M / 256, 4, G, c};
        pg8::EpiRes E{args.out, args.out, ALPHA}; pg8::ADense al{(unsigned)DFF * 2u};
        pg8::gemm_phase(F.lds, g, S, E, al); } SEAM(8);
    if (IN(9)) { ln_phase<0>(F, args, lng + 1 * D, lnb + 1 * D); } SEAM(9);
    if (IN(10)) { pg8::Gemm g{(const char*)(ws + WS_XB), (const char*)(ws + WS_GIN), D, 0}; pg8::StaticOrder S{M / 256, 8, G, c};
        pg8::EpiBf<2> E{(bf16*)(ws + WS_U), (bf16*)(ws + WS_V), D, nullptr, nullptr, nullptr}; pg8::ADense al{(unsigned)D * 2u};
        pg8::gemm_phase(F.lds, g, S, E, al); } SEAM(10);
    if (IN(11)) { for (int rep = 0; rep < REP_SPA; ++rep) p11_spatial(F, args); } SEAM(11);
    if (IN(12)) { pg8::Gemm g{(const char*)(ws + WS_Z), (const char*)(ws + WS_GOUT), D, 0}; pg8::StaticOrder S{M / 256, 4, G, c};
        pg8::EpiRes E{args.out, args.out, ALPHA}; pg8::ADense al{(unsigned)D * 2u};
        pg8::gemm_phase(F.lds, g, S, E, al); } SEAM(12);
    if (IN(13)) { ln_phase<1>(F, args, lng + 2 * D, lnb + 2 * D); } SEAM(13);
    {
        LAS int* tab = (LAS int*)(F.lds + LDS_MOE_OFF);
        if (hi > 14 && lo < 24) {
            __syncthreads();
            if (F.tid == 0) { int ts = 0;
                for (int e = 0; e < 8; ++e) { int n = (int)__hip_atomic_load(F.ctl + CW_CNT + 64 * e, __ATOMIC_RELAXED, __HIP_MEMORY_SCOPE_AGENT); if (n > CAP) n = CAP; tab[e] = n; tab[8 + e] = ts; ts += (n + 255) >> 8; }
                tab[16] = ts; }
            __syncthreads();
        }
        const int T = tab[16];
#pragma unroll 1
        for (int ch = 0; ch < 5; ++ch) {
            const int tile0 = 64 * ch; int nM = T - tile0; nM = nM < 0 ? 0 : (nM > 64 ? 64 : nM);
            nM = __builtin_amdgcn_readfirstlane(nM);
            if (IN(14 + 2 * ch)) { pg8::Gemm g{(const char*)(ws + WS_XB), (const char*)(ws + WS_MGU), D, (size_t)2 * DFE * D * 2}; pg8::MoeOrder S{nM, DFE / 128, G, c, tile0, tab};
                pg8::EpiBf<3> E{(bf16*)(ws + WS_HM), nullptr, DFE, nullptr, nullptr, nullptr}; pg8::AGather al{(const int*)(ws + WS_ROWTOK), (unsigned)D * 2u};
                pg8::gemm_phase(F.lds, g, S, E, al); }
            SEAM(14 + 2 * ch);
            if (IN(15 + 2 * ch)) { pg8::Gemm g{(const char*)(ws + WS_HM), (const char*)(ws + WS_MDN), DFE, (size_t)D * DFE * 2}; pg8::MoeOrder S{nM, 4, G, c, tile0, tab};
                pg8::EpiBf<4> E{(bf16*)(ws + WS_Y2), nullptr, D, nullptr, (const int*)(ws + WS_ROWDST), (const float*)(ws + WS_ROWGATE)}; pg8::ADense al{(unsigned)DFE * 2u};
                pg8::gemm_phase(F.lds, g, S, E, al); }
            SEAM(15 + 2 * ch);
        }
    }
    if (IN(24)) { ln_phase<2>(F, args, lng + 3 * D, lnb + 3 * D); }
#undef IN
#undef SEAM
}

extern "C" void kernel_launch(void* const* d_in, const int* in_sizes, int n_in, void* d_out, int out_size, void* d_ws, size_t ws_size, hipStream_t stream) {
    static int grid = 0;
    if (grid == 0) {
        if (n_in != 25 || in_sizes[0] != M * D || out_size != M * D || ws_size < WS_END) { fprintf(stderr, "kernel_launch: unexpected shapes (n_in %d, in0 %d, out %d, ws %zu); nothing launched\n", n_in, n_in > 0 ? in_sizes[0] : -1, out_size, ws_size); grid = -1; return; }
        int dev = 0, cus = 0, per_cu = 0;
        if (hipGetDevice(&dev) != hipSuccess || hipDeviceGetAttribute(&cus, hipDeviceAttributeMultiprocessorCount, dev) != hipSuccess) { grid = -1; return; }
        if (hipFuncSetAttribute((const void*)fwd, hipFuncAttributeMaxDynamicSharedMemorySize, LDS_BYTES) != hipSuccess) { fprintf(stderr, "kernel_launch: hipFuncSetAttribute failed\n"); grid = -1; return; }
        if (hipOccupancyMaxActiveBlocksPerMultiprocessor(&per_cu, (const void*)fwd, NTHREADS, LDS_BYTES) != hipSuccess || per_cu < 1) fprintf(stderr, "kernel_launch: occupancy query reports %d\n", per_cu);
        (void)hipGetLastError();
        grid = cus;
    }
    if (grid < 0) return;
    if (hipMemsetAsync((char*)d_ws + WS_CTL, 0, CTL_ZERO_BYTES, stream) != hipSuccess) return;
    Args a{};
    for (int i = 0; i < 25; ++i) a.in[i] = (const float*)d_in[i];
    a.out = (float*)d_out; a.ws = (unsigned char*)d_ws;
#if MK_ONE_LAUNCH
    a.ph_lo = 0; a.ph_hi = N_PHASES;
    hipLaunchKernelGGL(fwd, dim3(grid), dim3(NTHREADS), LDS_BYTES, stream, a);
#else
    for (int p = 0; p < N_PHASES; ++p) { a.ph_lo = p; a.ph_hi = p + 1; hipLaunchKernelGGL(fwd, dim3(grid), dim3(NTHREADS), LDS_BYTES, stream, a); }
#endif
}
```

```cpp
#include <hip/hip_runtime.h>
#include <cstdio>
#include <cstdint>

#ifndef REP_ATT
#define REP_ATT 1
#endif
#ifndef REP_SPA
#define REP_SPA 1
#endif
#ifndef REP_PRO
#define REP_PRO 1
#endif
#ifndef MK_ONE_LAUNCH
#define MK_ONE_LAUNCH 1
#endif

#define LAS __attribute__((address_space(3)))
#define GAS __attribute__((address_space(1)))
typedef unsigned short bf16;
typedef short bf16x8 __attribute__((ext_vector_type(8)));
typedef float f32x4 __attribute__((ext_vector_type(4)));
typedef float f32x2 __attribute__((ext_vector_type(2)));
typedef unsigned u32x4 __attribute__((ext_vector_type(4)));
typedef unsigned u32x2 __attribute__((ext_vector_type(2)));
typedef GAS unsigned gu32;

constexpr int NB = 16, SEQ = 2048, D = 1024, M = NB * SEQ;
constexpr int PW = 2048;
constexpr int INW = 2072;
constexpr int DFF = 2816, DFE = 3584, NEXP = 8, CAP = 32768;
constexpr int NCMP = 127;
constexpr float ALPHA = 1.4142135623730951f;
constexpr float LN_EPS = 1e-5f;
constexpr int NWAVES = 8, NTHREADS = 512;

constexpr size_t MiB = 1u << 20;
constexpr size_t WS_CTL = 0, CTL_ZERO_BYTES = 1 * MiB;
constexpr size_t WS_SMALL = 1 * MiB;
constexpr size_t WS_ROWTOK = 2 * MiB, WS_ROWDST = 3 * MiB, WS_ROWGATE = 4 * MiB;
constexpr size_t WS_WIN = 5 * MiB;
constexpr size_t WS_WC1 = 9 * MiB;
constexpr size_t WS_WO = 11 * MiB;
constexpr size_t WS_FGU = 13 * MiB;
constexpr size_t WS_FDN = 24 * MiB;
constexpr size_t WS_GIN = 30 * MiB;
constexpr size_t WS_GOUT = 34 * MiB;
constexpr size_t WS_MGU = 36 * MiB;
constexpr size_t WS_MDN = 148 * MiB;
constexpr size_t WS_XB = 204 * MiB;
constexpr size_t WS_BIG = 268 * MiB;
constexpr size_t WS_P = WS_BIG;
constexpr size_t WS_O = WS_BIG + 128 * MiB;
constexpr size_t WS_H = WS_BIG;
constexpr size_t WS_U = WS_BIG, WS_V = WS_BIG + 64 * MiB, WS_Z = WS_BIG + 128 * MiB;
constexpr size_t WS_HM = WS_BIG;
constexpr size_t WS_Y2 = WS_BIG + 112 * MiB;
constexpr size_t WS_GATES = 460 * MiB;
constexpr size_t WS_KC = 463 * MiB;
constexpr size_t WS_H1 = 480 * MiB;
constexpr size_t WS_KCC = 484 * MiB;
constexpr size_t WS_KCCB = 486 * MiB;
constexpr size_t WS_END = 508 * MiB;
static_assert(WS_Y2 + 128 * MiB <= WS_END && WS_H + (size_t)M * DFF * 2 <= WS_GATES && WS_KC + 17 * MiB <= WS_H1, "ws map");
constexpr int CW_BAR = 4096;
constexpr int CW_CNT = 16384;

constexpr int RING_BYTES = 131072;
constexpr int LDSCTL_OFF = RING_BYTES;
constexpr int LDS_STATS_OFF = RING_BYTES + 1024;
constexpr int LDS_MOE_OFF = RING_BYTES + 4096;
constexpr int LDS_BYTES = 147456;

#define LDS_WAIT() asm volatile("s_waitcnt lgkmcnt(0)" ::: "memory")
#define VM_WAIT() asm volatile("s_waitcnt vmcnt(0)" ::: "memory")
__device__ __forceinline__ unsigned f2bf(float f) { unsigned u = __builtin_bit_cast(unsigned, f); return (u + 0x7fffu + ((u >> 16) & 1u)) >> 16; }
__device__ __forceinline__ unsigned pk2(float lo, float hi) { return f2bf(lo) | (f2bf(hi) << 16); }
__device__ __forceinline__ float bflo(unsigned u) { return __builtin_bit_cast(float, u << 16); }
__device__ __forceinline__ float bfhi(unsigned u) { return __builtin_bit_cast(float, u & 0xffff0000u); }
__device__ __forceinline__ float bf2f(bf16 b) { return __builtin_bit_cast(float, (unsigned)b << 16); }
__device__ __forceinline__ float wave_sum(float v) {
#pragma unroll
    for (int o = 1; o < 64; o <<= 1) v += __shfl_xor(v, o);
    return v;
}
__device__ __forceinline__ float wave_max(float v) {
#pragma unroll
    for (int o = 1; o < 64; o <<= 1) v = fmaxf(v, __shfl_xor(v, o));
    return v;
}
__device__ __forceinline__ float gelu_tanh(float x) {
    const float u = 0.7978845608028654f * (x + 0.044715f * x * x * x);
    return x / (1.0f + __expf(-2.0f * u));
}
__device__ __forceinline__ float silu(float x) { return x / (1.0f + __expf(-x)); }
__device__ __forceinline__ float sigmoidf(float x) { return 1.0f / (1.0f + __expf(-x)); }

namespace pg8 {
constexpr int BM = 256, BK = 64, HALF = 128, HTB = HALF * BK * 2, STAGE_BYTES = 8 * HTB, NXCD = 8, WGM = 8;
__host__ __device__ __forceinline__ int lds_byte(int r, int c) { const int st = (r >> 4) * 2 + (c >> 5), rr = r & 15, cc = c & 31, ob = rr * 64 + cc * 2; return st * 1024 + (ob ^ (((ob >> 9) & 1) << 5)); }
__host__ __device__ __forceinline__ void stage_rc(int b, int& R, int& C) { const int st = b / 1024, sb = b % 1024, swz = sb ^ (((sb >> 9) & 1) << 5); R = (st >> 1) * 16 + swz / 64; C = (st & 1) * 32 + (swz % 64) / 2; }
__host__ __device__ __forceinline__ int perm32(int rho) { const int n = rho >> 4, i = rho & 15; return 8 * (i >> 2) + 4 * n + (i & 3); }

struct Unit { int pm, pn, e, te, ne; };
struct Gemm { const char* A; const char* Bt; int K; size_t eStrideB; };

struct ADense { unsigned pitchB; __device__ __forceinline__ unsigned operator()(const Unit& u, int R) const { return (unsigned)(u.pm * 256 + R) * pitchB; } };
struct AGather { const int* rowtok; unsigned pitchB;
    __device__ __forceinline__ unsigned operator()(const Unit& u, int R) const { const int ri = u.te * 256 + R; const int tok = ri < u.ne ? rowtok[u.e * CAP + ri] : 0; return (unsigned)tok * pitchB; } };

__device__ __forceinline__ bool static_unit(int i, int G, int c, int nM, int nN, int& pm, int& pn) {
    const int nwg = nM * nN; const long L = (long)i * G + c; if (L >= nwg) return false;
    int wgid = (int)L; { const int q = nwg / NXCD, r = nwg % NXCD, xcd = wgid % NXCD, off = wgid / NXCD; wgid = (xcd < r ? xcd * (q + 1) : r * (q + 1) + (xcd - r) * q) + off; }
    const int nig = WGM * nN, gid = wgid / nig, fm = gid * WGM, gsz = (nM - fm) < WGM ? (nM - fm) : WGM;
    pm = fm + ((wgid % nig) % gsz); pn = (wgid % nig) / gsz; return true;
}
struct StaticOrder { int nM, nN, G, c;
    __device__ __forceinline__ bool next(int i, Unit& u) const { u.e = 0; u.te = 0; u.ne = 0; return static_unit(i, G, c, nM, nN, u.pm, u.pn); } };
struct CmpOrder { int c;
    __device__ __forceinline__ bool next(int i, Unit& u) const { if (i > 0 || c >= 32) return false; u.pm = c; u.pn = 0; u.e = c >> 4; u.te = 0; u.ne = 0; return true; } };
struct MoeOrder { int nM, nN, G, c, tile0; const LAS int* tab;
    __device__ __forceinline__ bool next(int i, Unit& u) const {
        int pm, pn; if (!static_unit(i, G, c, nM, nN, pm, pn)) return false;
        const int ct = tile0 + pm; int e = 0;
#pragma unroll
        for (int k = 1; k < 8; ++k) e += (ct >= tab[8 + k]) ? 1 : 0;
        e = __builtin_amdgcn_readfirstlane(e);
        u.pm = pm; u.pn = pn; u.e = e; u.te = __builtin_amdgcn_readfirstlane(ct - tab[8 + e]); u.ne = __builtin_amdgcn_readfirstlane(tab[e]); return true; } };

__device__ __forceinline__ u32x4 pack8(const f32x4& a, const f32x4& b) { u32x4 w; w.x = pk2(a[0], a[1]); w.y = pk2(a[2], a[3]); w.z = pk2(b[0], b[1]); w.w = pk2(b[2], b[3]); return w; }

struct EpiRes {
    static constexpr bool PERM = false;
    const float* res; float* out; float alpha;
    __device__ __forceinline__ void operator()(const f32x4 (&acc)[2][2][4][2], const Unit& u, int wr, int wc, int fr, int fq) const {
        const int row0 = u.pm * BM + wr * 64 + fr, col0 = u.pn * BM + wc * 32 + 4 * fq;
#pragma unroll
        for (int ai = 0; ai < 2; ++ai)
#pragma unroll
            for (int m = 0; m < 4; ++m) { const size_t off = (size_t)(row0 + ai * HALF + m * 16) * D + col0;
#pragma unroll
                for (int bj = 0; bj < 2; ++bj)
#pragma unroll
                    for (int n = 0; n < 2; ++n) { const size_t o = off + bj * HALF + n * 16; const f32x4 r = *(const f32x4*)(res + o); *(f32x4*)(out + o) = acc[ai][bj][m][n] + alpha * r; } }
    }
};
template <int MODE> struct EpiBf {
    static constexpr bool PERM = true;
    bf16* O; bf16* O2; int ldc; const float* bias; const int* rowdst; const float* rowgate;
    __device__ __forceinline__ void operator()(const f32x4 (&acc)[2][2][4][2], const Unit& u, int wr, int wc, int fr, int fq) const {
        const int lr0 = wr * 64 + fr, ct = wc * 32 + 8 * fq;
#pragma unroll
        for (int ai = 0; ai < 2; ++ai)
#pragma unroll
            for (int m = 0; m < 4; ++m) {
                const int lr = lr0 + ai * HALF + m * 16; const int row = u.pm * BM + lr;
                if (MODE == 0) {
#pragma unroll
                    for (int bj = 0; bj < 2; ++bj) { const u32x4 w = pack8(acc[ai][bj][m][0], acc[ai][bj][m][1]);
                        *(u32x4*)(O + (size_t)row * PW + u.pn * BM + bj * HALF + ct) = w;
                        if (u.pn == 5) { const int b = row >> 11, t = row & 2047, hh = wc >> 1, d = (wc & 1) * 32 + 8 * fq;
                            *(u32x4*)(O2 + ((size_t)((bj * 32 + b * 2 + hh) * 2048 + t)) * 64 + d) = w; } }
                } else if (MODE == 1) {
#pragma unroll
                    for (int bj = 0; bj < 2; ++bj) { const int col = bj * HALF + ct; const float* bp = bias + u.e * 256 + col;
                        const f32x4 b0 = *(const f32x4*)bp, b1 = *(const f32x4*)(bp + 4); f32x4 v0 = acc[ai][bj][m][0] + b0, v1 = acc[ai][bj][m][1] + b1;
#pragma unroll
                        for (int j = 0; j < 4; ++j) { v0[j] = gelu_tanh(v0[j]); v1[j] = gelu_tanh(v1[j]); }
                        *(u32x4*)(O + (size_t)row * 256 + col) = pack8(v0, v1); }
                } else if (MODE == 2) {
                    bf16* dst = (u.pn < 4) ? O : O2;
#pragma unroll
                    for (int bj = 0; bj < 2; ++bj) { f32x4 v0 = acc[ai][bj][m][0], v1 = acc[ai][bj][m][1];
#pragma unroll
                        for (int j = 0; j < 4; ++j) { v0[j] = gelu_tanh(v0[j]); v1[j] = gelu_tanh(v1[j]); }
                        *(u32x4*)(dst + (size_t)row * D + (u.pn & 3) * BM + bj * HALF + ct) = pack8(v0, v1); }
                } else if (MODE == 3) {
                    f32x4 v0, v1;
#pragma unroll
                    for (int j = 0; j < 4; ++j) { v0[j] = silu(acc[ai][0][m][0][j]) * acc[ai][1][m][0][j]; v1[j] = silu(acc[ai][0][m][1][j]) * acc[ai][1][m][1][j]; }
                    *(u32x4*)(O + (size_t)row * ldc + u.pn * HALF + ct) = pack8(v0, v1);
                } else {
                    const int gi = u.te * 256 + lr;
                    if (gi < u.ne) { const int dst = rowdst[u.e * CAP + gi]; const float gt = rowgate[u.e * CAP + gi];
#pragma unroll
                        for (int bj = 0; bj < 2; ++bj) { const f32x4 v0 = acc[ai][bj][m][0] * gt, v1 = acc[ai][bj][m][1] * gt;
                            *(u32x4*)(O + (size_t)dst * D + u.pn * BM + bj * HALF + ct) = pack8(v0, v1); } }
                }
            }
    }
};

template <class Epi, class Sched, class AL>
__device__ __forceinline__ void gemm_phase(LAS unsigned char* lds, const Gemm g, const Sched& S, const Epi& E, const AL& al) {
    const int tid = threadIdx.x, wid = __builtin_amdgcn_readfirstlane(tid >> 6), lane = tid & 63, wr = wid >> 2, wc = wid & 3, fr = lane & 15, fq = lane >> 4;
    const int K = g.K, nt = K / BK;
    int Rs[2]; unsigned Cb[2], voffB[2];
#pragma unroll
    for (int i = 0; i < 2; ++i) { int R, C; stage_rc(tid * 16 + i * 8192, R, C); const int Rb = Epi::PERM ? ((R & ~31) + perm32(R & 31)) : R;
        Rs[i] = R; Cb[i] = (unsigned)C * 2u; voffB[i] = (unsigned)(Rb * K + C) * 2u; }
    const size_t kstep = (size_t)(BK * 2);
    const size_t hstepB = (size_t)HALF * K * 2;
    const size_t tstepB = 2 * hstepB;
    const unsigned ldsw = (unsigned)wid * 1024u;
    const int aoff = lds_byte(wr * 64 + fr, fq * 8), boff = lds_byte(wc * 32 + fr, fq * 8);
#define PG8_SA(b, h) (((b) * 2 + (h)) * HTB)
#define PG8_SB(b, h) ((4 + (b) * 2 + (h)) * HTB)
#define PG8_STAGE(bufoff, gbase, voff) do { _Pragma("unroll") for (int _i = 0; _i < 2; ++_i) \
        __builtin_amdgcn_global_load_lds((const unsigned*)((const char*)(gbase) + (voff)[_i]), (LAS unsigned*)(lds + (bufoff) + ldsw + _i * 8192), 16, 0, 0); } while (0)
#define PG8_LDA(dst, b, h) do { _Pragma("unroll") for (int m = 0; m < 4; ++m) _Pragma("unroll") for (int k = 0; k < 2; ++k) dst[m][k] = *(const LAS bf16x8*)(lds + PG8_SA(b, h) + aoff + m * 2048 + k * 1024); } while (0)
#define PG8_LDB(dst, b, h) do { _Pragma("unroll") for (int n = 0; n < 2; ++n) _Pragma("unroll") for (int k = 0; k < 2; ++k) dst[n][k] = *(const LAS bf16x8*)(lds + PG8_SB(b, h) + boff + n * 2048 + k * 1024); } while (0)
#define PG8_MMA(ai, bj, At, Bt) do { __builtin_amdgcn_s_setprio(1); _Pragma("unroll") for (int m = 0; m < 4; ++m) _Pragma("unroll") for (int n = 0; n < 2; ++n) _Pragma("unroll") for (int k = 0; k < 2; ++k) \
        acc[ai][bj][m][n] = __builtin_amdgcn_mfma_f32_16x16x32_bf16(Bt[n][k], At[m][k], acc[ai][bj][m][n], 0, 0, 0); __builtin_amdgcn_s_setprio(0); } while (0)
#define PG8_WAIT_V(n) asm volatile("s_waitcnt vmcnt(" #n ")" ::: "memory")
#define PG8_WAIT_L(n) asm volatile("s_waitcnt lgkmcnt(" #n ")" ::: "memory")
#define PG8_BAR __builtin_amdgcn_s_barrier()
#define PG8_SCHED __builtin_amdgcn_sched_barrier(0)
#define PG8_VOFF(dst, u) do { _Pragma("unroll") for (int _h = 0; _h < 2; ++_h) _Pragma("unroll") for (int _i = 0; _i < 2; ++_i) dst[_h][_i] = al(u, _h * HALF + Rs[_i]) + Cb[_i]; } while (0)
    Unit cur, nxt; int ui = 0;
    if (!S.next(0, cur)) return;
    f32x4 acc[2][2][4][2];
#pragma unroll
    for (int a = 0; a < 2; ++a)
#pragma unroll
        for (int b = 0; b < 2; ++b)
#pragma unroll
            for (int m = 0; m < 4; ++m)
#pragma unroll
                for (int n = 0; n < 2; ++n) acc[a][b][m][n] = (f32x4){0.f, 0.f, 0.f, 0.f};
    bf16x8 At[4][2], B0[2][2], B1[2][2];
    unsigned vC[2][2], vP[2][2], vN[2][2];
    PG8_VOFF(vC, cur);
#pragma unroll
    for (int h = 0; h < 2; ++h)
#pragma unroll
        for (int i = 0; i < 2; ++i) vP[h][i] = vC[h][i];
    const char* const A0 = g.A;
    const char* cB = g.Bt + (size_t)cur.e * g.eStrideB + (size_t)cur.pn * tstepB;
    PG8_STAGE(PG8_SB(0, 0), cB, voffB); PG8_STAGE(PG8_SB(0, 1), cB + hstepB, voffB); PG8_STAGE(PG8_SA(0, 0), A0, vC[0]); PG8_STAGE(PG8_SA(0, 1), A0, vC[1]);
    if (wr == 1) PG8_BAR;
    PG8_WAIT_V(2); PG8_BAR;
    PG8_STAGE(PG8_SB(1, 0), cB + kstep, voffB); PG8_STAGE(PG8_SA(1, 0), A0 + kstep, vC[0]); PG8_STAGE(PG8_SB(1, 1), cB + hstepB + kstep, voffB);
    PG8_WAIT_V(6); PG8_BAR;
    for (;;) {
        const bool has_next = S.next(ui + 1, nxt);
        const char* nB = cB;
        if (has_next) { PG8_VOFF(vN, nxt); nB = g.Bt + (size_t)nxt.e * g.eStrideB + (size_t)nxt.pn * tstepB; }
        else {
#pragma unroll
            for (int h = 0; h < 2; ++h)
#pragma unroll
                for (int i = 0; i < 2; ++i) vN[h][i] = vC[h][i]; }
        for (int t = 0; t < nt; t += 2) {
            const bool last = (t == nt - 2);
            if (last) {
#pragma unroll
                for (int h = 0; h < 2; ++h)
#pragma unroll
                    for (int i = 0; i < 2; ++i) vP[h][i] = vN[h][i]; }
            const char* a1 = A0 + (size_t)(t + 1) * kstep;
            const char* a2 = last ? A0 : A0 + (size_t)(t + 2) * kstep; const char* b2 = last ? nB : cB + (size_t)(t + 2) * kstep;
            const char* a3 = a2 + kstep; const char* b3 = b2 + kstep;
            PG8_LDB(B0, 0, 0); PG8_LDB(B1, 0, 1); PG8_SCHED; PG8_LDA(At, 0, 0); PG8_STAGE(PG8_SA(1, 1), a1, vC[1]);
            PG8_WAIT_V(8); PG8_WAIT_L(0); PG8_BAR; PG8_MMA(0, 0, At, B0); PG8_MMA(0, 1, At, B1); PG8_BAR; PG8_SCHED;
            PG8_LDA(At, 0, 1); PG8_STAGE(PG8_SB(0, 0), b2, voffB); PG8_STAGE(PG8_SB(0, 1), b2 + hstepB, voffB); PG8_STAGE(PG8_SA(0, 0), a2, vP[0]);
            PG8_WAIT_V(8); PG8_WAIT_L(0); PG8_BAR; PG8_MMA(1, 0, At, B0); PG8_MMA(1, 1, At, B1); PG8_BAR; PG8_SCHED;
            PG8_LDB(B0, 1, 0); PG8_LDB(B1, 1, 1); PG8_SCHED; PG8_LDA(At, 1, 0); PG8_STAGE(PG8_SA(0, 1), a2, vP[1]);
            PG8_WAIT_V(8); PG8_WAIT_L(0); PG8_BAR; PG8_MMA(0, 0, At, B0); PG8_MMA(0, 1, At, B1); PG8_BAR; PG8_SCHED;
            PG8_LDA(At, 1, 1); PG8_STAGE(PG8_SB(1, 0), b3, voffB); PG8_STAGE(PG8_SB(1, 1), b3 + hstepB, voffB); PG8_STAGE(PG8_SA(1, 0), a3, vP[0]);
            PG8_WAIT_V(8); PG8_WAIT_L(0); PG8_BAR; PG8_MMA(1, 0, At, B0); PG8_MMA(1, 1, At, B1); PG8_BAR; PG8_SCHED;
        }
        if (wr == 0) PG8_BAR;
        E(acc, cur, wr, wc, fr, fq);
        if (!has_next) break;
#pragma unroll
        for (int a = 0; a < 2; ++a)
#pragma unroll
            for (int b = 0; b < 2; ++b)
#pragma unroll
                for (int m = 0; m < 4; ++m)
#pragma unroll
                    for (int n = 0; n < 2; ++n) acc[a][b][m][n] = (f32x4){0.f, 0.f, 0.f, 0.f};
        cur = nxt; cB = nB; ++ui;
#pragma unroll
        for (int h = 0; h < 2; ++h)
#pragma unroll
            for (int i = 0; i < 2; ++i) vC[h][i] = vP[h][i];
        if (wr == 1) PG8_BAR;
    }
    PG8_WAIT_V(0);
    PG8_BAR;
#undef PG8_SA
#undef PG8_SB
#undef PG8_STAGE
#undef PG8_LDA
#undef PG8_LDB
#undef PG8_MMA
#undef PG8_WAIT_V
#undef PG8_WAIT_L
#undef PG8_BAR
#undef PG8_SCHED
#undef PG8_VOFF
}
}

#define XB_TMO      128
#define XB_XCNT(j)  (256  + 64 * (j))
#define XB_XSUB(j)  (1280 + 64 * (j))
#define XB_XGEN(j)  (2304 + 64 * (j))
#define XB_TOP      3328
#define XB_TOPGEN   3392
#define XCD_BAR_WORDS 3456
#define XB_SPIN_CAP (1u << 18)
__device__ __forceinline__ unsigned xb_ld(unsigned* p)              { return __hip_atomic_load(p, __ATOMIC_RELAXED, __HIP_MEMORY_SCOPE_AGENT); }
__device__ __forceinline__ unsigned xb_add(unsigned* p, unsigned v) { return __hip_atomic_fetch_add(p, v, __ATOMIC_RELAXED, __HIP_MEMORY_SCOPE_AGENT); }
__device__ __forceinline__ unsigned xb_xcc_id() { return (unsigned)__builtin_amdgcn_s_getreg((3 << 11) | 20) & 0xFu; }
#define XB_SPIN(cond, bar) do { unsigned _sp = 0; while (cond) { __builtin_amdgcn_s_sleep(1); \
    if ((++_sp & 255u) == 0u) { if (xb_ld(&(bar)[XB_TMO])) break; if (_sp > XB_SPIN_CAP) { atomicAdd(&(bar)[XB_TMO], 1u); break; } } } } while (0)
struct XcdBarrier { unsigned* bar; unsigned x; volatile LAS unsigned* st; };
__device__ __forceinline__ XcdBarrier xcd_barrier_post(unsigned* bar, volatile LAS unsigned* st) {
    XcdBarrier b; b.bar = bar; b.x = xb_xcc_id(); b.st = st;
    if (threadIdx.x == 0) (void)xb_add(&bar[XB_XCNT(b.x)], 1u);
    return b;
}
__device__ __forceinline__ void xcd_barrier_complete(unsigned* bar, unsigned x, unsigned& nloc, unsigned& nx) {
    const unsigned G = gridDim.x * gridDim.y * gridDim.z;
    unsigned sum, cnt, mine, sp = 0u;
    for (;;) {
        sum = 0u; cnt = 0u; mine = 0u;
#pragma unroll
        for (unsigned j = 0; j < 16; ++j) { const unsigned c = xb_ld(&bar[XB_XCNT(j)]); sum += c; cnt += (c > 0u) ? 1u : 0u; mine = (j == x) ? c : mine; }
        if (sum == G) break;
        __builtin_amdgcn_s_sleep(1);
        if ((++sp & 255u) == 0u) { if (xb_ld(&bar[XB_TMO])) break; if (sp > XB_SPIN_CAP) { atomicAdd(&bar[XB_TMO], 1u); break; } }
    }
    nloc = mine > 0u ? mine : 1u; nx = cnt > 0u ? cnt : 1u;
}
__device__ __forceinline__ void xcd_barrier(const XcdBarrier& b) {
    asm volatile("s_waitcnt vmcnt(0)" ::: "memory");
    __syncthreads();
    if (threadIdx.x == 0) {
        unsigned* bar = b.bar;
        __builtin_amdgcn_s_waitcnt(0);
        unsigned nloc = b.st[0], nx = b.st[1];
        if (nloc == 0u) { xcd_barrier_complete(bar, b.x, nloc, nx); b.st[0] = nloc; b.st[1] = nx; }
        const unsigned old = xb_add(&bar[XB_XSUB(b.x)], 1u);
        const unsigned gen = old / nloc;
        if (old + 1u == (gen + 1u) * nloc) {
            __builtin_amdgcn_fence(__ATOMIC_RELEASE, "agent");
            asm volatile("s_waitcnt vmcnt(0)" ::: "memory");
            const unsigned og = xb_add(&bar[XB_TOP], 1u);
            const unsigned tg = og / nx;
            if (og + 1u == (tg + 1u) * nx) xb_add(&bar[XB_TOPGEN], 1u);
            else XB_SPIN(xb_ld(&bar[XB_TOPGEN]) == tg, bar);
            __builtin_amdgcn_fence(__ATOMIC_ACQUIRE, "agent");
            xb_add(&bar[XB_XGEN(b.x)], 1u);
            asm volatile("s_waitcnt vmcnt(0)" ::: "memory");
        } else {
            XB_SPIN(xb_ld(&bar[XB_XGEN(b.x)]) == gen, bar);
            __builtin_amdgcn_fence(__ATOMIC_ACQUIRE, "agent");
            asm volatile("s_waitcnt vmcnt(0)" ::: "memory");
        }
    }
    __syncthreads();
}

struct Args {
    const float* in[25]; float* out; unsigned char* ws; int ph_lo, ph_hi;
};
struct Frame {
    LAS unsigned char* lds; gu32* ctl; unsigned char* ws;
    int tid, lane, wave, vcu, G;
};
enum { I_X = 0, I_WIN, I_SINK, I_PEK, I_WK1, I_WK2, I_PEV, I_WV1, I_WV2, I_WO, I_FG, I_FU, I_FD, I_GIN, I_GLNG, I_GLNB, I_GWS, I_GBS, I_GOUT, I_RT, I_MG, I_MU, I_MD, I_LNG, I_LNB };

__device__ __forceinline__ void tr_item(const float* W, int pitch, int k0, int n0, bf16* dst, int ldk, LAS float* scr, int lane) {
#pragma unroll 8
    for (int i = 0; i < 32; ++i) { const int kk = 2 * i + (lane >> 5); scr[kk * 33 + (lane & 31)] = W[(size_t)(k0 + kk) * pitch + n0 + (lane & 31)]; }
    LDS_WAIT(); asm volatile("" ::: "memory");
    const int c = lane & 7;
#pragma unroll
    for (int j = 0; j < 4; ++j) { const int n = (lane >> 3) + 8 * j; const LAS float* s = scr + (8 * c) * 33 + n;
        u32x4 o; o.x = pk2(s[0 * 33], s[1 * 33]); o.y = pk2(s[2 * 33], s[3 * 33]); o.z = pk2(s[4 * 33], s[5 * 33]); o.w = pk2(s[6 * 33], s[7 * 33]);
        *(u32x4*)(dst + (size_t)n * ldk + 8 * c) = o; }
    LDS_WAIT(); asm volatile("" ::: "memory");
}
__device__ __forceinline__ void tr_matrix_item(const float* W, int pitch, int K, int N, bf16* WT, int inter_up  , LAS float* scr, int item, int lane) {
    const int nblk = N / 32, kb = item / nblk, nb = item % nblk, k0 = 64 * kb, n0 = 32 * nb;
    const int drow = inter_up < 0 ? n0 : ((n0 >> 7) * 256 + (n0 & 127) + inter_up * 128);
    tr_item(W, pitch, k0, n0, WT + (size_t)drow * K + k0, K, scr, lane);
}

__device__ __forceinline__ void p0_prologue(Frame& F, const Args& a) {
    LAS float* scr = (LAS float*)(F.lds + F.wave * 16384);
    const int gw = F.vcu * NWAVES + F.wave, NGW = F.G * NWAVES;
    unsigned char* ws = F.ws;
    constexpr int IT_WIN = (D / 64) * (2048 / 32), IT_C1 = (2048 / 64) * (256 / 32), IT_SQ = (D / 64) * (D / 32), IT_FG = (D / 64) * (DFF / 32), IT_FD = (DFF / 64) * (D / 32),
                  IT_GIN = (D / 64) * (2048 / 32), IT_MG = (D / 64) * (DFE / 32), IT_MD = (DFE / 64) * (D / 32);
    constexpr int NITEMS = IT_WIN + 2 * IT_C1 + IT_SQ + 2 * IT_FG + IT_FD + IT_GIN + IT_SQ + NEXP * (2 * IT_MG + IT_MD);
    for (int it = gw; it < NITEMS; it += NGW) {
        int r = it;
        if (r < IT_WIN) { tr_matrix_item(a.in[I_WIN], INW, D, 2048, (bf16*)(ws + WS_WIN), -1, scr, r, F.lane); continue; } r -= IT_WIN;
        if (r < IT_C1) { tr_matrix_item(a.in[I_WK1], 256, 2048, 256, (bf16*)(ws + WS_WC1), -1, scr, r, F.lane); continue; } r -= IT_C1;
        if (r < IT_C1) { tr_matrix_item(a.in[I_WV1], 256, 2048, 256, (bf16*)(ws + WS_WC1) + 256 * 2048, -1, scr, r, F.lane); continue; } r -= IT_C1;
        if (r < IT_SQ) { tr_matrix_item(a.in[I_WO], D, D, D, (bf16*)(ws + WS_WO), -1, scr, r, F.lane); continue; } r -= IT_SQ;
        if (r < IT_FG) { tr_matrix_item(a.in[I_FG], DFF, D, DFF, (bf16*)(ws + WS_FGU), 0, scr, r, F.lane); continue; } r -= IT_FG;
        if (r < IT_FG) { tr_matrix_item(a.in[I_FU], DFF, D, DFF, (bf16*)(ws + WS_FGU), 1, scr, r, F.lane); continue; } r -= IT_FG;
        if (r < IT_FD) { tr_matrix_item(a.in[I_FD], D, DFF, D, (bf16*)(ws + WS_FDN), -1, scr, r, F.lane); continue; } r -= IT_FD;
        if (r < IT_GIN) { tr_matrix_item(a.in[I_GIN], 2048, D, 2048, (bf16*)(ws + WS_GIN), -1, scr, r, F.lane); continue; } r -= IT_GIN;
        if (r < IT_SQ) { tr_matrix_item(a.in[I_GOUT], D, D, D, (bf16*)(ws + WS_GOUT), -1, scr, r, F.lane); continue; } r -= IT_SQ;
        { const int per_e = 2 * IT_MG + IT_MD; const int e = r / per_e; int q = r % per_e;
          if (q < IT_MG) { tr_matrix_item(a.in[I_MG] + (size_t)e * D * DFE, DFE, D, DFE, (bf16*)(ws + WS_MGU) + (size_t)e * 2 * DFE * D, 0, scr, q, F.lane); continue; } q -= IT_MG;
          if (q < IT_MG) { tr_matrix_item(a.in[I_MU] + (size_t)e * D * DFE, DFE, D, DFE, (bf16*)(ws + WS_MGU) + (size_t)e * 2 * DFE * D, 1, scr, q, F.lane); continue; } q -= IT_MG;
          tr_matrix_item(a.in[I_MD] + (size_t)e * DFE * D, D, DFE, D, (bf16*)(ws + WS_MDN) + (size_t)e * D * DFE, -1, scr, q, F.lane); }
    }
    if (blockIdx.x < 16) {
        const int kv = blockIdx.x >> 3, n = (blockIdx.x & 7) * 32 + (F.tid & 31), ks = F.tid >> 5;
        const float* pe = a.in[kv ? I_PEV : I_PEK]; const float* w1 = a.in[kv ? I_WV1 : I_WK1]; float* b1 = (float*)(ws + WS_SMALL) + kv * 256;
        float sacc = 0.f;
#pragma unroll 8
        for (int k = ks * 128; k < ks * 128 + 128; ++k) sacc += pe[k] * w1[(size_t)k * 256 + n];
        LAS float* red = (LAS float*)(F.lds + 124 * 1024);
        red[F.tid] = sacc; __syncthreads();
        if (F.tid < 32) { float t = 0.f; for (int q = 0; q < 16; ++q) t += red[q * 32 + F.tid]; b1[n] = t; }
        __syncthreads();
    }
    {
        const float* x = a.in[I_X]; const float* win = a.in[I_WIN]; bf16* xb = (bf16*)(ws + WS_XB); float* gates = (float*)(ws + WS_GATES);
        LAS float* wg = (LAS float*)F.lds;
        __syncthreads();
        for (int i = F.tid; i < 24 * 1024; i += NTHREADS) { const int ch = i / 24, q = i % 24; wg[q * 1024 + ch] = win[(size_t)ch * INW + 2048 + q]; }
        __syncthreads();
        for (int m = gw; m < M; m += NGW) {
            const f32x4* xr = (const f32x4*)(x + (size_t)m * D) + F.lane; f32x4 v[4];
#pragma unroll
            for (int j = 0; j < 4; ++j) v[j] = xr[64 * j];
            unsigned long long* o8 = (unsigned long long*)(xb + (size_t)m * D) + F.lane;
#pragma unroll
            for (int j = 0; j < 4; ++j) o8[64 * j] = (unsigned long long)pk2(v[j][0], v[j][1]) | ((unsigned long long)pk2(v[j][2], v[j][3]) << 32);
            float mine = 0.f;
#pragma unroll 2
            for (int q = 0; q < 24; ++q) { float gq = 0.f;
#pragma unroll
                for (int j = 0; j < 4; ++j) { const f32x4 wv = *(const LAS f32x4*)(wg + q * 1024 + 256 * j + 4 * F.lane); gq += v[j][0] * wv[0] + v[j][1] * wv[1] + v[j][2] * wv[2] + v[j][3] * wv[3]; }
                gq = wave_sum(gq); mine = (F.lane == q) ? gq : mine; }
            if (F.lane < 24) gates[(size_t)m * 24 + F.lane] = mine;
        }
        __syncthreads();
    }
    if (blockIdx.x == 2 && F.tid < 256) ((u32x4*)(ws + WS_KC + (size_t)2 * 32 * 2048 * 64 * 2))[F.tid] = (u32x4){0u, 0u, 0u, 0u};
}

__device__ __forceinline__ void load_q(float (&q)[64], const bf16* qp, float scale) {
#pragma unroll
    for (int i = 0; i < 8; ++i) { const u32x4 v = ((const u32x4*)qp)[i];
        q[8 * i + 0] = bflo(v.x) * scale; q[8 * i + 1] = bfhi(v.x) * scale; q[8 * i + 2] = bflo(v.y) * scale; q[8 * i + 3] = bfhi(v.y) * scale;
        q[8 * i + 4] = bflo(v.z) * scale; q[8 * i + 5] = bfhi(v.z) * scale; q[8 * i + 6] = bflo(v.w) * scale; q[8 * i + 7] = bfhi(v.w) * scale; }
}
__device__ __forceinline__ float dot_bf(const float (&q)[64], const bf16* kp) {
    float s = 0.f;
#pragma unroll
    for (int i = 0; i < 8; ++i) { const u32x4 v = ((const u32x4*)kp)[i];
        s += q[8 * i + 0] * bflo(v.x) + q[8 * i + 1] * bfhi(v.x) + q[8 * i + 2] * bflo(v.y) + q[8 * i + 3] * bfhi(v.y)
           + q[8 * i + 4] * bflo(v.z) + q[8 * i + 5] * bfhi(v.z) + q[8 * i + 6] * bflo(v.w) + q[8 * i + 7] * bfhi(v.w); }
    return s;
}
__device__ __forceinline__ float dot_f32(const float (&q)[64], const float* kp) {
    float s = 0.f;
#pragma unroll
    for (int i = 0; i < 16; ++i) { const f32x4 v = ((const f32x4*)kp)[i]; s += q[4 * i] * v[0] + q[4 * i + 1] * v[1] + q[4 * i + 2] * v[2] + q[4 * i + 3] * v[3]; }
    return s;
}
__device__ __forceinline__ float pv_bf(float o, float e, const bf16* vbase, size_t pitch, int j0, int j1, int lane) {
    for (int j = j0; j < j1; ++j) { const float p = __builtin_bit_cast(float, __builtin_amdgcn_readlane(__builtin_bit_cast(int, e), j)); o += p * bf2f(vbase[(size_t)j * pitch + lane]); }
    return o;
}
__device__ __forceinline__ float pv_f32(float o, float e, const float* vbase, size_t pitch, int j0, int j1, int lane) {
    for (int j = j0; j < j1; ++j) { const float p = __builtin_bit_cast(float, __builtin_amdgcn_readlane(__builtin_bit_cast(int, e), j)); o += p * vbase[(size_t)j * pitch + lane]; }
    return o;
}
__device__ __forceinline__ float alibi_slope(int h) { return exp2f(-0.5f * (float)(h + 1)); }

__device__ __forceinline__ void p4_attention(Frame& F, const Args& a) {
    const int gw = F.vcu * NWAVES + F.wave, NGW = F.G * NWAVES, lane = F.lane;
    const bf16* P = (const bf16*)(F.ws + WS_P); bf16* O = (bf16*)(F.ws + WS_O);
    const float NINF = -__builtin_inff();
    for (int task = gw; task < M * 8; task += NGW) {
        const int m = task >> 3, h = task & 7, b = m >> 11, t = m & 2047, kvh = h >> 2;
        const float slope = alibi_slope(h), sink = a.in[I_SINK][h];
        float q[64]; load_q(q, P + (size_t)m * PW + h * 64, 0.125f);
        const bf16* Kb = P + (size_t)b * SEQ * PW + 512 + kvh * 64; const bf16* Vb = P + (size_t)b * SEQ * PW + 640 + kvh * 64;
        float s[2];
#pragma unroll
        for (int c = 0; c < 2; ++c) { const int kp = t - 127 + 64 * c + lane; const bool valid = kp >= 0; const int kc = valid ? kp : 0;
            const float d = dot_bf(q, Kb + (size_t)kc * PW); s[c] = valid ? d - slope * (float)(t - kp) : NINF; }
        float mx = fmaxf(wave_max(fmaxf(s[0], s[1])), sink);
        float e0 = __expf(s[0] - mx), e1 = __expf(s[1] - mx);
        const float den = wave_sum(e0 + e1) + __expf(sink - mx);
        float o = 0.f;
#pragma unroll
        for (int c = 0; c < 2; ++c) { const int base = t - 127 + 64 * c; const int j0 = base < 0 ? (-base < 64 ? -base : 64) : 0;
            o = pv_bf(o, c ? e1 : e0, Vb + (long)base * PW, PW, j0, 64, lane); }
        O[(size_t)m * D + h * 64 + lane] = (bf16)f2bf(o / den);
    }
    const float* KCC = (const float*)(F.ws + WS_KCC); const float* gates = (const float*)(F.ws + WS_GATES);
    LAS float* sc = (LAS float*)(F.lds + F.wave * 1024);
    for (int task = gw; task < M * 2; task += NGW) {
        const int m = task >> 1, hkv = task & 1, b = m >> 11, t = m & 2047, tb = t >> 6;
        const int nvc = t >= 31 ? ((t - 31) / 16 + 1 < NCMP ? (t - 31) / 16 + 1 : NCMP) : 0;
        const float* kcc = KCC + (size_t)((b * 2 + hkv) * 128) * 64; const float* vcc = KCC + (size_t)4096 * 64 + (size_t)((b * 2 + hkv) * 128) * 64;
        float oc0 = 0.f, oc1 = 0.f, oc2 = 0.f, oc3 = 0.f, ps0 = 0.f, ps1 = 0.f;
#pragma unroll 1
        for (int g = 0; g < 4; ++g) {
            const int hb = hkv * 4 + g; const float slope = alibi_slope(8 + hb);
            float q[64]; load_q(q, P + (size_t)m * PW + 768 + hb * 64, 0.125f);
            float s[2];
#pragma unroll
            for (int c = 0; c < 2; ++c) { const int cb = 64 * c + lane; const bool valid = cb < nvc;
                const float d = dot_f32(q, kcc + (size_t)cb * 64); s[c] = valid ? d - slope * (float)(t - (16 * cb + 31)) : NINF; }
            float mx = wave_max(fmaxf(s[0], s[1])); if (!(mx > NINF)) mx = 0.f;
            float e0 = (lane < nvc) ? __expf(s[0] - mx) : 0.f, e1 = (64 + lane < nvc) ? __expf(s[1] - mx) : 0.f;
            const float den = wave_sum(e0 + e1); const float inv = den > 0.f ? 1.0f / den : 1.0f;
            e0 *= inv; e1 *= inv; ps0 += e0; ps1 += e1;
            float o = 0.f;
            o = pv_f32(o, e0, vcc, 64, 0, nvc < 64 ? nvc : 64, lane);
            o = pv_f32(o, e1, vcc + 64 * 64, 64, 0, nvc > 64 ? nvc - 64 : 0, lane);
            oc0 = (g == 0) ? o : oc0; oc1 = (g == 1) ? o : oc1; oc2 = (g == 2) ? o : oc2; oc3 = (g == 3) ? o : oc3;
        }
        sc[lane] = ps0; sc[64 + lane] = ps1; LDS_WAIT(); asm volatile("" ::: "memory");
        float imp = 0.f;
        if (lane < 32) {
#pragma unroll
            for (int k = -1; k <= 3; ++k) { const int c = 4 * lane + k; if (c >= 0 && c < NCMP) imp += sc[c]; } }
        LDS_WAIT(); asm volatile("" ::: "memory");
        const bool validj = lane <= tb, forced = (lane == 0) || (lane == tb) || (lane == tb - 1);
        const float rank = (lane >= 32) ? NINF : (forced ? __builtin_inff() : (validj ? imp : NINF));
        int cnt = 0;
        for (int jj = 0; jj < 32; ++jj) { const float rj = __builtin_bit_cast(float, __builtin_amdgcn_readlane(__builtin_bit_cast(int, rank), jj)); cnt += (rj > rank || (rj == rank && jj < lane)) ? 1 : 0; }
        const unsigned selmask = (unsigned)__ballot(lane < 32 && cnt < 8 && validj);
#pragma unroll 1
        for (int g = 0; g < 4; ++g) {
            const int hb = hkv * 4 + g; const float slope = alibi_slope(8 + hb);
            float q[64]; load_q(q, P + (size_t)m * PW + 768 + hb * 64, 0.125f);
            float oslc = 0.f;
            {
                const bf16* Kb = P + (size_t)b * SEQ * PW + 1536 + hkv * 64; const bf16* Vb = P + (size_t)b * SEQ * PW + 1664 + hkv * 64;
                float s[8]; unsigned mm = selmask; float mx = NINF;
#pragma unroll
                for (int i = 0; i < 8; ++i) { s[i] = NINF;
                    if (mm) { const int j = __builtin_ctz(mm); mm &= mm - 1; const int kp = 64 * j + lane; const bool valid = kp <= t; const int kc = valid ? kp : t;
                        const float d = dot_bf(q, Kb + (size_t)kc * PW); s[i] = valid ? d - slope * (float)(t - kp) : NINF; }
                    mx = fmaxf(mx, s[i]); }
                mx = wave_max(mx);
                float den = 0.f;
#pragma unroll
                for (int i = 0; i < 8; ++i) { s[i] = __expf(s[i] - mx); den += s[i]; }
                den = wave_sum(den);
                mm = selmask;
#pragma unroll
                for (int i = 0; i < 8; ++i) { if (mm) { const int j = __builtin_ctz(mm); mm &= mm - 1; const int nk = (t - 64 * j + 1) < 64 ? (t - 64 * j + 1) : 64;
                        oslc = pv_bf(oslc, s[i], Vb + (size_t)(64 * j) * PW, PW, 0, nk, lane); } }
                oslc /= den;
            }
            float owin = 0.f;
            {
                const bf16* Kb = P + (size_t)b * SEQ * PW + 1792 + hkv * 64; const bf16* Vb = P + (size_t)b * SEQ * PW + 1920 + hkv * 64;
                float s[4]; float mx = NINF;
#pragma unroll
                for (int c = 0; c < 4; ++c) { const int kp = t - 255 + 64 * c + lane; const bool valid = kp >= 0; const int kc = valid ? kp : 0;
                    const float d = dot_bf(q, Kb + (size_t)kc * PW); s[c] = valid ? d - slope * (float)(t - kp) : NINF; mx = fmaxf(mx, s[c]); }
                mx = wave_max(mx);
                float den = 0.f;
#pragma unroll
                for (int c = 0; c < 4; ++c) { s[c] = __expf(s[c] - mx); den += s[c]; }
                den = wave_sum(den);
#pragma unroll
                for (int c = 0; c < 4; ++c) { const int base = t - 255 + 64 * c; const int j0 = base < 0 ? (-base < 64 ? -base : 64) : 0;
                    owin = pv_bf(owin, s[c], Vb + (long)base * PW, PW, j0, 64, lane); }
                owin /= den;
            }
            const float* gp = gates + (size_t)m * 24 + hb * 3;
            const float oc = (g == 0) ? oc0 : (g == 1) ? oc1 : (g == 2) ? oc2 : oc3;
            const float r = sigmoidf(gp[0]) * oc + sigmoidf(gp[1]) * oslc + sigmoidf(gp[2]) * owin;
            O[(size_t)m * D + 512 + hb * 64 + lane] = (bf16)f2bf(r);
        }
    }
}


namespace att {
typedef float f32x16 __attribute__((ext_vector_type(16)));
typedef short s16x4 __attribute__((ext_vector_type(4)));
typedef __bf16 bf16x2_t __attribute__((ext_vector_type(2)));
constexpr int KP = 144;
constexpr int TILEB = 64 * KP;
constexpr int BUFB = 2 * TILEB;
constexpr float LOG2E = 1.4426950408889634f;
__device__ __forceinline__ unsigned cvtpk(float lo, float hi) { f32x2 v = {lo, hi}; bf16x2_t b = __builtin_convertvector(v, bf16x2_t); return __builtin_bit_cast(unsigned, b); }
__device__ __forceinline__ f32x16 zero16() { f32x16 z;
#pragma unroll
    for (int i = 0; i < 16; ++i) z[i] = 0.f; return z; }
struct Stage { u32x4 k, v; };
__device__ __forceinline__ void stage_load(Stage& s, const bf16* Kg, const bf16* Vg, size_t pitch, int row0, int tid) {
    const int key = tid >> 3, ch = tid & 7; s.k = *(const u32x4*)(Kg + (size_t)(row0 + key) * pitch + ch * 8); s.v = *(const u32x4*)(Vg + (size_t)(row0 + key) * pitch + ch * 8); }
__device__ __forceinline__ void stage_store(const Stage& s, LAS unsigned char* buf, int tid) {
    const int key = tid >> 3, ch = tid & 7; *(LAS u32x4*)(buf + key * KP + ch * 16) = s.k; *(LAS u32x4*)(buf + TILEB + key * KP + ch * 16) = s.v; }
__device__ __forceinline__ bf16x8 pack_frag(const f32x16& x, int s) {
    u32x4 w; w.x = cvtpk(x[8 * s], x[8 * s + 1]); w.y = cvtpk(x[8 * s + 2], x[8 * s + 3]); w.z = cvtpk(x[8 * s + 4], x[8 * s + 5]); w.w = cvtpk(x[8 * s + 6], x[8 * s + 7]); return __builtin_bit_cast(bf16x8, w); }

template <int MODE>
__device__ __forceinline__ void stream(f32x16 (&oT)[2], f32x16& imp, float& m_run, float& l_run, const bf16x8 (&qf)[4], const bf16* Kg, const bf16* Vg, size_t pitch,
                                       int first, int ntile, unsigned umask, int tq, float slope, unsigned selmask, int W, LAS unsigned char* lds, int tid, int lane) {
    const int r = lane & 31, h = lane >> 5;
    const float NINF = -__builtin_inff();
    if (ntile <= 0) return;
    __syncthreads();
    Stage st; unsigned mm = umask;
    int kt = (MODE == 1) ? __builtin_ctz(mm) : first; if (MODE == 1) mm &= mm - 1;
    stage_load(st, Kg, Vg, pitch, 64 * kt, tid);
    for (int i = 0; i < ntile; ++i) {
        LAS unsigned char* buf = lds + (i & 1) * BUFB;
        stage_store(st, buf, tid);
        __syncthreads();
        const int ktc = kt;
        if (i + 1 < ntile) { kt = (MODE == 1) ? __builtin_ctz(mm) : kt + 1; if (MODE == 1) mm &= mm - 1; stage_load(st, Kg, Vg, pitch, 64 * kt, tid); }
        f32x16 p[2];
#pragma unroll
        for (int blk = 0; blk < 2; ++blk) { p[blk] = zero16();
#pragma unroll
            for (int d0 = 0; d0 < 4; ++d0) { const bf16x8 ka = *(const LAS bf16x8*)(buf + (32 * blk + r) * KP + (16 * d0 + 8 * h) * 2);
                p[blk] = __builtin_amdgcn_mfma_f32_32x32x16_bf16(ka, qf[d0], p[blk], 0, 0, 0); } }
        float fb, step;
        if (MODE == 2) { fb = (float)(tq - 31 - 16 * (64 * ktc + 4 * h)); step = 16.f; } else { fb = (float)(tq - 64 * ktc - 4 * h); step = 1.f; }
        const bool lane_on = (MODE == 1) ? ((selmask >> ktc) & 1u) != 0u : true;
        float tmax = NINF;
#pragma unroll
        for (int blk = 0; blk < 2; ++blk)
#pragma unroll
            for (int i2 = 0; i2 < 16; ++i2) { const float dist = fb - step * (float)(32 * blk + (i2 & 3) + 8 * (i2 >> 2));
                bool valid = dist >= 0.f && lane_on; if (MODE == 0) valid = valid && dist < (float)W;
                const float sv = valid ? p[blk][i2] - slope * dist : NINF; p[blk][i2] = sv; tmax = fmaxf(tmax, sv); }
        tmax = fmaxf(tmax, __shfl_xor(tmax, 32));
        const float m_new = fmaxf(m_run, tmax), m_use = (m_new == NINF) ? 0.f : m_new;
        const float alpha = __builtin_amdgcn_exp2f((m_run - m_use) * LOG2E), mb = -m_use * LOG2E;
        float rs = 0.f;
#pragma unroll
        for (int blk = 0; blk < 2; ++blk)
#pragma unroll
            for (int i2 = 0; i2 < 16; ++i2) { const float e = __builtin_amdgcn_exp2f(fmaf(p[blk][i2], LOG2E, mb)); p[blk][i2] = e; rs += e; }
        l_run = l_run * alpha + rs; m_run = m_new;
#pragma unroll
        for (int i2 = 0; i2 < 16; ++i2) { oT[0][i2] *= alpha; oT[1][i2] *= alpha; if (MODE == 2) imp[i2] *= alpha; }
        const LAS unsigned char* vb = buf + TILEB + (4 * h + ((lane >> 2) & 3)) * KP + (16 * ((lane >> 4) & 1) + 4 * (lane & 3)) * 2;
#pragma unroll
        for (int blk = 0; blk < 2; ++blk)
#pragma unroll
            for (int s = 0; s < 2; ++s) { const int ks = 2 * blk + s; const bf16x8 pf = pack_frag(p[blk], s);
#pragma unroll
                for (int db = 0; db < 2; ++db) { const LAS unsigned char* ad = vb + (16 * ks) * KP + (32 * db) * 2;
                    const s16x4 lo = __builtin_bit_cast(s16x4, __builtin_amdgcn_ds_read_tr16_b64_v4i16((LAS s16x4*)ad));
                    const s16x4 hi = __builtin_bit_cast(s16x4, __builtin_amdgcn_ds_read_tr16_b64_v4i16((LAS s16x4*)(ad + 8 * KP)));
                    const bf16x8 vf = (bf16x8){lo[0], lo[1], lo[2], lo[3], hi[0], hi[1], hi[2], hi[3]};
                    oT[db] = __builtin_amdgcn_mfma_f32_32x32x16_bf16(vf, pf, oT[db], 0, 0, 0); }
                if (MODE == 2) {
                    u32x4 w;
#pragma unroll
                    for (int e2 = 0; e2 < 4; ++e2) { const int c0 = 64 * ktc + 16 * ks + 8 * (e2 >> 1) + 4 * h + 2 * (e2 & 1), c1 = c0 + 1;
                        const unsigned b0 = (c0 >= 4 * r - 1 && c0 <= 4 * r + 3) ? 0x3F80u : 0u, b1 = (c1 >= 4 * r - 1 && c1 <= 4 * r + 3) ? 0x3F80u : 0u; w[e2] = b0 | (b1 << 16); }
                    imp = __builtin_amdgcn_mfma_f32_32x32x16_bf16(__builtin_bit_cast(bf16x8, w), pf, imp, 0, 0, 0); } }
    }
}
__device__ __forceinline__ void load_qfrag(bf16x8 (&qf)[4], const bf16* qrow, int h) {
#pragma unroll
    for (int d0 = 0; d0 < 4; ++d0) { const u32x4 v = *(const u32x4*)(qrow + 16 * d0 + 8 * h); u32x4 w;
        w.x = cvtpk(bflo(v.x) * 0.125f, bfhi(v.x) * 0.125f); w.y = cvtpk(bflo(v.y) * 0.125f, bfhi(v.y) * 0.125f); w.z = cvtpk(bflo(v.z) * 0.125f, bfhi(v.z) * 0.125f); w.w = cvtpk(bflo(v.w) * 0.125f, bfhi(v.w) * 0.125f);
        qf[d0] = __builtin_bit_cast(bf16x8, w); }
}
__device__ __forceinline__ void fold(f32x16 (&res)[2], const f32x16 (&oT)[2], float sc) {
#pragma unroll
    for (int i = 0; i < 16; ++i) { res[0][i] += sc * oT[0][i]; res[1][i] += sc * oT[1][i]; } }
__device__ __forceinline__ void store_o(bf16* orow, const f32x16 (&res)[2], int h) {
#pragma unroll
    for (int db = 0; db < 2; ++db)
#pragma unroll
        for (int a4 = 0; a4 < 4; ++a4) { u32x2 w; w.x = cvtpk(res[db][4 * a4], res[db][4 * a4 + 1]); w.y = cvtpk(res[db][4 * a4 + 2], res[db][4 * a4 + 3]);
            *(u32x2*)(orow + 32 * db + 8 * a4 + 4 * h) = w; }
}
}

__device__ __forceinline__ void p4_attention_mfma(Frame& F, const Args& a) {
    using namespace att;
    const int lane = F.lane, tid = F.tid, w = F.wave, r = lane & 31, h = lane >> 5, g = r >> 3, qi = r & 7;
    const bf16* P = (const bf16*)(F.ws + WS_P); bf16* O = (bf16*)(F.ws + WS_O);
    const bf16* KCB = (const bf16*)(F.ws + WS_KCCB); const float* gates = (const float*)(F.ws + WS_GATES);
    LAS unsigned* ubuf = (LAS unsigned*)(F.lds + 4 * BUFB);
    const float NINF = -__builtin_inff();
    const int x = F.vcu, bh = x >> 3, qslot = x & 7, b = bh >> 1, hkv = bh & 1;
    if (x >= 256) return;
    for (int rr = 0; rr < 4; ++rr) {
        const int qt = (rr & 1) ? 8 * rr + 7 - qslot : 8 * rr + qslot;
        const int tq = 64 * qt + 8 * w + qi; const size_t m = (size_t)b * SEQ + tq;
        const bf16* Pb = P + (size_t)b * SEQ * PW;
        {
            const int hd = hkv * 4 + g; const float slope = alibi_slope(hd);
            bf16x8 qf[4]; load_qfrag(qf, P + m * PW + hd * 64, h);
            f32x16 oT[2] = {zero16(), zero16()}, dummy = zero16(); float m_run = NINF, l_run = 0.f;
            const int first = qt >= 2 ? qt - 2 : 0;
            stream<0>(oT, dummy, m_run, l_run, qf, Pb + 512 + hkv * 64, Pb + 640 + hkv * 64, PW, first, qt - first + 1, 0u, tq, slope, 0u, 128, F.lds, tid, lane);
            float l_tot = l_run + __shfl_xor(l_run, 32); l_tot += __expf(a.in[I_SINK][hd] - m_run);
            f32x16 res[2] = {zero16(), zero16()}; fold(res, oT, 1.0f / l_tot);
            store_o(O + m * D + hd * 64, res, h);
        }
        {
            const int hb = hkv * 4 + g; const float slope = alibi_slope(8 + hb);
            bf16x8 qf[4]; load_qfrag(qf, P + m * PW + 768 + hb * 64, h);
            const float* gp = gates + m * 24 + hb * 3;
            const float g0 = sigmoidf(gp[0]), g1 = sigmoidf(gp[1]), g2 = sigmoidf(gp[2]);
            f32x16 res[2] = {zero16(), zero16()};
            unsigned selmask = 0u;
            {
                f32x16 oT[2] = {zero16(), zero16()}, imp = zero16(); float m_run = NINF, l_run = 0.f;
                const int nvc_max = (64 * qt + 63 >= 31) ? ((64 * qt + 63 - 31) / 16 + 1) : 0;
                const int ntile = nvc_max > 64 ? 2 : (nvc_max > 0 ? 1 : 0);
                stream<2>(oT, imp, m_run, l_run, qf, KCB + (size_t)(bh * 128) * 64, KCB + (size_t)4096 * 64 + (size_t)(bh * 128) * 64, 64, 0, ntile, 0u, tq, slope, 0u, 0, F.lds, tid, lane);
                const float l_tot = l_run + __shfl_xor(l_run, 32); const float inv = l_tot > 0.f ? 1.0f / l_tot : 0.f;
                fold(res, oT, g0 * inv);
                float R[32];
#pragma unroll
                for (int i = 0; i < 16; ++i) { float v = imp[i] * inv; v += __shfl_xor(v, 8); v += __shfl_xor(v, 16); const float o = __shfl_xor(v, 32);
                    const int j0 = (i & 3) + 8 * (i >> 2); R[j0] = h ? o : v; R[j0 + 4] = h ? v : o; }
                const int tb = tq >> 6;
#pragma unroll
                for (int j = 0; j < 32; ++j) R[j] = (j == 0 || j == tb || j == tb - 1) ? __builtin_inff() : (j <= tb ? R[j] : NINF);
#pragma unroll 1
                for (int rd = 0; rd < 8; ++rd) { float best = NINF; int bj = -1;
#pragma unroll
                    for (int j = 0; j < 32; ++j) { if (R[j] > best) { best = R[j]; bj = j; } }
                    if (bj >= 0) selmask |= 1u << bj;
#pragma unroll
                    for (int j = 0; j < 32; ++j) R[j] = (j == bj) ? NINF : R[j]; }
            }
            unsigned um = selmask;
#pragma unroll
            for (int o2 = 1; o2 < 64; o2 <<= 1) um |= (unsigned)__shfl_xor((int)um, o2);
            __syncthreads();
            if (lane == 0) ubuf[w] = um;
            __syncthreads();
            um = ubuf[0] | ubuf[1] | ubuf[2] | ubuf[3] | ubuf[4] | ubuf[5] | ubuf[6] | ubuf[7];
            um = (unsigned)__builtin_amdgcn_readfirstlane((int)um);
            {
                f32x16 oT[2] = {zero16(), zero16()}, dummy = zero16(); float m_run = NINF, l_run = 0.f;
                stream<1>(oT, dummy, m_run, l_run, qf, Pb + 1536 + hkv * 64, Pb + 1664 + hkv * 64, PW, 0, __builtin_popcount(um), um, tq, slope, selmask, 0, F.lds, tid, lane);
                const float l_tot = l_run + __shfl_xor(l_run, 32); fold(res, oT, g1 / l_tot);
            }
            {
                f32x16 oT[2] = {zero16(), zero16()}, dummy = zero16(); float m_run = NINF, l_run = 0.f;
                const int first = qt >= 4 ? qt - 4 : 0;
                stream<0>(oT, dummy, m_run, l_run, qf, Pb + 1792 + hkv * 64, Pb + 1920 + hkv * 64, PW, first, qt - first + 1, 0u, tq, slope, 0u, 256, F.lds, tid, lane);
                const float l_tot = l_run + __shfl_xor(l_run, 32); fold(res, oT, g2 / l_tot);
            }
            store_o(O + m * D + 512 + hb * 64, res, h);
        }
    }
}


__device__ __forceinline__ void p11_spatial_mfma(Frame& F, const Args& a) {
    using namespace att;
    constexpr int VP = 272;
    const bf16* U = (const bf16*)(F.ws + WS_U); const bf16* V = (const bf16*)(F.ws + WS_V); bf16* Z = (bf16*)(F.ws + WS_Z);
    LAS f32x2* st = (LAS f32x2*)(F.lds + LDS_STATS_OFF);
    const float* lng = a.in[I_GLNG]; const float* lnb = a.in[I_GLNB]; const float* ws_ = a.in[I_GWS]; const float* bs = a.in[I_GBS];
    const int tid = F.tid, lane = F.lane, w = F.wave, r = lane & 31, h = lane >> 5, tb = w & 3, cb0 = 2 * (w >> 2);
    for (int unit = blockIdx.x; unit < NB * 16; unit += F.G) {
        const int m0 = unit * 128;
        __syncthreads();
        for (int rr = 0; rr < 16; ++rr) { const int row = w * 16 + rr; const bf16* vr = V + (size_t)(m0 + row) * D;
            const u32x4 p0 = ((const u32x4*)vr)[lane], p1 = ((const u32x4*)vr)[64 + lane]; float x[16];
            x[0] = bflo(p0.x); x[1] = bfhi(p0.x); x[2] = bflo(p0.y); x[3] = bfhi(p0.y); x[4] = bflo(p0.z); x[5] = bfhi(p0.z); x[6] = bflo(p0.w); x[7] = bfhi(p0.w);
            x[8] = bflo(p1.x); x[9] = bfhi(p1.x); x[10] = bflo(p1.y); x[11] = bfhi(p1.y); x[12] = bflo(p1.z); x[13] = bfhi(p1.z); x[14] = bflo(p1.w); x[15] = bfhi(p1.w);
            float sm = 0.f;
#pragma unroll
            for (int i = 0; i < 16; ++i) sm += x[i];
            const float mean = wave_sum(sm) * (1.f / D); float s2 = 0.f;
#pragma unroll
            for (int i = 0; i < 16; ++i) { const float d = x[i] - mean; s2 += d * d; }
            const float rstd = 1.f / sqrtf(wave_sum(s2) * (1.f / D) + LN_EPS);
            if (lane == 0) st[row] = (f32x2){mean, rstd}; }
        __syncthreads();
#pragma unroll 1
        for (int g = 0; g < 8; ++g) {
            LAS unsigned char* buf = F.lds + (g & 1) * (128 * VP);
            { const int c8 = tid & 15; const float* gp = lng + g * 128 + 8 * c8; const float* bp = lnb + g * 128 + 8 * c8;
              const f32x4 ga = *(const f32x4*)gp, gb = *(const f32x4*)(gp + 4), ba = *(const f32x4*)bp, bb = *(const f32x4*)(bp + 4);
#pragma unroll
              for (int k = 0; k < 4; ++k) { const int sidx = (tid >> 4) + 32 * k; const f32x2 ms = st[sidx];
                  const u32x4 v = *(const u32x4*)(V + (size_t)(m0 + sidx) * D + g * 128 + 8 * c8); u32x4 o;
                  o.x = cvtpk((bflo(v.x) - ms.x) * ms.y * ga[0] + ba[0], (bfhi(v.x) - ms.x) * ms.y * ga[1] + ba[1]);
                  o.y = cvtpk((bflo(v.y) - ms.x) * ms.y * ga[2] + ba[2], (bfhi(v.y) - ms.x) * ms.y * ga[3] + ba[3]);
                  o.z = cvtpk((bflo(v.z) - ms.x) * ms.y * gb[0] + bb[0], (bfhi(v.z) - ms.x) * ms.y * gb[1] + bb[1]);
                  o.w = cvtpk((bflo(v.w) - ms.x) * ms.y * gb[2] + bb[2], (bfhi(v.w) - ms.x) * ms.y * gb[3] + bb[3]);
                  *(LAS u32x4*)(buf + sidx * VP + c8 * 16) = o; } }
            const int t = 32 * tb + r; bf16x8 wf[8];
#pragma unroll
            for (int ks = 0; ks < 8; ++ks) { const int s0 = 16 * ks + 8 * h; const float* wp = ws_ + (size_t)g * 16384 + t * 128 + s0; u32x4 o = (u32x4){0u, 0u, 0u, 0u};
                if (ks <= 2 * tb + 1) { f32x4 w0 = *(const f32x4*)wp, w1 = *(const f32x4*)(wp + 4);
#pragma unroll
                    for (int j = 0; j < 4; ++j) { if (s0 + j > t) w0[j] = 0.f; if (s0 + 4 + j > t) w1[j] = 0.f; }
                    o.x = cvtpk(w0[0], w0[1]); o.y = cvtpk(w0[2], w0[3]); o.z = cvtpk(w1[0], w1[1]); o.w = cvtpk(w1[2], w1[3]); }
                wf[ks] = __builtin_bit_cast(bf16x8, o); }
            __syncthreads();
            f32x16 acc[2] = {zero16(), zero16()};
            const LAS unsigned char* ab = buf + (8 * h + ((lane >> 2) & 3)) * VP + (16 * ((lane >> 4) & 1) + 4 * (lane & 3)) * 2;
#pragma unroll
            for (int ks = 0; ks < 8; ++ks) { if (ks <= 2 * tb + 1) {
#pragma unroll
                for (int cb = 0; cb < 2; ++cb) { const LAS unsigned char* ad = ab + (16 * ks) * VP + (32 * (cb0 + cb)) * 2;
                    const s16x4 lo = __builtin_bit_cast(s16x4, __builtin_amdgcn_ds_read_tr16_b64_v4i16((LAS s16x4*)ad));
                    const s16x4 hi = __builtin_bit_cast(s16x4, __builtin_amdgcn_ds_read_tr16_b64_v4i16((LAS s16x4*)(ad + 4 * VP)));
                    const bf16x8 vf = (bf16x8){lo[0], lo[1], lo[2], lo[3], hi[0], hi[1], hi[2], hi[3]};
                    acc[cb] = __builtin_amdgcn_mfma_f32_32x32x16_bf16(vf, wf[ks], acc[cb], 0, 0, 0); } } }
            const float bt = bs[g * 128 + t]; const size_t rowo = (size_t)(m0 + t) * D + g * 128;
#pragma unroll
            for (int cb = 0; cb < 2; ++cb)
#pragma unroll
                for (int a4 = 0; a4 < 4; ++a4) { const size_t o = rowo + 32 * (cb0 + cb) + 8 * a4 + 4 * h; const u32x2 uu = *(const u32x2*)(U + o); u32x2 zz;
                    zz.x = cvtpk(bflo(uu.x) * (acc[cb][4 * a4] + bt), bfhi(uu.x) * (acc[cb][4 * a4 + 1] + bt)); zz.y = cvtpk(bflo(uu.y) * (acc[cb][4 * a4 + 2] + bt), bfhi(uu.y) * (acc[cb][4 * a4 + 3] + bt));
                    *(u32x2*)(Z + o) = zz; }
        }
    }
}

template <int MODE>
__device__ __forceinline__ void ln_phase(Frame& F, const Args& a, const float* lg, const float* lb) {
    const int gw = F.vcu * NWAVES + F.wave, NGW = F.G * NWAVES, lane = F.lane;
    float* out = a.out; bf16* xb = (bf16*)(F.ws + WS_XB);
    f32x4 gg[4], bb[4];
#pragma unroll
    for (int j = 0; j < 4; ++j) { gg[j] = *((const f32x4*)lg + lane + 64 * j); bb[j] = *((const f32x4*)lb + lane + 64 * j); }
    for (int m = gw; m < M; m += NGW) {
        f32x4* xr = (f32x4*)(out + (size_t)m * D) + lane; f32x4 v[4]; float s = 0.f;
#pragma unroll
        for (int j = 0; j < 4; ++j) v[j] = xr[64 * j];
        if (MODE == 2) {
            const bf16* y = (const bf16*)(F.ws + WS_Y2) + (size_t)m * 2 * D;
#pragma unroll
            for (int j = 0; j < 4; ++j) { const u32x2 y0 = *((const u32x2*)y + lane + 64 * j), y1 = *((const u32x2*)(y + D) + lane + 64 * j);
                v[j][0] = ALPHA * v[j][0] + bflo(y0.x) + bflo(y1.x); v[j][1] = ALPHA * v[j][1] + bfhi(y0.x) + bfhi(y1.x);
                v[j][2] = ALPHA * v[j][2] + bflo(y0.y) + bflo(y1.y); v[j][3] = ALPHA * v[j][3] + bfhi(y0.y) + bfhi(y1.y); }
        }
#pragma unroll
        for (int j = 0; j < 4; ++j) s += (v[j][0] + v[j][1]) + (v[j][2] + v[j][3]);
        const float mean = wave_sum(s) * (1.f / D); float s2 = 0.f;
#pragma unroll
        for (int j = 0; j < 4; ++j) { v[j] = v[j] - mean; s2 += (v[j][0] * v[j][0] + v[j][1] * v[j][1]) + (v[j][2] * v[j][2] + v[j][3] * v[j][3]); }
        const float rstd = 1.f / sqrtf(wave_sum(s2) * (1.f / D) + LN_EPS);
#pragma unroll
        for (int j = 0; j < 4; ++j) { v[j] = v[j] * rstd * gg[j] + bb[j]; xr[64 * j] = v[j]; }
        if (MODE != 2) {
            unsigned long long* o8 = (unsigned long long*)(xb + (size_t)m * D) + lane;
#pragma unroll
            for (int j = 0; j < 4; ++j) o8[64 * j] = (unsigned long long)pk2(v[j][0], v[j][1]) | ((unsigned long long)pk2(v[j][2], v[j][3]) << 32);
        }
        if (MODE == 1) {
            const float* wr = a.in[I_RT]; float lg8[8];
#pragma unroll
            for (int e = 0; e < 8; ++e) lg8[e] = 0.f;
#pragma unroll
            for (int j = 0; j < 4; ++j)
#pragma unroll
                for (int i = 0; i < 4; ++i) { const float* w = wr + (size_t)(256 * j + 4 * lane + i) * 8; const f32x4 w0 = *(const f32x4*)w, w1 = *(const f32x4*)(w + 4); const float xv = v[j][i];
                    lg8[0] += xv * w0[0]; lg8[1] += xv * w0[1]; lg8[2] += xv * w0[2]; lg8[3] += xv * w0[3]; lg8[4] += xv * w1[0]; lg8[5] += xv * w1[1]; lg8[6] += xv * w1[2]; lg8[7] += xv * w1[3]; }
#pragma unroll
            for (int e = 0; e < 8; ++e) lg8[e] = wave_sum(lg8[e]);
            int e0 = 0; float v0 = lg8[0];
#pragma unroll
            for (int e = 1; e < 8; ++e) if (lg8[e] > v0) { v0 = lg8[e]; e0 = e; }
            int e1 = -1; float v1 = -__builtin_inff();
#pragma unroll
            for (int e = 0; e < 8; ++e) if (e != e0 && lg8[e] > v1) { v1 = lg8[e]; e1 = e; }
            const float g0 = 1.0f / (1.0f + __expf(v1 - v0)), g1 = 1.0f - g0;
            if (lane == 0) {
                int* rowtok = (int*)(F.ws + WS_ROWTOK); int* rowdst = (int*)(F.ws + WS_ROWDST); float* rowgate = (float*)(F.ws + WS_ROWGATE);
                const unsigned p0 = atomicAdd((unsigned*)(F.ctl + CW_CNT + 64 * e0), 1u), p1 = atomicAdd((unsigned*)(F.ctl + CW_CNT + 64 * e1), 1u);
                rowtok[e0 * CAP + p0] = m; rowdst[e0 * CAP + p0] = 2 * m; rowgate[e0 * CAP + p0] = g0;
                rowtok[e1 * CAP + p1] = m; rowdst[e1 * CAP + p1] = 2 * m + 1; rowgate[e1 * CAP + p1] = g1;
            }
        }
    }
}

__device__ __forceinline__ void p3_compress2(Frame& F, const Args& a) {
    const bf16* H1 = (const bf16*)(F.ws + WS_H1); float* KCC = (float*)(F.ws + WS_KCC);
    const int gt = blockIdx.x * NTHREADS + F.tid, NT = F.G * NTHREADS;
    for (int idx = gt; idx < 2 * 4096 * 64; idx += NT) {
        const int n = idx & 63, r = (idx >> 6) & 4095, kv = idx >> 18;
        const float* w2 = a.in[kv ? I_WV2 : I_WK2]; const bf16* h = H1 + (size_t)(kv * 4096 + r) * 256; float s = 0.f;
        for (int j8 = 0; j8 < 32; ++j8) { const u32x4 v = ((const u32x4*)h)[j8]; const float* w = w2 + (size_t)(8 * j8) * 64 + n;
            s += bflo(v.x) * w[0] + bfhi(v.x) * w[64] + bflo(v.y) * w[128] + bfhi(v.y) * w[192] + bflo(v.z) * w[256] + bfhi(v.z) * w[320] + bflo(v.w) * w[384] + bfhi(v.w) * w[448]; }
        KCC[idx] = s; ((bf16*)(F.ws + WS_KCCB))[idx] = (bf16)f2bf(s);
    }
}

__device__ __forceinline__ void p11_spatial(Frame& F, const Args& a) {
    const bf16* U = (const bf16*)(F.ws + WS_U); const bf16* V = (const bf16*)(F.ws + WS_V); bf16* Z = (bf16*)(F.ws + WS_Z);
    LAS float* Wl = (LAS float*)(F.lds); LAS float* vn = (LAS float*)(F.lds + 65536); LAS f32x2* st = (LAS f32x2*)(F.lds + LDS_STATS_OFF);
    const float* lng = a.in[I_GLNG]; const float* lnb = a.in[I_GLNB]; const float* ws_ = a.in[I_GWS]; const float* bs = a.in[I_GBS];
    const int tid = F.tid, lane = F.lane;
    for (int unit = blockIdx.x; unit < NB * 16; unit += F.G) {
        const int m0 = unit * 128;
        __syncthreads();
        for (int rr = 0; rr < 16; ++rr) { const int r = F.wave * 16 + rr; const bf16* vr = V + (size_t)(m0 + r) * D;
            const u32x4 p0 = ((const u32x4*)vr)[lane], p1 = ((const u32x4*)vr)[64 + lane]; float x[16];
            x[0] = bflo(p0.x); x[1] = bfhi(p0.x); x[2] = bflo(p0.y); x[3] = bfhi(p0.y); x[4] = bflo(p0.z); x[5] = bfhi(p0.z); x[6] = bflo(p0.w); x[7] = bfhi(p0.w);
            x[8] = bflo(p1.x); x[9] = bfhi(p1.x); x[10] = bflo(p1.y); x[11] = bfhi(p1.y); x[12] = bflo(p1.z); x[13] = bfhi(p1.z); x[14] = bflo(p1.w); x[15] = bfhi(p1.w);
            float s = 0.f;
#pragma unroll
            for (int i = 0; i < 16; ++i) s += x[i];
            const float mean = wave_sum(s) * (1.f / D); float s2 = 0.f;
#pragma unroll
            for (int i = 0; i < 16; ++i) { const float d = x[i] - mean; s2 += d * d; }
            const float rstd = 1.f / sqrtf(wave_sum(s2) * (1.f / D) + LN_EPS);
            if (lane == 0) st[r] = (f32x2){mean, rstd}; }
        __syncthreads();
        for (int g = 0; g < 8; ++g) {
            for (int i = tid; i < 128 * 32; i += NTHREADS) { const int t = i >> 5, s4 = (i & 31) * 4; f32x4 w = *(const f32x4*)(ws_ + (size_t)g * 16384 + t * 128 + s4);
                if (s4 + 0 > t) w[0] = 0.f; if (s4 + 1 > t) w[1] = 0.f; if (s4 + 2 > t) w[2] = 0.f; if (s4 + 3 > t) w[3] = 0.f; *(LAS f32x4*)(Wl + t * 128 + s4) = w; }
            { const int ch = tid & 127; const float gch = lng[g * 128 + ch], bch = lnb[g * 128 + ch];
              for (int s = tid >> 7; s < 128; s += 4) { const f32x2 ms = st[s]; vn[s * 128 + ch] = (bf2f(V[(size_t)(m0 + s) * D + g * 128 + ch]) - ms.x) * ms.y * gch + bch; } }
            __syncthreads();
            { const int ch = tid & 127, tq = tid >> 7; float acc[32];
#pragma unroll
              for (int i = 0; i < 32; ++i) acc[i] = 0.f;
              const int s4end = (tq * 32 + 32) / 4;
              for (int s4 = 0; s4 < s4end; ++s4) { const float v0 = vn[(4 * s4) * 128 + ch], v1 = vn[(4 * s4 + 1) * 128 + ch], v2 = vn[(4 * s4 + 2) * 128 + ch], v3 = vn[(4 * s4 + 3) * 128 + ch];
#pragma unroll
                  for (int i = 0; i < 32; ++i) { const f32x4 w = *(const LAS f32x4*)(Wl + (tq * 32 + i) * 128 + 4 * s4); acc[i] += w[0] * v0 + w[1] * v1 + w[2] * v2 + w[3] * v3; } }
#pragma unroll
              for (int i = 0; i < 32; ++i) { const int t = tq * 32 + i; const size_t o = (size_t)(m0 + t) * D + g * 128 + ch;
                  Z[o] = (bf16)f2bf(bf2f(U[o]) * (acc[i] + bs[g * 128 + t])); } }
            __syncthreads();
        }
    }
}

constexpr int N_PHASES = 25;
__global__ void __launch_bounds__(NTHREADS, 2) fwd(Args args) {
    extern __shared__ __attribute__((aligned(16))) unsigned char lds[];
    Frame F;
    F.lds = (LAS unsigned char*)lds; F.ws = args.ws; F.ctl = (gu32*)(args.ws + WS_CTL);
    F.tid = threadIdx.x; F.lane = F.tid & 63; F.wave = __builtin_amdgcn_readfirstlane(F.tid >> 6);
    F.G = gridDim.x; { const int bx = blockIdx.x; F.vcu = (F.G % 8 == 0) ? (bx % 8) * (F.G / 8) + bx / 8 : bx; }
    for (int u = F.tid; u < (LDS_BYTES - LDSCTL_OFF) / 4; u += NTHREADS) ((LAS unsigned*)(F.lds + LDSCTL_OFF))[u] = 0u;
    __syncthreads();
    unsigned char* ws = args.ws;
#if MK_ONE_LAUNCH
    XcdBarrier bar = xcd_barrier_post((unsigned*)(F.ctl + CW_BAR), (volatile LAS unsigned*)(F.lds + LDSCTL_OFF));
#define GRID_BAR() xcd_barrier(bar)
#else
#define GRID_BAR() do { } while (0)
#endif
    const int lo = args.ph_lo, hi = args.ph_hi;
#define IN(k) (lo <= (k) && (k) < hi)
#define SEAM(k) do { if (IN(k) && IN((k) + 1)) GRID_BAR(); } while (0)
    const int G = F.G, c = (int)blockIdx.x;
    const float* lng = args.in[I_LNG]; const float* lnb = args.in[I_LNB];

    if (IN(0)) { for (int rep = 0; rep < REP_PRO; ++rep) p0_prologue(F, args); } SEAM(0);
    if (IN(1)) { pg8::Gemm g{(const char*)(ws + WS_XB), (const char*)(ws + WS_WIN), D, 0}; pg8::StaticOrder S{M / 256, 8, G, c};
        pg8::EpiBf<0> E{(bf16*)(ws + WS_P), (bf16*)(ws + WS_KC), PW, nullptr, nullptr, nullptr}; pg8::ADense al{(unsigned)D * 2u};
        pg8::gemm_phase(F.lds, g, S, E, al); } SEAM(1);
    if (IN(2)) { pg8::Gemm g{(const char*)(ws + WS_KC), (const char*)(ws + WS_WC1), 2048, (size_t)256 * 2048 * 2}; pg8::CmpOrder S{c};
        pg8::EpiBf<1> E{(bf16*)(ws + WS_H1), nullptr, 256, (const float*)(ws + WS_SMALL), nullptr, nullptr}; pg8::ADense al{1024u * 2u};
        pg8::gemm_phase(F.lds, g, S, E, al); } SEAM(2);
    if (IN(3)) { p3_compress2(F, args); } SEAM(3);
    if (IN(4)) { for (int rep = 0; rep < REP_ATT; ++rep) p4_attention_mfma(F, args); } SEAM(4);
    if (IN(5)) { pg8::Gemm g{(const char*)(ws + WS_O), (const char*)(ws + WS_WO), D, 0}; pg8::StaticOrder S{M / 256, 4, G, c};
        pg8::EpiRes E{args.in[I_X], args.out, ALPHA}; pg8::ADense al{(unsigned)D * 2u};
        pg8::gemm_phase(F.lds, g, S, E, al); } SEAM(5);
    if (IN(6)) { ln_phase<0>(F, args, lng + 0 * D, lnb + 0 * D); } SEAM(6);
    if (IN(7)) { pg8::Gemm g{(const char*)(ws + WS_XB), (const char*)(ws + WS_FGU), D, 0}; pg8::StaticOrder S{M / 256, DFF / 128, G, c};
        pg8::EpiBf<3> E{(bf16*)(ws + WS_H), nullptr, DFF, nullptr, nullptr, nullptr}; pg8::ADense al{(unsigned)D * 2u};
        pg8::gemm_phase(F.lds, g, S, E, al); } SEAM(7);
    if (IN(8)) { pg8::Gemm g{(const char*)(ws + WS_H), (const char*)(ws + WS_FDN), DFF, 0}; pg8::StaticOrder S{M / 256, 4, G, c};
        pg8::EpiRes E{args.out, args.out, ALPHA}; pg8::ADense al{(unsigned)DFF * 2u};
        pg8::gemm_phase(F.lds, g, S, E, al); } SEAM(8);
    if (IN(9)) { ln_phase<0>(F, args, lng + 1 * D, lnb + 1 * D); } SEAM(9);
    if (IN(10)) { pg8::Gemm g{(const char*)(ws + WS_XB), (const char*)(ws + WS_GIN), D, 0}; pg8::StaticOrder S{M / 256, 8, G, c};
        pg8::EpiBf<2> E{(bf16*)(ws + WS_U), (bf16*)(ws + WS_V), D, nullptr, nullptr, nullptr}; pg8::ADense al{(unsigned)D * 2u};
        pg8::gemm_phase(F.lds, g, S, E, al); } SEAM(10);
    if (IN(11)) { for (int rep = 0; rep < REP_SPA; ++rep) p11_spatial_mfma(F, args); } SEAM(11);
    if (IN(12)) { pg8::Gemm g{(const char*)(ws + WS_Z), (const char*)(ws + WS_GOUT), D, 0}; pg8::StaticOrder S{M / 256, 4, G, c};
        pg8::EpiRes E{args.out, args.out, ALPHA}; pg8::ADense al{(unsigned)D * 2u};
        pg8::gemm_phase(F.lds, g, S, E, al); } SEAM(12);
    if (IN(13)) { ln_phase<1>(F, args, lng + 2 * D, lnb + 2 * D); } SEAM(13);
    {
        LAS int* tab = (LAS int*)(F.lds + LDS_MOE_OFF);
        if (hi > 14 && lo < 24) {
            __syncthreads();
            if (F.tid == 0) { int ts = 0;
                for (int e = 0; e < 8; ++e) { int n = (int)__hip_atomic_load(F.ctl + CW_CNT + 64 * e, __ATOMIC_RELAXED, __HIP_MEMORY_SCOPE_AGENT); if (n > CAP) n = CAP; tab[e] = n; tab[8 + e] = ts; ts += (n + 255) >> 8; }
                tab[16] = ts; }
            __syncthreads();
        }
        const int T = tab[16];
#pragma unroll 1
        for (int ch = 0; ch < 5; ++ch) {
            const int tile0 = 64 * ch; int nM = T - tile0; nM = nM < 0 ? 0 : (nM > 64 ? 64 : nM);
            nM = __builtin_amdgcn_readfirstlane(nM);
            if (IN(14 + 2 * ch)) { pg8::Gemm g{(const char*)(ws + WS_XB), (const char*)(ws + WS_MGU), D, (size_t)2 * DFE * D * 2}; pg8::MoeOrder S{nM, DFE / 128, G, c, tile0, tab};
                pg8::EpiBf<3> E{(bf16*)(ws + WS_HM), nullptr, DFE, nullptr, nullptr, nullptr}; pg8::AGather al{(const int*)(ws + WS_ROWTOK), (unsigned)D * 2u};
                pg8::gemm_phase(F.lds, g, S, E, al); }
            SEAM(14 + 2 * ch);
            if (IN(15 + 2 * ch)) { pg8::Gemm g{(const char*)(ws + WS_HM), (const char*)(ws + WS_MDN), DFE, (size_t)D * DFE * 2}; pg8::MoeOrder S{nM, 4, G, c, tile0, tab};
                pg8::EpiBf<4> E{(bf16*)(ws + WS_Y2), nullptr, D, nullptr, (const int*)(ws + WS_ROWDST), (const float*)(ws + WS_ROWGATE)}; pg8::ADense al{(unsigned)DFE * 2u};
                pg8::gemm_phase(F.lds, g, S, E, al); }
            SEAM(15 + 2 * ch);
        }
    }
    if (IN(24)) { ln_phase<2>(F, args, lng + 3 * D, lnb + 3 * D); }
#undef IN
#undef SEAM
}

extern "C" void kernel_launch(void* const* d_in, const int* in_sizes, int n_in, void* d_out, int out_size, void* d_ws, size_t ws_size, hipStream_t stream) {
    static int grid = 0;
    if (grid == 0) {
        if (n_in != 25 || in_sizes[0] != M * D || out_size != M * D || ws_size < WS_END) { fprintf(stderr, "kernel_launch: unexpected shapes (n_in %d, in0 %d, out %d, ws %zu); nothing launched\n", n_in, n_in > 0 ? in_sizes[0] : -1, out_size, ws_size); grid = -1; return; }
        int dev = 0, cus = 0, per_cu = 0;
        if (hipGetDevice(&dev) != hipSuccess || hipDeviceGetAttribute(&cus, hipDeviceAttributeMultiprocessorCount, dev) != hipSuccess) { grid = -1; return; }
        if (hipFuncSetAttribute((const void*)fwd, hipFuncAttributeMaxDynamicSharedMemorySize, LDS_BYTES) != hipSuccess) { fprintf(stderr, "kernel_launch: hipFuncSetAttribute failed\n"); grid = -1; return; }
        if (hipOccupancyMaxActiveBlocksPerMultiprocessor(&per_cu, (const void*)fwd, NTHREADS, LDS_BYTES) != hipSuccess || per_cu < 1) fprintf(stderr, "kernel_launch: occupancy query reports %d\n", per_cu);
        (void)hipGetLastError();
        grid = cus;
    }
    if (grid < 0) return;
    if (hipMemsetAsync((char*)d_ws + WS_CTL, 0, CTL_ZERO_BYTES, stream) != hipSuccess) return;
    Args a{};
    for (int i = 0; i < 25; ++i) a.in[i] = (const float*)d_in[i];
    a.out = (float*)d_out; a.ws = (unsigned char*)d_ws;
#if MK_ONE_LAUNCH
    a.ph_lo = 0; a.ph_hi = N_PHASES;
    hipLaunchKernelGGL(fwd, dim3(grid), dim3(NTHREADS), LDS_BYTES, stream, a);
#else
    for (int p = 0; p < N_PHASES; ++p) { a.ph_lo = p; a.ph_hi = p + 1; hipLaunchKernelGGL(fwd, dim3(grid), dim3(NTHREADS), LDS_BYTES, stream, a); }
#endif
}
```

```cpp
#include <hip/hip_runtime.h>
#include <cstdio>
#include <cstdint>

#ifndef REP_ATT
#define REP_ATT 1
#endif
#ifndef REP_SPA
#define REP_SPA 1
#endif
#ifndef REP_PRO
#define REP_PRO 1
#endif
#ifndef MK_ONE_LAUNCH
#define MK_ONE_LAUNCH 1
#endif

#define LAS __attribute__((address_space(3)))
#define GAS __attribute__((address_space(1)))
typedef unsigned short bf16;
typedef short bf16x8 __attribute__((ext_vector_type(8)));
typedef float f32x4 __attribute__((ext_vector_type(4)));
typedef float f32x2 __attribute__((ext_vector_type(2)));
typedef unsigned u32x4 __attribute__((ext_vector_type(4)));
typedef unsigned u32x2 __attribute__((ext_vector_type(2)));
typedef GAS unsigned gu32;

constexpr int NB = 16, SEQ = 2048, D = 1024, M = NB * SEQ;
constexpr int PW = 2048;
constexpr int INW = 2072;
constexpr int DFF = 2816, DFE = 3584, NEXP = 8, CAP = 32768;
constexpr int NCMP = 127;
constexpr float ALPHA = 1.4142135623730951f;
constexpr float LN_EPS = 1e-5f;
constexpr int NWAVES = 8, NTHREADS = 512;

constexpr size_t MiB = 1u << 20;
constexpr size_t WS_CTL = 0, CTL_ZERO_BYTES = 1 * MiB;
constexpr size_t WS_SMALL = 1 * MiB;
constexpr size_t WS_ROWTOK = 2 * MiB, WS_ROWDST = 3 * MiB, WS_ROWGATE = 4 * MiB;
constexpr size_t WS_WIN = 5 * MiB;
constexpr size_t WS_WC1 = 9 * MiB;
constexpr size_t WS_WO = 11 * MiB;
constexpr size_t WS_FGU = 13 * MiB;
constexpr size_t WS_FDN = 24 * MiB;
constexpr size_t WS_GIN = 30 * MiB;
constexpr size_t WS_GOUT = 34 * MiB;
constexpr size_t WS_MGU = 36 * MiB;
constexpr size_t WS_MDN = 148 * MiB;
constexpr size_t WS_XB = 204 * MiB;
constexpr size_t WS_BIG = 268 * MiB;
constexpr size_t WS_P = WS_BIG;
constexpr size_t WS_O = WS_BIG + 128 * MiB;
constexpr size_t WS_H = WS_BIG;
constexpr size_t WS_U = WS_BIG, WS_V = WS_BIG + 64 * MiB, WS_Z = WS_BIG + 128 * MiB;
constexpr size_t WS_HM = WS_BIG;
constexpr size_t WS_Y2 = WS_BIG + 112 * MiB;
constexpr size_t WS_GATES = 460 * MiB;
constexpr size_t WS_KC = 463 * MiB;
constexpr size_t WS_H1 = 480 * MiB;
constexpr size_t WS_KCC = 484 * MiB;
constexpr size_t WS_KCCB = 486 * MiB;
constexpr size_t WS_END = 508 * MiB;
static_assert(WS_Y2 + 128 * MiB <= WS_END && WS_H + (size_t)M * DFF * 2 <= WS_GATES && WS_KC + 17 * MiB <= WS_H1, "ws map");
constexpr int CW_BAR = 4096;
constexpr int CW_CNT = 16384;

constexpr int RING_BYTES = 131072;
constexpr int LDSCTL_OFF = RING_BYTES;
constexpr int LDS_STATS_OFF = RING_BYTES + 1024;
constexpr int LDS_MOE_OFF = RING_BYTES + 4096;
constexpr int LDS_BYTES = 147456;

#define LDS_WAIT() asm volatile("s_waitcnt lgkmcnt(0)" ::: "memory")
#define VM_WAIT() asm volatile("s_waitcnt vmcnt(0)" ::: "memory")
__device__ __forceinline__ unsigned f2bf(float f) { unsigned u = __builtin_bit_cast(unsigned, f); return (u + 0x7fffu + ((u >> 16) & 1u)) >> 16; }
__device__ __forceinline__ unsigned pk2(float lo, float hi) { return f2bf(lo) | (f2bf(hi) << 16); }
__device__ __forceinline__ float bflo(unsigned u) { return __builtin_bit_cast(float, u << 16); }
__device__ __forceinline__ float bfhi(unsigned u) { return __builtin_bit_cast(float, u & 0xffff0000u); }
__device__ __forceinline__ float bf2f(bf16 b) { return __builtin_bit_cast(float, (unsigned)b << 16); }
__device__ __forceinline__ float wave_sum(float v) {
#pragma unroll
    for (int o = 1; o < 64; o <<= 1) v += __shfl_xor(v, o);
    return v;
}
__device__ __forceinline__ float wave_max(float v) {
#pragma unroll
    for (int o = 1; o < 64; o <<= 1) v = fmaxf(v, __shfl_xor(v, o));
    return v;
}
__device__ __forceinline__ float gelu_tanh(float x) {
    const float u = 0.7978845608028654f * (x + 0.044715f * x * x * x);
    return x / (1.0f + __expf(-2.0f * u));
}
__device__ __forceinline__ float silu(float x) { return x / (1.0f + __expf(-x)); }
__device__ __forceinline__ float sigmoidf(float x) { return 1.0f / (1.0f + __expf(-x)); }

namespace pg8 {
constexpr int BM = 256, BK = 64, HALF = 128, HTB = HALF * BK * 2, STAGE_BYTES = 8 * HTB, NXCD = 8, WGM = 8;
__host__ __device__ __forceinline__ int lds_byte(int r, int c) { const int st = (r >> 4) * 2 + (c >> 5), rr = r & 15, cc = c & 31, ob = rr * 64 + cc * 2; return st * 1024 + (ob ^ (((ob >> 9) & 1) << 5)); }
__host__ __device__ __forceinline__ void stage_rc(int b, int& R, int& C) { const int st = b / 1024, sb = b % 1024, swz = sb ^ (((sb >> 9) & 1) << 5); R = (st >> 1) * 16 + swz / 64; C = (st & 1) * 32 + (swz % 64) / 2; }
__host__ __device__ __forceinline__ int perm32(int rho) { const int n = rho >> 4, i = rho & 15; return 8 * (i >> 2) + 4 * n + (i & 3); }

struct Unit { int pm, pn, e, te, ne; };
struct Gemm { const char* A; const char* Bt; int K; size_t eStrideB; };

struct ADense { unsigned pitchB; __device__ __forceinline__ unsigned operator()(const Unit& u, int R) const { return (unsigned)(u.pm * 256 + R) * pitchB; } };
struct AGather { const int* rowtok; unsigned pitchB;
    __device__ __forceinline__ unsigned operator()(const Unit& u, int R) const { const int ri = u.te * 256 + R; const int tok = ri < u.ne ? rowtok[u.e * CAP + ri] : 0; return (unsigned)tok * pitchB; } };

__device__ __forceinline__ bool static_unit(int i, int G, int c, int nM, int nN, int& pm, int& pn) {
    const int nwg = nM * nN; const long L = (long)i * G + c; if (L >= nwg) return false;
    int wgid = (int)L; { const int q = nwg / NXCD, r = nwg % NXCD, xcd = wgid % NXCD, off = wgid / NXCD; wgid = (xcd < r ? xcd * (q + 1) : r * (q + 1) + (xcd - r) * q) + off; }
    const int nig = WGM * nN, gid = wgid / nig, fm = gid * WGM, gsz = (nM - fm) < WGM ? (nM - fm) : WGM;
    pm = fm + ((wgid % nig) % gsz); pn = (wgid % nig) / gsz; return true;
}
struct StaticOrder { int nM, nN, G, c;
    __device__ __forceinline__ bool next(int i, Unit& u) const { u.e = 0; u.te = 0; u.ne = 0; return static_unit(i, G, c, nM, nN, u.pm, u.pn); } };
struct CmpOrder { int c;
    __device__ __forceinline__ bool next(int i, Unit& u) const { if (i > 0 || c >= 32) return false; u.pm = c; u.pn = 0; u.e = c >> 4; u.te = 0; u.ne = 0; return true; } };
struct MoeOrder { int nM, nN, G, c, tile0; const LAS int* tab;
    __device__ __forceinline__ bool next(int i, Unit& u) const {
        int pm, pn; if (!static_unit(i, G, c, nM, nN, pm, pn)) return false;
        const int ct = tile0 + pm; int e = 0;
#pragma unroll
        for (int k = 1; k < 8; ++k) e += (ct >= tab[8 + k]) ? 1 : 0;
        e = __builtin_amdgcn_readfirstlane(e);
        u.pm = pm; u.pn = pn; u.e = e; u.te = __builtin_amdgcn_readfirstlane(ct - tab[8 + e]); u.ne = __builtin_amdgcn_readfirstlane(tab[e]); return true; } };

__device__ __forceinline__ u32x4 pack8(const f32x4& a, const f32x4& b) { u32x4 w; w.x = pk2(a[0], a[1]); w.y = pk2(a[2], a[3]); w.z = pk2(b[0], b[1]); w.w = pk2(b[2], b[3]); return w; }

struct EpiRes {
    static constexpr bool PERM = false;
    const float* res; float* out; float alpha;
    __device__ __forceinline__ void operator()(const f32x4 (&acc)[2][2][4][2], const Unit& u, int wr, int wc, int fr, int fq) const {
        const int row0 = u.pm * BM + wr * 64 + fr, col0 = u.pn * BM + wc * 32 + 4 * fq;
#pragma unroll
        for (int ai = 0; ai < 2; ++ai)
#pragma unroll
            for (int m = 0; m < 4; ++m) { const size_t off = (size_t)(row0 + ai * HALF + m * 16) * D + col0;
#pragma unroll
                for (int bj = 0; bj < 2; ++bj)
#pragma unroll
                    for (int n = 0; n < 2; ++n) { const size_t o = off + bj * HALF + n * 16; const f32x4 r = *(const f32x4*)(res + o); *(f32x4*)(out + o) = acc[ai][bj][m][n] + alpha * r; } }
    }
};
template <int MODE> struct EpiBf {
    static constexpr bool PERM = true;
    bf16* O; bf16* O2; int ldc; const float* bias; const int* rowdst; const float* rowgate;
    __device__ __forceinline__ void operator()(const f32x4 (&acc)[2][2][4][2], const Unit& u, int wr, int wc, int fr, int fq) const {
        const int lr0 = wr * 64 + fr, ct = wc * 32 + 8 * fq;
#pragma unroll
        for (int ai = 0; ai < 2; ++ai)
#pragma unroll
            for (int m = 0; m < 4; ++m) {
                const int lr = lr0 + ai * HALF + m * 16; const int row = u.pm * BM + lr;
                if (MODE == 0) {
#pragma unroll
                    for (int bj = 0; bj < 2; ++bj) { const u32x4 w = pack8(acc[ai][bj][m][0], acc[ai][bj][m][1]);
                        *(u32x4*)(O + (size_t)row * PW + u.pn * BM + bj * HALF + ct) = w;
                        if (u.pn == 5) { const int b = row >> 11, t = row & 2047, hh = wc >> 1, d = (wc & 1) * 32 + 8 * fq;
                            *(u32x4*)(O2 + ((size_t)((bj * 32 + b * 2 + hh) * 2048 + t)) * 64 + d) = w; } }
                } else if (MODE == 1) {
#pragma unroll
                    for (int bj = 0; bj < 2; ++bj) { const int col = bj * HALF + ct; const float* bp = bias + u.e * 256 + col;
                        const f32x4 b0 = *(const f32x4*)bp, b1 = *(const f32x4*)(bp + 4); f32x4 v0 = acc[ai][bj][m][0] + b0, v1 = acc[ai][bj][m][1] + b1;
#pragma unroll
                        for (int j = 0; j < 4; ++j) { v0[j] = gelu_tanh(v0[j]); v1[j] = gelu_tanh(v1[j]); }
                        *(u32x4*)(O + (size_t)row * 256 + col) = pack8(v0, v1); }
                } else if (MODE == 2) {
                    bf16* dst = (u.pn < 4) ? O : O2;
#pragma unroll
                    for (int bj = 0; bj < 2; ++bj) { f32x4 v0 = acc[ai][bj][m][0], v1 = acc[ai][bj][m][1];
#pragma unroll
                        for (int j = 0; j < 4; ++j) { v0[j] = gelu_tanh(v0[j]); v1[j] = gelu_tanh(v1[j]); }
                        *(u32x4*)(dst + (size_t)row * D + (u.pn & 3) * BM + bj * HALF + ct) = pack8(v0, v1); }
                } else if (MODE == 3) {
                    f32x4 v0, v1;
#pragma unroll
                    for (int j = 0; j < 4; ++j) { v0[j] = silu(acc[ai][0][m][0][j]) * acc[ai][1][m][0][j]; v1[j] = silu(acc[ai][0][m][1][j]) * acc[ai][1][m][1][j]; }
                    *(u32x4*)(O + (size_t)row * ldc + u.pn * HALF + ct) = pack8(v0, v1);
                } else {
                    const int gi = u.te * 256 + lr;
                    if (gi < u.ne) { const int dst = rowdst[u.e * CAP + gi]; const float gt = rowgate[u.e * CAP + gi];
#pragma unroll
                        for (int bj = 0; bj < 2; ++bj) { const f32x4 v0 = acc[ai][bj][m][0] * gt, v1 = acc[ai][bj][m][1] * gt;
                            *(u32x4*)(O + (size_t)dst * D + u.pn * BM + bj * HALF + ct) = pack8(v0, v1); } }
                }
            }
    }
};

template <class Epi, class Sched, class AL>
__device__ __forceinline__ void gemm_phase(LAS unsigned char* lds, const Gemm g, const Sched& S, const Epi& E, const AL& al) {
    const int tid = threadIdx.x, wid = __builtin_amdgcn_readfirstlane(tid >> 6), lane = tid & 63, wr = wid >> 2, wc = wid & 3, fr = lane & 15, fq = lane >> 4;
    const int K = g.K, nt = K / BK;
    int Rs[2]; unsigned Cb[2], voffB[2];
#pragma unroll
    for (int i = 0; i < 2; ++i) { int R, C; stage_rc(tid * 16 + i * 8192, R, C); const int Rb = Epi::PERM ? ((R & ~31) + perm32(R & 31)) : R;
        Rs[i] = R; Cb[i] = (unsigned)C * 2u; voffB[i] = (unsigned)(Rb * K + C) * 2u; }
    const size_t kstep = (size_t)(BK * 2);
    const size_t hstepB = (size_t)HALF * K * 2;
    const size_t tstepB = 2 * hstepB;
    const unsigned ldsw = (unsigned)wid * 1024u;
    const int aoff = lds_byte(wr * 64 + fr, fq * 8), boff = lds_byte(wc * 32 + fr, fq * 8);
#define PG8_SA(b, h) (((b) * 2 + (h)) * HTB)
#define PG8_SB(b, h) ((4 + (b) * 2 + (h)) * HTB)
#define PG8_STAGE(bufoff, gbase, voff) do { _Pragma("unroll") for (int _i = 0; _i < 2; ++_i) \
        __builtin_amdgcn_global_load_lds((const unsigned*)((const char*)(gbase) + (voff)[_i]), (LAS unsigned*)(lds + (bufoff) + ldsw + _i * 8192), 16, 0, 0); } while (0)
#define PG8_LDA(dst, b, h) do { _Pragma("unroll") for (int m = 0; m < 4; ++m) _Pragma("unroll") for (int k = 0; k < 2; ++k) dst[m][k] = *(const LAS bf16x8*)(lds + PG8_SA(b, h) + aoff + m * 2048 + k * 1024); } while (0)
#define PG8_LDB(dst, b, h) do { _Pragma("unroll") for (int n = 0; n < 2; ++n) _Pragma("unroll") for (int k = 0; k < 2; ++k) dst[n][k] = *(const LAS bf16x8*)(lds + PG8_SB(b, h) + boff + n * 2048 + k * 1024); } while (0)
#define PG8_MMA(ai, bj, At, Bt) do { __builtin_amdgcn_s_setprio(1); _Pragma("unroll") for (int m = 0; m < 4; ++m) _Pragma("unroll") for (int n = 0; n < 2; ++n) _Pragma("unroll") for (int k = 0; k < 2; ++k) \
        acc[ai][bj][m][n] = __builtin_amdgcn_mfma_f32_16x16x32_bf16(Bt[n][k], At[m][k], acc[ai][bj][m][n], 0, 0, 0); __builtin_amdgcn_s_setprio(0); } while (0)
#define PG8_WAIT_V(n) asm volatile("s_waitcnt vmcnt(" #n ")" ::: "memory")
#define PG8_WAIT_L(n) asm volatile("s_waitcnt lgkmcnt(" #n ")" ::: "memory")
#define PG8_BAR __builtin_amdgcn_s_barrier()
#define PG8_SCHED __builtin_amdgcn_sched_barrier(0)
#define PG8_VOFF(dst, u) do { _Pragma("unroll") for (int _h = 0; _h < 2; ++_h) _Pragma("unroll") for (int _i = 0; _i < 2; ++_i) dst[_h][_i] = al(u, _h * HALF + Rs[_i]) + Cb[_i]; } while (0)
    Unit cur, nxt; int ui = 0;
    if (!S.next(0, cur)) return;
    f32x4 acc[2][2][4][2];
#pragma unroll
    for (int a = 0; a < 2; ++a)
#pragma unroll
        for (int b = 0; b < 2; ++b)
#pragma unroll
            for (int m = 0; m < 4; ++m)
#pragma unroll
                for (int n = 0; n < 2; ++n) acc[a][b][m][n] = (f32x4){0.f, 0.f, 0.f, 0.f};
    bf16x8 At[4][2], B0[2][2], B1[2][2];
    unsigned vC[2][2], vP[2][2], vN[2][2];
    PG8_VOFF(vC, cur);
#pragma unroll
    for (int h = 0; h < 2; ++h)
#pragma unroll
        for (int i = 0; i < 2; ++i) vP[h][i] = vC[h][i];
    const char* const A0 = g.A;
    const char* cB = g.Bt + (size_t)cur.e * g.eStrideB + (size_t)cur.pn * tstepB;
    PG8_STAGE(PG8_SB(0, 0), cB, voffB); PG8_STAGE(PG8_SB(0, 1), cB + hstepB, voffB); PG8_STAGE(PG8_SA(0, 0), A0, vC[0]); PG8_STAGE(PG8_SA(0, 1), A0, vC[1]);
    if (wr == 1) PG8_BAR;
    PG8_WAIT_V(2); PG8_BAR;
    PG8_STAGE(PG8_SB(1, 0), cB + kstep, voffB); PG8_STAGE(PG8_SA(1, 0), A0 + kstep, vC[0]); PG8_STAGE(PG8_SB(1, 1), cB + hstepB + kstep, voffB);
    PG8_WAIT_V(6); PG8_BAR;
    for (;;) {
        const bool has_next = S.next(ui + 1, nxt);
        const char* nB = cB;
        if (has_next) { PG8_VOFF(vN, nxt); nB = g.Bt + (size_t)nxt.e * g.eStrideB + (size_t)nxt.pn * tstepB; }
        else {
#pragma unroll
            for (int h = 0; h < 2; ++h)
#pragma unroll
                for (int i = 0; i < 2; ++i) vN[h][i] = vC[h][i]; }
        for (int t = 0; t < nt; t += 2) {
            const bool last = (t == nt - 2);
            if (last) {
#pragma unroll
                for (int h = 0; h < 2; ++h)
#pragma unroll
                    for (int i = 0; i < 2; ++i) vP[h][i] = vN[h][i]; }
            const char* a1 = A0 + (size_t)(t + 1) * kstep;
            const char* a2 = last ? A0 : A0 + (size_t)(t + 2) * kstep; const char* b2 = last ? nB : cB + (size_t)(t + 2) * kstep;
            const char* a3 = a2 + kstep; const char* b3 = b2 + kstep;
            PG8_LDB(B0, 0, 0); PG8_LDB(B1, 0, 1); PG8_SCHED; PG8_LDA(At, 0, 0); PG8_STAGE(PG8_SA(1, 1), a1, vC[1]);
            PG8_WAIT_V(8); PG8_WAIT_L(0); PG8_BAR; PG8_MMA(0, 0, At, B0); PG8_MMA(0, 1, At, B1); PG8_BAR; PG8_SCHED;
            PG8_LDA(At, 0, 1); PG8_STAGE(PG8_SB(0, 0), b2, voffB); PG8_STAGE(PG8_SB(0, 1), b2 + hstepB, voffB); PG8_STAGE(PG8_SA(0, 0), a2, vP[0]);
            PG8_WAIT_V(8); PG8_WAIT_L(0); PG8_BAR; PG8_MMA(1, 0, At, B0); PG8_MMA(1, 1, At, B1); PG8_BAR; PG8_SCHED;
            PG8_LDB(B0, 1, 0); PG8_LDB(B1, 1, 1); PG8_SCHED; PG8_LDA(At, 1, 0); PG8_STAGE(PG8_SA(0, 1), a2, vP[1]);
            PG8_WAIT_V(8); PG8_WAIT_L(0); PG8_BAR; PG8_MMA(0, 0, At, B0); PG8_MMA(0, 1, At, B1); PG8_BAR; PG8_SCHED;
            PG8_LDA(At, 1, 1); PG8_STAGE(PG8_SB(1, 0), b3, voffB); PG8_STAGE(PG8_SB(1, 1), b3 + hstepB, voffB); PG8_STAGE(PG8_SA(1, 0), a3, vP[0]);
            PG8_WAIT_V(8); PG8_WAIT_L(0); PG8_BAR; PG8_MMA(1, 0, At, B0); PG8_MMA(1, 1, At, B1); PG8_BAR; PG8_SCHED;
        }
        if (wr == 0) PG8_BAR;
        E(acc, cur, wr, wc, fr, fq);
        if (!has_next) break;
#pragma unroll
        for (int a = 0; a < 2; ++a)
#pragma unroll
            for (int b = 0; b < 2; ++b)
#pragma unroll
                for (int m = 0; m < 4; ++m)
#pragma unroll
                    for (int n = 0; n < 2; ++n) acc[a][b][m][n] = (f32x4){0.f, 0.f, 0.f, 0.f};
        cur = nxt; cB = nB; ++ui;
#pragma unroll
        for (int h = 0; h < 2; ++h)
#pragma unroll
            for (int i = 0; i < 2; ++i) vC[h][i] = vP[h][i];
        if (wr == 1) PG8_BAR;
    }
    PG8_WAIT_V(0);
    PG8_BAR;
#undef PG8_SA
#undef PG8_SB
#undef PG8_STAGE
#undef PG8_LDA
#undef PG8_LDB
#undef PG8_MMA
#undef PG8_WAIT_V
#undef PG8_WAIT_L
#undef PG8_BAR
#undef PG8_SCHED
#undef PG8_VOFF
}
}

#define XB_TMO      128
#define XB_XCNT(j)  (256  + 64 * (j))
#define XB_XSUB(j)  (1280 + 64 * (j))
#define XB_XGEN(j)  (2304 + 64 * (j))
#define XB_TOP      3328
#define XB_TOPGEN   3392
#define XCD_BAR_WORDS 3456
#define XB_SPIN_CAP (1u << 18)
__device__ __forceinline__ unsigned xb_ld(unsigned* p)              { return __hip_atomic_load(p, __ATOMIC_RELAXED, __HIP_MEMORY_SCOPE_AGENT); }
__device__ __forceinline__ unsigned xb_add(unsigned* p, unsigned v) { return __hip_atomic_fetch_add(p, v, __ATOMIC_RELAXED, __HIP_MEMORY_SCOPE_AGENT); }
__device__ __forceinline__ unsigned xb_xcc_id() { return (unsigned)__builtin_amdgcn_s_getreg((3 << 11) | 20) & 0xFu; }
#define XB_SPIN(cond, bar) do { unsigned _sp = 0; while (cond) { __builtin_amdgcn_s_sleep(1); \
    if ((++_sp & 255u) == 0u) { if (xb_ld(&(bar)[XB_TMO])) break; if (_sp > XB_SPIN_CAP) { atomicAdd(&(bar)[XB_TMO], 1u); break; } } } } while (0)
struct XcdBarrier { unsigned* bar; unsigned x; volatile LAS unsigned* st; };
__device__ __forceinline__ XcdBarrier xcd_barrier_post(unsigned* bar, volatile LAS unsigned* st) {
    XcdBarrier b; b.bar = bar; b.x = xb_xcc_id(); b.st = st;
    if (threadIdx.x == 0) (void)xb_add(&bar[XB_XCNT(b.x)], 1u);
    return b;
}
__device__ __forceinline__ void xcd_barrier_complete(unsigned* bar, unsigned x, unsigned& nloc, unsigned& nx) {
    const unsigned G = gridDim.x * gridDim.y * gridDim.z;
    unsigned sum, cnt, mine, sp = 0u;
    for (;;) {
        sum = 0u; cnt = 0u; mine = 0u;
#pragma unroll
        for (unsigned j = 0; j < 16; ++j) { const unsigned c = xb_ld(&bar[XB_XCNT(j)]); sum += c; cnt += (c > 0u) ? 1u : 0u; mine = (j == x) ? c : mine; }
        if (sum == G) break;
        __builtin_amdgcn_s_sleep(1);
        if ((++sp & 255u) == 0u) { if (xb_ld(&bar[XB_TMO])) break; if (sp > XB_SPIN_CAP) { atomicAdd(&bar[XB_TMO], 1u); break; } }
    }
    nloc = mine > 0u ? mine : 1u; nx = cnt > 0u ? cnt : 1u;
}
__device__ __forceinline__ void xcd_barrier(const XcdBarrier& b) {
    asm volatile("s_waitcnt vmcnt(0)" ::: "memory");
    __syncthreads();
    if (threadIdx.x == 0) {
        unsigned* bar = b.bar;
        __builtin_amdgcn_s_waitcnt(0);
        unsigned nloc = b.st[0], nx = b.st[1];
        if (nloc == 0u) { xcd_barrier_complete(bar, b.x, nloc, nx); b.st[0] = nloc; b.st[1] = nx; }
        const unsigned old = xb_add(&bar[XB_XSUB(b.x)], 1u);
        const unsigned gen = old / nloc;
        if (old + 1u == (gen + 1u) * nloc) {
            __builtin_amdgcn_fence(__ATOMIC_RELEASE, "agent");
            asm volatile("s_waitcnt vmcnt(0)" ::: "memory");
            const unsigned og = xb_add(&bar[XB_TOP], 1u);
            const unsigned tg = og / nx;
            if (og + 1u == (tg + 1u) * nx) xb_add(&bar[XB_TOPGEN], 1u);
            else XB_SPIN(xb_ld(&bar[XB_TOPGEN]) == tg, bar);
            __builtin_amdgcn_fence(__ATOMIC_ACQUIRE, "agent");
            xb_add(&bar[XB_XGEN(b.x)], 1u);
            asm volatile("s_waitcnt vmcnt(0)" ::: "memory");
        } else {
            XB_SPIN(xb_ld(&bar[XB_XGEN(b.x)]) == gen, bar);
            __builtin_amdgcn_fence(__ATOMIC_ACQUIRE, "agent");
            asm volatile("s_waitcnt vmcnt(0)" ::: "memory");
        }
    }
    __syncthreads();
}

struct Args {
    const float* in[25]; float* out; unsigned char* ws; int ph_lo, ph_hi;
};
struct Frame {
    LAS unsigned char* lds; gu32* ctl; unsigned char* ws;
    int tid, lane, wave, vcu, G;
};
enum { I_X = 0, I_WIN, I_SINK, I_PEK, I_WK1, I_WK2, I_PEV, I_WV1, I_WV2, I_WO, I_FG, I_FU, I_FD, I_GIN, I_GLNG, I_GLNB, I_GWS, I_GBS, I_GOUT, I_RT, I_MG, I_MU, I_MD, I_LNG, I_LNB };

__device__ __forceinline__ void tr_item(const float* W, int pitch, int k0, int n0, bf16* dst, int ldk, LAS float* scr, int lane) {
#pragma unroll 8
    for (int i = 0; i < 32; ++i) { const int kk = 2 * i + (lane >> 5); scr[kk * 33 + (lane & 31)] = W[(size_t)(k0 + kk) * pitch + n0 + (lane & 31)]; }
    LDS_WAIT(); asm volatile("" ::: "memory");
    const int c = lane & 7;
#pragma unroll
    for (int j = 0; j < 4; ++j) { const int n = (lane >> 3) + 8 * j; const LAS float* s = scr + (8 * c) * 33 + n;
        u32x4 o; o.x = pk2(s[0 * 33], s[1 * 33]); o.y = pk2(s[2 * 33], s[3 * 33]); o.z = pk2(s[4 * 33], s[5 * 33]); o.w = pk2(s[6 * 33], s[7 * 33]);
        *(u32x4*)(dst + (size_t)n * ldk + 8 * c) = o; }
    LDS_WAIT(); asm volatile("" ::: "memory");
}
__device__ __forceinline__ void tr_matrix_item(const float* W, int pitch, int K, int N, bf16* WT, int inter_up  , LAS float* scr, int item, int lane) {
    const int nblk = N / 32, kb = item / nblk, nb = item % nblk, k0 = 64 * kb, n0 = 32 * nb;
    const int drow = inter_up < 0 ? n0 : ((n0 >> 7) * 256 + (n0 & 127) + inter_up * 128);
    tr_item(W, pitch, k0, n0, WT + (size_t)drow * K + k0, K, scr, lane);
}

__device__ __forceinline__ void p0_prologue(Frame& F, const Args& a) {
    LAS float* scr = (LAS float*)(F.lds + F.wave * 16384);
    const int gw = F.vcu * NWAVES + F.wave, NGW = F.G * NWAVES;
    unsigned char* ws = F.ws;
    constexpr int IT_WIN = (D / 64) * (2048 / 32), IT_C1 = (2048 / 64) * (256 / 32), IT_SQ = (D / 64) * (D / 32), IT_FG = (D / 64) * (DFF / 32), IT_FD = (DFF / 64) * (D / 32),
                  IT_GIN = (D / 64) * (2048 / 32), IT_MG = (D / 64) * (DFE / 32), IT_MD = (DFE / 64) * (D / 32);
    constexpr int NITEMS = IT_WIN + 2 * IT_C1 + IT_SQ + 2 * IT_FG + IT_FD + IT_GIN + IT_SQ + NEXP * (2 * IT_MG + IT_MD);
    for (int it = gw; it < NITEMS; it += NGW) {
        int r = it;
        if (r < IT_WIN) { tr_matrix_item(a.in[I_WIN], INW, D, 2048, (bf16*)(ws + WS_WIN), -1, scr, r, F.lane); continue; } r -= IT_WIN;
        if (r < IT_C1) { tr_matrix_item(a.in[I_WK1], 256, 2048, 256, (bf16*)(ws + WS_WC1), -1, scr, r, F.lane); continue; } r -= IT_C1;
        if (r < IT_C1) { tr_matrix_item(a.in[I_WV1], 256, 2048, 256, (bf16*)(ws + WS_WC1) + 256 * 2048, -1, scr, r, F.lane); continue; } r -= IT_C1;
        if (r < IT_SQ) { tr_matrix_item(a.in[I_WO], D, D, D, (bf16*)(ws + WS_WO), -1, scr, r, F.lane); continue; } r -= IT_SQ;
        if (r < IT_FG) { tr_matrix_item(a.in[I_FG], DFF, D, DFF, (bf16*)(ws + WS_FGU), 0, scr, r, F.lane); continue; } r -= IT_FG;
        if (r < IT_FG) { tr_matrix_item(a.in[I_FU], DFF, D, DFF, (bf16*)(ws + WS_FGU), 1, scr, r, F.lane); continue; } r -= IT_FG;
        if (r < IT_FD) { tr_matrix_item(a.in[I_FD], D, DFF, D, (bf16*)(ws + WS_FDN), -1, scr, r, F.lane); continue; } r -= IT_FD;
        if (r < IT_GIN) { tr_matrix_item(a.in[I_GIN], 2048, D, 2048, (bf16*)(ws + WS_GIN), -1, scr, r, F.lane); continue; } r -= IT_GIN;
        if (r < IT_SQ) { tr_matrix_item(a.in[I_GOUT], D, D, D, (bf16*)(ws + WS_GOUT), -1, scr, r, F.lane); continue; } r -= IT_SQ;
        { const int per_e = 2 * IT_MG + IT_MD; const int e = r / per_e; int q = r % per_e;
          if (q < IT_MG) { tr_matrix_item(a.in[I_MG] + (size_t)e * D * DFE, DFE, D, DFE, (bf16*)(ws + WS_MGU) + (size_t)e * 2 * DFE * D, 0, scr, q, F.lane); continue; } q -= IT_MG;
          if (q < IT_MG) { tr_matrix_item(a.in[I_MU] + (size_t)e * D * DFE, DFE, D, DFE, (bf16*)(ws + WS_MGU) + (size_t)e * 2 * DFE * D, 1, scr, q, F.lane); continue; } q -= IT_MG;
          tr_matrix_item(a.in[I_MD] + (size_t)e * DFE * D, D, DFE, D, (bf16*)(ws + WS_MDN) + (size_t)e * D * DFE, -1, scr, q, F.lane); }
    }
    if (blockIdx.x < 16) {
        const int kv = blockIdx.x >> 3, n = (blockIdx.x & 7) * 32 + (F.tid & 31), ks = F.tid >> 5;
        const float* pe = a.in[kv ? I_PEV : I_PEK]; const float* w1 = a.in[kv ? I_WV1 : I_WK1]; float* b1 = (float*)(ws + WS_SMALL) + kv * 256;
        float sacc = 0.f;
#pragma unroll 8
        for (int k = ks * 128; k < ks * 128 + 128; ++k) sacc += pe[k] * w1[(size_t)k * 256 + n];
        LAS float* red = (LAS float*)(F.lds + 124 * 1024);
        red[F.tid] = sacc; __syncthreads();
        if (F.tid < 32) { float t = 0.f; for (int q = 0; q < 16; ++q) t += red[q * 32 + F.tid]; b1[n] = t; }
        __syncthreads();
    }
    {
        const float* x = a.in[I_X]; const float* win = a.in[I_WIN]; bf16* xb = (bf16*)(ws + WS_XB); float* gates = (float*)(ws + WS_GATES);
        LAS float* wg = (LAS float*)F.lds;
        __syncthreads();
        for (int i = F.tid; i < 24 * 1024; i += NTHREADS) { const int ch = i / 24, q = i % 24; wg[q * 1024 + ch] = win[(size_t)ch * INW + 2048 + q]; }
        __syncthreads();
        for (int m = gw; m < M; m += NGW) {
            const f32x4* xr = (const f32x4*)(x + (size_t)m * D) + F.lane; f32x4 v[4];
#pragma unroll
            for (int j = 0; j < 4; ++j) v[j] = xr[64 * j];
            unsigned long long* o8 = (unsigned long long*)(xb + (size_t)m * D) + F.lane;
#pragma unroll
            for (int j = 0; j < 4; ++j) o8[64 * j] = (unsigned long long)pk2(v[j][0], v[j][1]) | ((unsigned long long)pk2(v[j][2], v[j][3]) << 32);
            float mine = 0.f;
#pragma unroll 2
            for (int q = 0; q < 24; ++q) { float gq = 0.f;
#pragma unroll
                for (int j = 0; j < 4; ++j) { const f32x4 wv = *(const LAS f32x4*)(wg + q * 1024 + 256 * j + 4 * F.lane); gq += v[j][0] * wv[0] + v[j][1] * wv[1] + v[j][2] * wv[2] + v[j][3] * wv[3]; }
                gq = wave_sum(gq); mine = (F.lane == q) ? gq : mine; }
            if (F.lane < 24) gates[(size_t)m * 24 + F.lane] = mine;
        }
        __syncthreads();
    }
    if (blockIdx.x == 2 && F.tid < 256) ((u32x4*)(ws + WS_KC + (size_t)2 * 32 * 2048 * 64 * 2))[F.tid] = (u32x4){0u, 0u, 0u, 0u};
}

__device__ __forceinline__ void load_q(float (&q)[64], const bf16* qp, float scale) {
#pragma unroll
    for (int i = 0; i < 8; ++i) { const u32x4 v = ((const u32x4*)qp)[i];
        q[8 * i + 0] = bflo(v.x) * scale; q[8 * i + 1] = bfhi(v.x) * scale; q[8 * i + 2] = bflo(v.y) * scale; q[8 * i + 3] = bfhi(v.y) * scale;
        q[8 * i + 4] = bflo(v.z) * scale; q[8 * i + 5] = bfhi(v.z) * scale; q[8 * i + 6] = bflo(v.w) * scale; q[8 * i + 7] = bfhi(v.w) * scale; }
}
__device__ __forceinline__ float dot_bf(const float (&q)[64], const bf16* kp) {
    float s = 0.f;
#pragma unroll
    for (int i = 0; i < 8; ++i) { const u32x4 v = ((const u32x4*)kp)[i];
        s += q[8 * i + 0] * bflo(v.x) + q[8 * i + 1] * bfhi(v.x) + q[8 * i + 2] * bflo(v.y) + q[8 * i + 3] * bfhi(v.y)
           + q[8 * i + 4] * bflo(v.z) + q[8 * i + 5] * bfhi(v.z) + q[8 * i + 6] * bflo(v.w) + q[8 * i + 7] * bfhi(v.w); }
    return s;
}
__device__ __forceinline__ float dot_f32(const float (&q)[64], const float* kp) {
    float s = 0.f;
#pragma unroll
    for (int i = 0; i < 16; ++i) { const f32x4 v = ((const f32x4*)kp)[i]; s += q[4 * i] * v[0] + q[4 * i + 1] * v[1] + q[4 * i + 2] * v[2] + q[4 * i + 3] * v[3]; }
    return s;
}
__device__ __forceinline__ float pv_bf(float o, float e, const bf16* vbase, size_t pitch, int j0, int j1, int lane) {
    for (int j = j0; j < j1; ++j) { const float p = __builtin_bit_cast(float, __builtin_amdgcn_readlane(__builtin_bit_cast(int, e), j)); o += p * bf2f(vbase[(size_t)j * pitch + lane]); }
    return o;
}
__device__ __forceinline__ float pv_f32(float o, float e, const float* vbase, size_t pitch, int j0, int j1, int lane) {
    for (int j = j0; j < j1; ++j) { const float p = __builtin_bit_cast(float, __builtin_amdgcn_readlane(__builtin_bit_cast(int, e), j)); o += p * vbase[(size_t)j * pitch + lane]; }
    return o;
}
__device__ __forceinline__ float alibi_slope(int h) { return exp2f(-0.5f * (float)(h + 1)); }

__device__ __forceinline__ void p4_attention(Frame& F, const Args& a) {
    const int gw = F.vcu * NWAVES + F.wave, NGW = F.G * NWAVES, lane = F.lane;
    const bf16* P = (const bf16*)(F.ws + WS_P); bf16* O = (bf16*)(F.ws + WS_O);
    const float NINF = -__builtin_inff();
    for (int task = gw; task < M * 8; task += NGW) {
        const int m = task >> 3, h = task & 7, b = m >> 11, t = m & 2047, kvh = h >> 2;
        const float slope = alibi_slope(h), sink = a.in[I_SINK][h];
        float q[64]; load_q(q, P + (size_t)m * PW + h * 64, 0.125f);
        const bf16* Kb = P + (size_t)b * SEQ * PW + 512 + kvh * 64; const bf16* Vb = P + (size_t)b * SEQ * PW + 640 + kvh * 64;
        float s[2];
#pragma unroll
        for (int c = 0; c < 2; ++c) { const int kp = t - 127 + 64 * c + lane; const bool valid = kp >= 0; const int kc = valid ? kp : 0;
            const float d = dot_bf(q, Kb + (size_t)kc * PW); s[c] = valid ? d - slope * (float)(t - kp) : NINF; }
        float mx = fmaxf(wave_max(fmaxf(s[0], s[1])), sink);
        float e0 = __expf(s[0] - mx), e1 = __expf(s[1] - mx);
        const float den = wave_sum(e0 + e1) + __expf(sink - mx);
        float o = 0.f;
#pragma unroll
        for (int c = 0; c < 2; ++c) { const int base = t - 127 + 64 * c; const int j0 = base < 0 ? (-base < 64 ? -base : 64) : 0;
            o = pv_bf(o, c ? e1 : e0, Vb + (long)base * PW, PW, j0, 64, lane); }
        O[(size_t)m * D + h * 64 + lane] = (bf16)f2bf(o / den);
    }
    const float* KCC = (const float*)(F.ws + WS_KCC); const float* gates = (const float*)(F.ws + WS_GATES);
    LAS float* sc = (LAS float*)(F.lds + F.wave * 1024);
    for (int task = gw; task < M * 2; task += NGW) {
        const int m = task >> 1, hkv = task & 1, b = m >> 11, t = m & 2047, tb = t >> 6;
        const int nvc = t >= 31 ? ((t - 31) / 16 + 1 < NCMP ? (t - 31) / 16 + 1 : NCMP) : 0;
        const float* kcc = KCC + (size_t)((b * 2 + hkv) * 128) * 64; const float* vcc = KCC + (size_t)4096 * 64 + (size_t)((b * 2 + hkv) * 128) * 64;
        float oc0 = 0.f, oc1 = 0.f, oc2 = 0.f, oc3 = 0.f, ps0 = 0.f, ps1 = 0.f;
#pragma unroll 1
        for (int g = 0; g < 4; ++g) {
            const int hb = hkv * 4 + g; const float slope = alibi_slope(8 + hb);
            float q[64]; load_q(q, P + (size_t)m * PW + 768 + hb * 64, 0.125f);
            float s[2];
#pragma unroll
            for (int c = 0; c < 2; ++c) { const int cb = 64 * c + lane; const bool valid = cb < nvc;
                const float d = dot_f32(q, kcc + (size_t)cb * 64); s[c] = valid ? d - slope * (float)(t - (16 * cb + 31)) : NINF; }
            float mx = wave_max(fmaxf(s[0], s[1])); if (!(mx > NINF)) mx = 0.f;
            float e0 = (lane < nvc) ? __expf(s[0] - mx) : 0.f, e1 = (64 + lane < nvc) ? __expf(s[1] - mx) : 0.f;
            const float den = wave_sum(e0 + e1); const float inv = den > 0.f ? 1.0f / den : 1.0f;
            e0 *= inv; e1 *= inv; ps0 += e0; ps1 += e1;
            float o = 0.f;
            o = pv_f32(o, e0, vcc, 64, 0, nvc < 64 ? nvc : 64, lane);
            o = pv_f32(o, e1, vcc + 64 * 64, 64, 0, nvc > 64 ? nvc - 64 : 0, lane);
            oc0 = (g == 0) ? o : oc0; oc1 = (g == 1) ? o : oc1; oc2 = (g == 2) ? o : oc2; oc3 = (g == 3) ? o : oc3;
        }
        sc[lane] = ps0; sc[64 + lane] = ps1; LDS_WAIT(); asm volatile("" ::: "memory");
        float imp = 0.f;
        if (lane < 32) {
#pragma unroll
            for (int k = -1; k <= 3; ++k) { const int c = 4 * lane + k; if (c >= 0 && c < NCMP) imp += sc[c]; } }
        LDS_WAIT(); asm volatile("" ::: "memory");
        const bool validj = lane <= tb, forced = (lane == 0) || (lane == tb) || (lane == tb - 1);
        const float rank = (lane >= 32) ? NINF : (forced ? __builtin_inff() : (validj ? imp : NINF));
        int cnt = 0;
        for (int jj = 0; jj < 32; ++jj) { const float rj = __builtin_bit_cast(float, __builtin_amdgcn_readlane(__builtin_bit_cast(int, rank), jj)); cnt += (rj > rank || (rj == rank && jj < lane)) ? 1 : 0; }
        const unsigned selmask = (unsigned)__ballot(lane < 32 && cnt < 8 && validj);
#pragma unroll 1
        for (int g = 0; g < 4; ++g) {
            const int hb = hkv * 4 + g; const float slope = alibi_slope(8 + hb);
            float q[64]; load_q(q, P + (size_t)m * PW + 768 + hb * 64, 0.125f);
            float oslc = 0.f;
            {
                const bf16* Kb = P + (size_t)b * SEQ * PW + 1536 + hkv * 64; const bf16* Vb = P + (size_t)b * SEQ * PW + 1664 + hkv * 64;
                float s[8]; unsigned mm = selmask; float mx = NINF;
#pragma unroll
                for (int i = 0; i < 8; ++i) { s[i] = NINF;
                    if (mm) { const int j = __builtin_ctz(mm); mm &= mm - 1; const int kp = 64 * j + lane; const bool valid = kp <= t; const int kc = valid ? kp : t;
                        const float d = dot_bf(q, Kb + (size_t)kc * PW); s[i] = valid ? d - slope * (float)(t - kp) : NINF; }
                    mx = fmaxf(mx, s[i]); }
                mx = wave_max(mx);
                float den = 0.f;
#pragma unroll
                for (int i = 0; i < 8; ++i) { s[i] = __expf(s[i] - mx); den += s[i]; }
                den = wave_sum(den);
                mm = selmask;
#pragma unroll
                for (int i = 0; i < 8; ++i) { if (mm) { const int j = __builtin_ctz(mm); mm &= mm - 1; const int nk = (t - 64 * j + 1) < 64 ? (t - 64 * j + 1) : 64;
                        oslc = pv_bf(oslc, s[i], Vb + (size_t)(64 * j) * PW, PW, 0, nk, lane); } }
                oslc /= den;
            }
            float owin = 0.f;
            {
                const bf16* Kb = P + (size_t)b * SEQ * PW + 1792 + hkv * 64; const bf16* Vb = P + (size_t)b * SEQ * PW + 1920 + hkv * 64;
                float s[4]; float mx = NINF;
#pragma unroll
                for (int c = 0; c < 4; ++c) { const int kp = t - 255 + 64 * c + lane; const bool valid = kp >= 0; const int kc = valid ? kp : 0;
                    const float d = dot_bf(q, Kb + (size_t)kc * PW); s[c] = valid ? d - slope * (float)(t - kp) : NINF; mx = fmaxf(mx, s[c]); }
                mx = wave_max(mx);
                float den = 0.f;
#pragma unroll
                for (int c = 0; c < 4; ++c) { s[c] = __expf(s[c] - mx); den += s[c]; }
                den = wave_sum(den);
#pragma unroll
                for (int c = 0; c < 4; ++c) { const int base = t - 255 + 64 * c; const int j0 = base < 0 ? (-base < 64 ? -base : 64) : 0;
                    owin = pv_bf(owin, s[c], Vb + (long)base * PW, PW, j0, 64, lane); }
                owin /= den;
            }
            const float* gp = gates + (size_t)m * 24 + hb * 3;
            const float oc = (g == 0) ? oc0 : (g == 1) ? oc1 : (g == 2) ? oc2 : oc3;
            const float r = sigmoidf(gp[0]) * oc + sigmoidf(gp[1]) * oslc + sigmoidf(gp[2]) * owin;
            O[(size_t)m * D + 512 + hb * 64 + lane] = (bf16)f2bf(r);
        }
    }
}


namespace att {
typedef float f32x16 __attribute__((ext_vector_type(16)));
typedef short s16x4 __attribute__((ext_vector_type(4)));
typedef __bf16 bf16x2_t __attribute__((ext_vector_type(2)));
constexpr int KP = 144;
constexpr int TILEB = 64 * KP;
constexpr int BUFB = 2 * TILEB;
constexpr float LOG2E = 1.4426950408889634f;
__device__ __forceinline__ unsigned cvtpk(float lo, float hi) { f32x2 v = {lo, hi}; bf16x2_t b = __builtin_convertvector(v, bf16x2_t); return __builtin_bit_cast(unsigned, b); }
__device__ __forceinline__ f32x16 zero16() { f32x16 z;
#pragma unroll
    for (int i = 0; i < 16; ++i) z[i] = 0.f; return z; }
struct Stage { u32x4 k, v; };
__device__ __forceinline__ void stage_load(Stage& s, const bf16* Kg, const bf16* Vg, size_t pitch, int row0, int tid) {
    const int key = tid >> 3, ch = tid & 7; s.k = *(const u32x4*)(Kg + (size_t)(row0 + key) * pitch + ch * 8); s.v = *(const u32x4*)(Vg + (size_t)(row0 + key) * pitch + ch * 8); }
__device__ __forceinline__ void stage_store(const Stage& s, LAS unsigned char* buf, int tid) {
    const int key = tid >> 3, ch = tid & 7; *(LAS u32x4*)(buf + key * KP + ch * 16) = s.k; *(LAS u32x4*)(buf + TILEB + key * KP + ch * 16) = s.v; }
__device__ __forceinline__ bf16x8 pack_frag(const f32x16& x, int s) {
    u32x4 w; w.x = cvtpk(x[8 * s], x[8 * s + 1]); w.y = cvtpk(x[8 * s + 2], x[8 * s + 3]); w.z = cvtpk(x[8 * s + 4], x[8 * s + 5]); w.w = cvtpk(x[8 * s + 6], x[8 * s + 7]); return __builtin_bit_cast(bf16x8, w); }

template <int MODE>
__device__ __forceinline__ void stream(f32x16 (&oT)[2], f32x16& imp, float& m_run, float& l_run, const bf16x8 (&qf)[4], const bf16* Kg, const bf16* Vg, size_t pitch,
                                       int first, int ntile, unsigned umask, int tq, float slope, unsigned selmask, int W, LAS unsigned char* lds, int tid, int lane) {
    const int r = lane & 31, h = lane >> 5;
    const float NINF = -__builtin_inff();
    if (ntile <= 0) return;
    __syncthreads();
    Stage st; unsigned mm = umask;
    int kt = (MODE == 1) ? __builtin_ctz(mm) : first; if (MODE == 1) mm &= mm - 1;
    stage_load(st, Kg, Vg, pitch, 64 * kt, tid);
    for (int i = 0; i < ntile; ++i) {
        LAS unsigned char* buf = lds + (i & 1) * BUFB;
        stage_store(st, buf, tid);
        __syncthreads();
        const int ktc = kt;
        if (i + 1 < ntile) { kt = (MODE == 1) ? __builtin_ctz(mm) : kt + 1; if (MODE == 1) mm &= mm - 1; stage_load(st, Kg, Vg, pitch, 64 * kt, tid); }
        f32x16 p[2];
#pragma unroll
        for (int blk = 0; blk < 2; ++blk) { p[blk] = zero16();
#pragma unroll
            for (int d0 = 0; d0 < 4; ++d0) { const bf16x8 ka = *(const LAS bf16x8*)(buf + (32 * blk + r) * KP + (16 * d0 + 8 * h) * 2);
                p[blk] = __builtin_amdgcn_mfma_f32_32x32x16_bf16(ka, qf[d0], p[blk], 0, 0, 0); } }
        float fb, step;
        if (MODE == 2) { fb = (float)(tq - 31 - 16 * (64 * ktc + 4 * h)); step = 16.f; } else { fb = (float)(tq - 64 * ktc - 4 * h); step = 1.f; }
        const bool lane_on = (MODE == 1) ? ((selmask >> ktc) & 1u) != 0u : true;
        float tmax = NINF;
#pragma unroll
        for (int blk = 0; blk < 2; ++blk)
#pragma unroll
            for (int i2 = 0; i2 < 16; ++i2) { const float dist = fb - step * (float)(32 * blk + (i2 & 3) + 8 * (i2 >> 2));
                bool valid = dist >= 0.f && lane_on; if (MODE == 0) valid = valid && dist < (float)W;
                const float sv = valid ? p[blk][i2] - slope * dist : NINF; p[blk][i2] = sv; tmax = fmaxf(tmax, sv); }
        tmax = fmaxf(tmax, __shfl_xor(tmax, 32));
        const float m_new = fmaxf(m_run, tmax), m_use = (m_new == NINF) ? 0.f : m_new;
        const float alpha = __builtin_amdgcn_exp2f((m_run - m_use) * LOG2E), mb = -m_use * LOG2E;
        float rs = 0.f;
#pragma unroll
        for (int blk = 0; blk < 2; ++blk)
#pragma unroll
            for (int i2 = 0; i2 < 16; ++i2) { const float e = __builtin_amdgcn_exp2f(fmaf(p[blk][i2], LOG2E, mb)); p[blk][i2] = e; rs += e; }
        l_run = l_run * alpha + rs; m_run = m_new;
#pragma unroll
        for (int i2 = 0; i2 < 16; ++i2) { oT[0][i2] *= alpha; oT[1][i2] *= alpha; if (MODE == 2) imp[i2] *= alpha; }
        const LAS unsigned char* vb = buf + TILEB + (4 * h + ((lane >> 2) & 3)) * KP + (16 * ((lane >> 4) & 1) + 4 * (lane & 3)) * 2;
#pragma unroll
        for (int blk = 0; blk < 2; ++blk)
#pragma unroll
            for (int s = 0; s < 2; ++s) { const int ks = 2 * blk + s; const bf16x8 pf = pack_frag(p[blk], s);
#pragma unroll
                for (int db = 0; db < 2; ++db) { const LAS unsigned char* ad = vb + (16 * ks) * KP + (32 * db) * 2;
                    const s16x4 lo = __builtin_bit_cast(s16x4, __builtin_amdgcn_ds_read_tr16_b64_v4i16((LAS s16x4*)ad));
                    const s16x4 hi = __builtin_bit_cast(s16x4, __builtin_amdgcn_ds_read_tr16_b64_v4i16((LAS s16x4*)(ad + 8 * KP)));
                    const bf16x8 vf = (bf16x8){lo[0], lo[1], lo[2], lo[3], hi[0], hi[1], hi[2], hi[3]};
                    oT[db] = __builtin_amdgcn_mfma_f32_32x32x16_bf16(vf, pf, oT[db], 0, 0, 0); }
                if (MODE == 2) {
                    u32x4 w;
#pragma unroll
                    for (int e2 = 0; e2 < 4; ++e2) { const int c0 = 64 * ktc + 16 * ks + 8 * (e2 >> 1) + 4 * h + 2 * (e2 & 1), c1 = c0 + 1;
                        const unsigned b0 = (c0 >= 4 * r - 1 && c0 <= 4 * r + 3) ? 0x3F80u : 0u, b1 = (c1 >= 4 * r - 1 && c1 <= 4 * r + 3) ? 0x3F80u : 0u; w[e2] = b0 | (b1 << 16); }
                    imp = __builtin_amdgcn_mfma_f32_32x32x16_bf16(__builtin_bit_cast(bf16x8, w), pf, imp, 0, 0, 0); } }
    }
}
__device__ __forceinline__ void load_qfrag(bf16x8 (&qf)[4], const bf16* qrow, int h) {
#pragma unroll
    for (int d0 = 0; d0 < 4; ++d0) { const u32x4 v = *(const u32x4*)(qrow + 16 * d0 + 8 * h); u32x4 w;
        w.x = cvtpk(bflo(v.x) * 0.125f, bfhi(v.x) * 0.125f); w.y = cvtpk(bflo(v.y) * 0.125f, bfhi(v.y) * 0.125f); w.z = cvtpk(bflo(v.z) * 0.125f, bfhi(v.z) * 0.125f); w.w = cvtpk(bflo(v.w) * 0.125f, bfhi(v.w) * 0.125f);
        qf[d0] = __builtin_bit_cast(bf16x8, w); }
}
__device__ __forceinline__ void fold(f32x16 (&res)[2], const f32x16 (&oT)[2], float sc) {
#pragma unroll
    for (int i = 0; i < 16; ++i) { res[0][i] += sc * oT[0][i]; res[1][i] += sc * oT[1][i]; } }
__device__ __forceinline__ void store_o(bf16* orow, const f32x16 (&res)[2], int h) {
#pragma unroll
    for (int db = 0; db < 2; ++db)
#pragma unroll
        for (int a4 = 0; a4 < 4; ++a4) { u32x2 w; w.x = cvtpk(res[db][4 * a4], res[db][4 * a4 + 1]); w.y = cvtpk(res[db][4 * a4 + 2], res[db][4 * a4 + 3]);
            *(u32x2*)(orow + 32 * db + 8 * a4 + 4 * h) = w; }
}
}

__device__ __forceinline__ void p4_attention_mfma(Frame& F, const Args& a) {
    using namespace att;
    const int lane = F.lane, tid = F.tid, w = F.wave, r = lane & 31, h = lane >> 5, g = r >> 3, qi = r & 7;
    const bf16* P = (const bf16*)(F.ws + WS_P); bf16* O = (bf16*)(F.ws + WS_O);
    const bf16* KCB = (const bf16*)(F.ws + WS_KCCB); const float* gates = (const float*)(F.ws + WS_GATES);
    LAS unsigned* ubuf = (LAS unsigned*)(F.lds + 4 * BUFB);
    const float NINF = -__builtin_inff();
    const int x = F.vcu, bh = x >> 3, qslot = x & 7, b = bh >> 1, hkv = bh & 1;
    if (x >= 256) return;
    for (int rr = 0; rr < 4; ++rr) {
        const int qt = (rr & 1) ? 8 * rr + 7 - qslot : 8 * rr + qslot;
        const int tq = 64 * qt + 8 * w + qi; const size_t m = (size_t)b * SEQ + tq;
        const bf16* Pb = P + (size_t)b * SEQ * PW;
        {
            const int hd = hkv * 4 + g; const float slope = alibi_slope(hd);
            bf16x8 qf[4]; load_qfrag(qf, P + m * PW + hd * 64, h);
            f32x16 oT[2] = {zero16(), zero16()}, dummy = zero16(); float m_run = NINF, l_run = 0.f;
            const int first = qt >= 2 ? qt - 2 : 0;
            stream<0>(oT, dummy, m_run, l_run, qf, Pb + 512 + hkv * 64, Pb + 640 + hkv * 64, PW, first, qt - first + 1, 0u, tq, slope, 0u, 128, F.lds, tid, lane);
            float l_tot = l_run + __shfl_xor(l_run, 32); l_tot += __expf(a.in[I_SINK][hd] - m_run);
            f32x16 res[2] = {zero16(), zero16()}; fold(res, oT, 1.0f / l_tot);
            store_o(O + m * D + hd * 64, res, h);
        }
        {
            const int hb = hkv * 4 + g; const float slope = alibi_slope(8 + hb);
            bf16x8 qf[4]; load_qfrag(qf, P + m * PW + 768 + hb * 64, h);
            const float* gp = gates + m * 24 + hb * 3;
            const float g0 = sigmoidf(gp[0]), g1 = sigmoidf(gp[1]), g2 = sigmoidf(gp[2]);
            f32x16 res[2] = {zero16(), zero16()};
            unsigned selmask = 0u;
            {
                f32x16 oT[2] = {zero16(), zero16()}, imp = zero16(); float m_run = NINF, l_run = 0.f;
                const int nvc_max = (64 * qt + 63 >= 31) ? ((64 * qt + 63 - 31) / 16 + 1) : 0;
                const int ntile = nvc_max > 64 ? 2 : (nvc_max > 0 ? 1 : 0);
                stream<2>(oT, imp, m_run, l_run, qf, KCB + (size_t)(bh * 128) * 64, KCB + (size_t)4096 * 64 + (size_t)(bh * 128) * 64, 64, 0, ntile, 0u, tq, slope, 0u, 0, F.lds, tid, lane);
                const float l_tot = l_run + __shfl_xor(l_run, 32); const float inv = l_tot > 0.f ? 1.0f / l_tot : 0.f;
                fold(res, oT, g0 * inv);
                float R[32];
#pragma unroll
                for (int i = 0; i < 16; ++i) { float v = imp[i] * inv; v += __shfl_xor(v, 8); v += __shfl_xor(v, 16); const float o = __shfl_xor(v, 32);
                    const int j0 = (i & 3) + 8 * (i >> 2); R[j0] = h ? o : v; R[j0 + 4] = h ? v : o; }
                const int tb = tq >> 6;
#pragma unroll
                for (int j = 0; j < 32; ++j) R[j] = (j == 0 || j == tb || j == tb - 1) ? __builtin_inff() : (j <= tb ? R[j] : NINF);
#pragma unroll 1
                for (int rd = 0; rd < 8; ++rd) { float best = NINF; int bj = -1;
#pragma unroll
                    for (int j = 0; j < 32; ++j) { if (R[j] > best) { best = R[j]; bj = j; } }
                    if (bj >= 0) selmask |= 1u << bj;
#pragma unroll
                    for (int j = 0; j < 32; ++j) R[j] = (j == bj) ? NINF : R[j]; }
            }
            unsigned um = selmask;
#pragma unroll
            for (int o2 = 1; o2 < 64; o2 <<= 1) um |= (unsigned)__shfl_xor((int)um, o2);
            __syncthreads();
            if (lane == 0) ubuf[w] = um;
            __syncthreads();
            um = ubuf[0] | ubuf[1] | ubuf[2] | ubuf[3] | ubuf[4] | ubuf[5] | ubuf[6] | ubuf[7];
            um = (unsigned)__builtin_amdgcn_readfirstlane((int)um);
            {
                f32x16 oT[2] = {zero16(), zero16()}, dummy = zero16(); float m_run = NINF, l_run = 0.f;
                stream<1>(oT, dummy, m_run, l_run, qf, Pb + 1536 + hkv * 64, Pb + 1664 + hkv * 64, PW, 0, __builtin_popcount(um), um, tq, slope, selmask, 0, F.lds, tid, lane);
                const float l_tot = l_run + __shfl_xor(l_run, 32); fold(res, oT, g1 / l_tot);
            }
            {
                f32x16 oT[2] = {zero16(), zero16()}, dummy = zero16(); float m_run = NINF, l_run = 0.f;
                const int first = qt >= 4 ? qt - 4 : 0;
                stream<0>(oT, dummy, m_run, l_run, qf, Pb + 1792 + hkv * 64, Pb + 1920 + hkv * 64, PW, first, qt - first + 1, 0u, tq, slope, 0u, 256, F.lds, tid, lane);
                const float l_tot = l_run + __shfl_xor(l_run, 32); fold(res, oT, g2 / l_tot);
            }
            store_o(O + m * D + 512 + hb * 64, res, h);
        }
    }
}


__device__ __forceinline__ void p11_spatial_mfma(Frame& F, const Args& a) {
    using namespace att;
    constexpr int VP = 272;
    const bf16* U = (const bf16*)(F.ws + WS_U); const bf16* V = (const bf16*)(F.ws + WS_V); bf16* Z = (bf16*)(F.ws + WS_Z);
    LAS f32x2* st = (LAS f32x2*)(F.lds + LDS_STATS_OFF);
    const float* lng = a.in[I_GLNG]; const float* lnb = a.in[I_GLNB]; const float* ws_ = a.in[I_GWS]; const float* bs = a.in[I_GBS];
    const int tid = F.tid, lane = F.lane, w = F.wave, r = lane & 31, h = lane >> 5, tb = w & 3, cb0 = 2 * (w >> 2);
    for (int unit = blockIdx.x; unit < NB * 16; unit += F.G) {
        const int m0 = unit * 128;
        __syncthreads();
        for (int rr = 0; rr < 16; ++rr) { const int row = w * 16 + rr; const bf16* vr = V + (size_t)(m0 + row) * D;
            const u32x4 p0 = ((const u32x4*)vr)[lane], p1 = ((const u32x4*)vr)[64 + lane]; float x[16];
            x[0] = bflo(p0.x); x[1] = bfhi(p0.x); x[2] = bflo(p0.y); x[3] = bfhi(p0.y); x[4] = bflo(p0.z); x[5] = bfhi(p0.z); x[6] = bflo(p0.w); x[7] = bfhi(p0.w);
            x[8] = bflo(p1.x); x[9] = bfhi(p1.x); x[10] = bflo(p1.y); x[11] = bfhi(p1.y); x[12] = bflo(p1.z); x[13] = bfhi(p1.z); x[14] = bflo(p1.w); x[15] = bfhi(p1.w);
            float sm = 0.f;
#pragma unroll
            for (int i = 0; i < 16; ++i) sm += x[i];
            const float mean = wave_sum(sm) * (1.f / D); float s2 = 0.f;
#pragma unroll
            for (int i = 0; i < 16; ++i) { const float d = x[i] - mean; s2 += d * d; }
            const float rstd = 1.f / sqrtf(wave_sum(s2) * (1.f / D) + LN_EPS);
            if (lane == 0) st[row] = (f32x2){mean, rstd}; }
        __syncthreads();
#pragma unroll 1
        for (int g = 0; g < 8; ++g) {
            LAS unsigned char* buf = F.lds + (g & 1) * (128 * VP);
            { const int c8 = tid & 15; const float* gp = lng + g * 128 + 8 * c8; const float* bp = lnb + g * 128 + 8 * c8;
              const f32x4 ga = *(const f32x4*)gp, gb = *(const f32x4*)(gp + 4), ba = *(const f32x4*)bp, bb = *(const f32x4*)(bp + 4);
#pragma unroll
              for (int k = 0; k < 4; ++k) { const int sidx = (tid >> 4) + 32 * k; const f32x2 ms = st[sidx];
                  const u32x4 v = *(const u32x4*)(V + (size_t)(m0 + sidx) * D + g * 128 + 8 * c8); u32x4 o;
                  o.x = cvtpk((bflo(v.x) - ms.x) * ms.y * ga[0] + ba[0], (bfhi(v.x) - ms.x) * ms.y * ga[1] + ba[1]);
                  o.y = cvtpk((bflo(v.y) - ms.x) * ms.y * ga[2] + ba[2], (bfhi(v.y) - ms.x) * ms.y * ga[3] + ba[3]);
                  o.z = cvtpk((bflo(v.z) - ms.x) * ms.y * gb[0] + bb[0], (bfhi(v.z) - ms.x) * ms.y * gb[1] + bb[1]);
                  o.w = cvtpk((bflo(v.w) - ms.x) * ms.y * gb[2] + bb[2], (bfhi(v.w) - ms.x) * ms.y * gb[3] + bb[3]);
                  *(LAS u32x4*)(buf + sidx * VP + c8 * 16) = o; } }
            const int t = 32 * tb + r; bf16x8 wf[8];
#pragma unroll
            for (int ks = 0; ks < 8; ++ks) { const int s0 = 16 * ks + 8 * h; const float* wp = ws_ + (size_t)g * 16384 + t * 128 + s0; u32x4 o = (u32x4){0u, 0u, 0u, 0u};
                if (ks <= 2 * tb + 1) { f32x4 w0 = *(const f32x4*)wp, w1 = *(const f32x4*)(wp + 4);
#pragma unroll
                    for (int j = 0; j < 4; ++j) { if (s0 + j > t) w0[j] = 0.f; if (s0 + 4 + j > t) w1[j] = 0.f; }
                    o.x = cvtpk(w0[0], w0[1]); o.y = cvtpk(w0[2], w0[3]); o.z = cvtpk(w1[0], w1[1]); o.w = cvtpk(w1[2], w1[3]); }
                wf[ks] = __builtin_bit_cast(bf16x8, o); }
            __syncthreads();
            f32x16 acc[2] = {zero16(), zero16()};
            const LAS unsigned char* ab = buf + (8 * h + ((lane >> 2) & 3)) * VP + (16 * ((lane >> 4) & 1) + 4 * (lane & 3)) * 2;
#pragma unroll
            for (int ks = 0; ks < 8; ++ks) { if (ks <= 2 * tb + 1) {
#pragma unroll
                for (int cb = 0; cb < 2; ++cb) { const LAS unsigned char* ad = ab + (16 * ks) * VP + (32 * (cb0 + cb)) * 2;
                    const s16x4 lo = __builtin_bit_cast(s16x4, __builtin_amdgcn_ds_read_tr16_b64_v4i16((LAS s16x4*)ad));
                    const s16x4 hi = __builtin_bit_cast(s16x4, __builtin_amdgcn_ds_read_tr16_b64_v4i16((LAS s16x4*)(ad + 4 * VP)));
                    const bf16x8 vf = (bf16x8){lo[0], lo[1], lo[2], lo[3], hi[0], hi[1], hi[2], hi[3]};
                    acc[cb] = __builtin_amdgcn_mfma_f32_32x32x16_bf16(vf, wf[ks], acc[cb], 0, 0, 0); } } }
            const float bt = bs[g * 128 + t]; const size_t rowo = (size_t)(m0 + t) * D + g * 128;
#pragma unroll
            for (int cb = 0; cb < 2; ++cb)
#pragma unroll
                for (int a4 = 0; a4 < 4; ++a4) { const size_t o = rowo + 32 * (cb0 + cb) + 8 * a4 + 4 * h; const u32x2 uu = *(const u32x2*)(U + o); u32x2 zz;
                    zz.x = cvtpk(bflo(uu.x) * (acc[cb][4 * a4] + bt), bfhi(uu.x) * (acc[cb][4 * a4 + 1] + bt)); zz.y = cvtpk(bflo(uu.y) * (acc[cb][4 * a4 + 2] + bt), bfhi(uu.y) * (acc[cb][4 * a4 + 3] + bt));
                    *(u32x2*)(Z + o) = zz; }
        }
    }
}

template <int MODE>
__device__ __forceinline__ void ln_phase(Frame& F, const Args& a, const float* lg, const float* lb) {
    const int gw = F.vcu * NWAVES + F.wave, NGW = F.G * NWAVES, lane = F.lane;
    float* out = a.out; bf16* xb = (bf16*)(F.ws + WS_XB);
    f32x4 gg[4], bb[4];
#pragma unroll
    for (int j = 0; j < 4; ++j) { gg[j] = *((const f32x4*)lg + lane + 64 * j); bb[j] = *((const f32x4*)lb + lane + 64 * j); }
    LAS float* wrl = (LAS float*)F.lds;
    LAS int* rinfo = (LAS int*)(F.lds + 32768);
    LAS int* lcnt = (LAS int*)(F.lds + 32768 + 4096);
    LAS int* lbase = lcnt + 8;
    int nrow = 0;
    if (MODE == 1) {
        __syncthreads();
        for (int i = F.tid; i < 8192; i += NTHREADS) wrl[(i & 7) * 1024 + (i >> 3)] = a.in[I_RT][i];
        if (F.tid < 8) lcnt[F.tid] = 0;
        __syncthreads();
    }
    for (int m = gw; m < M; m += NGW) {
        f32x4* xr = (f32x4*)(out + (size_t)m * D) + lane; f32x4 v[4]; float s = 0.f;
#pragma unroll
        for (int j = 0; j < 4; ++j) v[j] = xr[64 * j];
        if (MODE == 2) {
            const bf16* y = (const bf16*)(F.ws + WS_Y2) + (size_t)m * 2 * D;
#pragma unroll
            for (int j = 0; j < 4; ++j) { const u32x2 y0 = *((const u32x2*)y + lane + 64 * j), y1 = *((const u32x2*)(y + D) + lane + 64 * j);
                v[j][0] = ALPHA * v[j][0] + bflo(y0.x) + bflo(y1.x); v[j][1] = ALPHA * v[j][1] + bfhi(y0.x) + bfhi(y1.x);
                v[j][2] = ALPHA * v[j][2] + bflo(y0.y) + bflo(y1.y); v[j][3] = ALPHA * v[j][3] + bfhi(y0.y) + bfhi(y1.y); }
        }
#pragma unroll
        for (int j = 0; j < 4; ++j) s += (v[j][0] + v[j][1]) + (v[j][2] + v[j][3]);
        const float mean = wave_sum(s) * (1.f / D); float s2 = 0.f;
#pragma unroll
        for (int j = 0; j < 4; ++j) { v[j] = v[j] - mean; s2 += (v[j][0] * v[j][0] + v[j][1] * v[j][1]) + (v[j][2] * v[j][2] + v[j][3] * v[j][3]); }
        const float rstd = 1.f / sqrtf(wave_sum(s2) * (1.f / D) + LN_EPS);
#pragma unroll
        for (int j = 0; j < 4; ++j) { v[j] = v[j] * rstd * gg[j] + bb[j]; xr[64 * j] = v[j]; }
        if (MODE != 2) {
            unsigned long long* o8 = (unsigned long long*)(xb + (size_t)m * D) + lane;
#pragma unroll
            for (int j = 0; j < 4; ++j) o8[64 * j] = (unsigned long long)pk2(v[j][0], v[j][1]) | ((unsigned long long)pk2(v[j][2], v[j][3]) << 32);
        }
        if (MODE == 1) {
            float lg8[8];
#pragma unroll
            for (int e = 0; e < 8; ++e) { float t8 = 0.f;
#pragma unroll
                for (int j = 0; j < 4; ++j) { const f32x4 wv = *(const LAS f32x4*)(wrl + e * 1024 + 256 * j + 4 * lane); t8 += v[j][0] * wv[0] + v[j][1] * wv[1] + v[j][2] * wv[2] + v[j][3] * wv[3]; }
                lg8[e] = wave_sum(t8); }
            int e0 = 0; float v0 = lg8[0];
#pragma unroll
            for (int e = 1; e < 8; ++e) if (lg8[e] > v0) { v0 = lg8[e]; e0 = e; }
            int e1 = -1; float v1 = -__builtin_inff();
#pragma unroll
            for (int e = 0; e < 8; ++e) if (e != e0 && lg8[e] > v1) { v1 = lg8[e]; e1 = e; }
            const float g0 = 1.0f / (1.0f + __expf(v1 - v0)), g1 = 1.0f - g0;
            if (lane == 0) {
                const int slot = F.wave * 16 + nrow;
                const int p0 = __hip_atomic_fetch_add((int*)(lcnt + e0), 1, __ATOMIC_RELAXED, __HIP_MEMORY_SCOPE_WORKGROUP), p1 = __hip_atomic_fetch_add((int*)(lcnt + e1), 1, __ATOMIC_RELAXED, __HIP_MEMORY_SCOPE_WORKGROUP);
                rinfo[slot * 8 + 0] = m; rinfo[slot * 8 + 1] = e0; rinfo[slot * 8 + 2] = e1; rinfo[slot * 8 + 3] = p0; rinfo[slot * 8 + 4] = p1; rinfo[slot * 8 + 5] = __builtin_bit_cast(int, g0); rinfo[slot * 8 + 6] = __builtin_bit_cast(int, g1);
            }
            ++nrow;
        }
    }
    if (MODE == 1) {
        __syncthreads();
        if (F.tid < 8) lbase[F.tid] = (int)atomicAdd((unsigned*)(F.ctl + CW_CNT + 64 * F.tid), (unsigned)lcnt[F.tid]);
        __syncthreads();
        int* rowtok = (int*)(F.ws + WS_ROWTOK); int* rowdst = (int*)(F.ws + WS_ROWDST); float* rowgate = (float*)(F.ws + WS_ROWGATE);
        if (F.tid < 128) { const int slot = F.tid; const int wv_ = slot >> 4, k = slot & 15;
            if ((F.vcu * NWAVES + wv_) + k * NGW < M) { const int m = rinfo[slot * 8], e0 = rinfo[slot * 8 + 1], e1 = rinfo[slot * 8 + 2];
                const int q0 = e0 * CAP + lbase[e0] + rinfo[slot * 8 + 3], q1 = e1 * CAP + lbase[e1] + rinfo[slot * 8 + 4];
                rowtok[q0] = m; rowdst[q0] = 2 * m; rowgate[q0] = __builtin_bit_cast(float, rinfo[slot * 8 + 5]);
                rowtok[q1] = m; rowdst[q1] = 2 * m + 1; rowgate[q1] = __builtin_bit_cast(float, rinfo[slot * 8 + 6]); } }
    }
}

__device__ __forceinline__ void p3_compress2(Frame& F, const Args& a) {
    const bf16* H1 = (const bf16*)(F.ws + WS_H1); float* KCC = (float*)(F.ws + WS_KCC);
    const int gt = blockIdx.x * NTHREADS + F.tid, NT = F.G * NTHREADS;
    for (int idx = gt; idx < 2 * 4096 * 64; idx += NT) {
        const int n = idx & 63, r = (idx >> 6) & 4095, kv = idx >> 18;
        const float* w2 = a.in[kv ? I_WV2 : I_WK2]; const bf16* h = H1 + (size_t)(kv * 4096 + r) * 256; float s = 0.f;
        for (int j8 = 0; j8 < 32; ++j8) { const u32x4 v = ((const u32x4*)h)[j8]; const float* w = w2 + (size_t)(8 * j8) * 64 + n;
            s += bflo(v.x) * w[0] + bfhi(v.x) * w[64] + bflo(v.y) * w[128] + bfhi(v.y) * w[192] + bflo(v.z) * w[256] + bfhi(v.z) * w[320] + bflo(v.w) * w[384] + bfhi(v.w) * w[448]; }
        KCC[idx] = s; ((bf16*)(F.ws + WS_KCCB))[idx] = (bf16)f2bf(s);
    }
}

__device__ __forceinline__ void p11_spatial(Frame& F, const Args& a) {
    const bf16* U = (const bf16*)(F.ws + WS_U); const bf16* V = (const bf16*)(F.ws + WS_V); bf16* Z = (bf16*)(F.ws + WS_Z);
    LAS float* Wl = (LAS float*)(F.lds); LAS float* vn = (LAS float*)(F.lds + 65536); LAS f32x2* st = (LAS f32x2*)(F.lds + LDS_STATS_OFF);
    const float* lng = a.in[I_GLNG]; const float* lnb = a.in[I_GLNB]; const float* ws_ = a.in[I_GWS]; const float* bs = a.in[I_GBS];
    const int tid = F.tid, lane = F.lane;
    for (int unit = blockIdx.x; unit < NB * 16; unit += F.G) {
        const int m0 = unit * 128;
        __syncthreads();
        for (int rr = 0; rr < 16; ++rr) { const int r = F.wave * 16 + rr; const bf16* vr = V + (size_t)(m0 + r) * D;
            const u32x4 p0 = ((const u32x4*)vr)[lane], p1 = ((const u32x4*)vr)[64 + lane]; float x[16];
            x[0] = bflo(p0.x); x[1] = bfhi(p0.x); x[2] = bflo(p0.y); x[3] = bfhi(p0.y); x[4] = bflo(p0.z); x[5] = bfhi(p0.z); x[6] = bflo(p0.w); x[7] = bfhi(p0.w);
            x[8] = bflo(p1.x); x[9] = bfhi(p1.x); x[10] = bflo(p1.y); x[11] = bfhi(p1.y); x[12] = bflo(p1.z); x[13] = bfhi(p1.z); x[14] = bflo(p1.w); x[15] = bfhi(p1.w);
            float s = 0.f;
#pragma unroll
            for (int i = 0; i < 16; ++i) s += x[i];
            const float mean = wave_sum(s) * (1.f / D); float s2 = 0.f;
#pragma unroll
            for (int i = 0; i < 16; ++i) { const float d = x[i] - mean; s2 += d * d; }
            const float rstd = 1.f / sqrtf(wave_sum(s2) * (1.f / D) + LN_EPS);
            if (lane == 0) st[r] = (f32x2){mean, rstd}; }
        __syncthreads();
        for (int g = 0; g < 8; ++g) {
            for (int i = tid; i < 128 * 32; i += NTHREADS) { const int t = i >> 5, s4 = (i & 31) * 4; f32x4 w = *(const f32x4*)(ws_ + (size_t)g * 16384 + t * 128 + s4);
                if (s4 + 0 > t) w[0] = 0.f; if (s4 + 1 > t) w[1] = 0.f; if (s4 + 2 > t) w[2] = 0.f; if (s4 + 3 > t) w[3] = 0.f; *(LAS f32x4*)(Wl + t * 128 + s4) = w; }
            { const int ch = tid & 127; const float gch = lng[g * 128 + ch], bch = lnb[g * 128 + ch];
              for (int s = tid >> 7; s < 128; s += 4) { const f32x2 ms = st[s]; vn[s * 128 + ch] = (bf2f(V[(size_t)(m0 + s) * D + g * 128 + ch]) - ms.x) * ms.y * gch + bch; } }
            __syncthreads();
            { const int ch = tid & 127, tq = tid >> 7; float acc[32];
#pragma unroll
              for (int i = 0; i < 32; ++i) acc[i] = 0.f;
              const int s4end = (tq * 32 + 32) / 4;
              for (int s4 = 0; s4 < s4end; ++s4) { const float v0 = vn[(4 * s4) * 128 + ch], v1 = vn[(4 * s4 + 1) * 128 + ch], v2 = vn[(4 * s4 + 2) * 128 + ch], v3 = vn[(4 * s4 + 3) * 128 + ch];
#pragma unroll
                  for (int i = 0; i < 32; ++i) { const f32x4 w = *(const LAS f32x4*)(Wl + (tq * 32 + i) * 128 + 4 * s4); acc[i] += w[0] * v0 + w[1] * v1 + w[2] * v2 + w[3] * v3; } }
#pragma unroll
              for (int i = 0; i < 32; ++i) { const int t = tq * 32 + i; const size_t o = (size_t)(m0 + t) * D + g * 128 + ch;
                  Z[o] = (bf16)f2bf(bf2f(U[o]) * (acc[i] + bs[g * 128 + t])); } }
            __syncthreads();
        }
    }
}

constexpr int N_PHASES = 25;
__global__ void __launch_bounds__(NTHREADS, 2) fwd(Args args) {
    extern __shared__ __attribute__((aligned(16))) unsigned char lds[];
    Frame F;
    F.lds = (LAS unsigned char*)lds; F.ws = args.ws; F.ctl = (gu32*)(args.ws + WS_CTL);
    F.tid = threadIdx.x; F.lane = F.tid & 63; F.wave = __builtin_amdgcn_readfirstlane(F.tid >> 6);
    F.G = gridDim.x; { const int bx = blockIdx.x; F.vcu = (F.G % 8 == 0) ? (bx % 8) * (F.G / 8) + bx / 8 : bx; }
    for (int u = F.tid; u < (LDS_BYTES - LDSCTL_OFF) / 4; u += NTHREADS) ((LAS unsigned*)(F.lds + LDSCTL_OFF))[u] = 0u;
    __syncthreads();
    unsigned char* ws = args.ws;
#if MK_ONE_LAUNCH
    XcdBarrier bar = xcd_barrier_post((unsigned*)(F.ctl + CW_BAR), (volatile LAS unsigned*)(F.lds + LDSCTL_OFF));
#define GRID_BAR() xcd_barrier(bar)
#else
#define GRID_BAR() do { } while (0)
#endif
    const int lo = args.ph_lo, hi = args.ph_hi;
#define IN(k) (lo <= (k) && (k) < hi)
#define SEAM(k) do { if (IN(k) && IN((k) + 1)) GRID_BAR(); } while (0)
    const int G = F.G, c = (int)blockIdx.x;
    const float* lng = args.in[I_LNG]; const float* lnb = args.in[I_LNB];

    if (IN(0)) { for (int rep = 0; rep < REP_PRO; ++rep) p0_prologue(F, args); } SEAM(0);
    if (IN(1)) { pg8::Gemm g{(const char*)(ws + WS_XB), (const char*)(ws + WS_WIN), D, 0}; pg8::StaticOrder S{M / 256, 8, G, c};
        pg8::EpiBf<0> E{(bf16*)(ws + WS_P), (bf16*)(ws + WS_KC), PW, nullptr, nullptr, nullptr}; pg8::ADense al{(unsigned)D * 2u};
        pg8::gemm_phase(F.lds, g, S, E, al); } SEAM(1);
    if (IN(2)) { pg8::Gemm g{(const char*)(ws + WS_KC), (const char*)(ws + WS_WC1), 2048, (size_t)256 * 2048 * 2}; pg8::CmpOrder S{c};
        pg8::EpiBf<1> E{(bf16*)(ws + WS_H1), nullptr, 256, (const float*)(ws + WS_SMALL), nullptr, nullptr}; pg8::ADense al{1024u * 2u};
        pg8::gemm_phase(F.lds, g, S, E, al); } SEAM(2);
    if (IN(3)) { p3_compress2(F, args); } SEAM(3);
    if (IN(4)) { for (int rep = 0; rep < REP_ATT; ++rep) p4_attention_mfma(F, args); } SEAM(4);
    if (IN(5)) { pg8::Gemm g{(const char*)(ws + WS_O), (const char*)(ws + WS_WO), D, 0}; pg8::StaticOrder S{M / 256, 4, G, c};
        pg8::EpiRes E{args.in[I_X], args.out, ALPHA}; pg8::ADense al{(unsigned)D * 2u};
        pg8::gemm_phase(F.lds, g, S, E, al); } SEAM(5);
    if (IN(6)) { ln_phase<0>(F, args, lng + 0 * D, lnb + 0 * D); } SEAM(6);
    if (IN(7)) { pg8::Gemm g{(const char*)(ws + WS_XB), (const char*)(ws + WS_FGU), D, 0}; pg8::StaticOrder S{M / 256, DFF / 128, G, c};
        pg8::EpiBf<3> E{(bf16*)(ws + WS_H), nullptr, DFF, nullptr, nullptr, nullptr}; pg8::ADense al{(unsigned)D * 2u};
        pg8::gemm_phase(F.lds, g, S, E, al); } SEAM(7);
    if (IN(8)) { pg8::Gemm g{(const char*)(ws + WS_H), (const char*)(ws + WS_FDN), DFF, 0}; pg8::StaticOrder S{M / 256, 4, G, c};
        pg8::EpiRes E{args.out, args.out, ALPHA}; pg8::ADense al{(unsigned)DFF * 2u};
        pg8::gemm_phase(F.lds, g, S, E, al); } SEAM(8);
    if (IN(9)) { ln_phase<0>(F, args, lng + 1 * D, lnb + 1 * D); } SEAM(9);
    if (IN(10)) { pg8::Gemm g{(const char*)(ws + WS_XB), (const char*)(ws + WS_GIN), D, 0}; pg8::StaticOrder S{M / 256, 8, G, c};
        pg8::EpiBf<2> E{(bf16*)(ws + WS_U), (bf16*)(ws + WS_V), D, nullptr, nullptr, nullptr}; pg8::ADense al{(unsigned)D * 2u};
        pg8::gemm_phase(F.lds, g, S, E, al); } SEAM(10);
    if (IN(11)) { for (int rep = 0; rep < REP_SPA; ++rep) p11_spatial_mfma(F, args); } SEAM(11);
    if (IN(12)) { pg8::Gemm g{(const char*)(ws + WS_Z), (const char*)(ws + WS_GOUT), D, 0}; pg8::StaticOrder S{M / 256, 4, G, c};
        pg8::EpiRes E{args.out, args.out, ALPHA}; pg8::ADense al{(unsigned)D * 2u};
        pg8::gemm_phase(F.lds, g, S, E, al); } SEAM(12);
    if (IN(13)) { ln_phase<1>(F, args, lng + 2 * D, lnb + 2 * D); } SEAM(13);
    {
        LAS int* tab = (LAS int*)(F.lds + LDS_MOE_OFF);
        if (hi > 14 && lo < 24) {
            __syncthreads();
            if (F.tid == 0) { int ts = 0;
                for (int e = 0; e < 8; ++e) { int n = (int)__hip_atomic_load(F.ctl + CW_CNT + 64 * e, __ATOMIC_RELAXED, __HIP_MEMORY_SCOPE_AGENT); if (n > CAP) n = CAP; tab[e] = n; tab[8 + e] = ts; ts += (n + 255) >> 8; }
                tab[16] = ts; }
            __syncthreads();
        }
        const int T = tab[16];
#pragma unroll 1
        for (int ch = 0; ch < 5; ++ch) {
            const int tile0 = 64 * ch; int nM = T - tile0; nM = nM < 0 ? 0 : (nM > 64 ? 64 : nM);
            nM = __builtin_amdgcn_readfirstlane(nM);
            if (IN(14 + 2 * ch)) { pg8::Gemm g{(const char*)(ws + WS_XB), (const char*)(ws + WS_MGU), D, (size_t)2 * DFE * D * 2}; pg8::MoeOrder S{nM, DFE / 128, G, c, tile0, tab};
                pg8::EpiBf<3> E{(bf16*)(ws + WS_HM), nullptr, DFE, nullptr, nullptr, nullptr}; pg8::AGather al{(const int*)(ws + WS_ROWTOK), (unsigned)D * 2u};
                pg8::gemm_phase(F.lds, g, S, E, al); }
            SEAM(14 + 2 * ch);
            if (IN(15 + 2 * ch)) { pg8::Gemm g{(const char*)(ws + WS_HM), (const char*)(ws + WS_MDN), DFE, (size_t)D * DFE * 2}; pg8::MoeOrder S{nM, 4, G, c, tile0, tab};
                pg8::EpiBf<4> E{(bf16*)(ws + WS_Y2), nullptr, D, nullptr, (const int*)(ws + WS_ROWDST), (const float*)(ws + WS_ROWGATE)}; pg8::ADense al{(unsigned)DFE * 2u};
                pg8::gemm_phase(F.lds, g, S, E, al); }
            SEAM(15 + 2 * ch);
        }
    }
    if (IN(24)) { ln_phase<2>(F, args, lng + 3 * D, lnb + 3 * D); }
#undef IN
#undef SEAM
}

extern "C" void kernel_launch(void* const* d_in, const int* in_sizes, int n_in, void* d_out, int out_size, void* d_ws, size_t ws_size, hipStream_t stream) {
    static int grid = 0;
    if (grid == 0) {
        if (n_in != 25 || in_sizes[0] != M * D || out_size != M * D || ws_size < WS_END) { fprintf(stderr, "kernel_launch: unexpected shapes (n_in %d, in0 %d, out %d, ws %zu); nothing launched\n", n_in, n_in > 0 ? in_sizes[0] : -1, out_size, ws_size); grid = -1; return; }
        int dev = 0, cus = 0, per_cu = 0;
        if (hipGetDevice(&dev) != hipSuccess || hipDeviceGetAttribute(&cus, hipDeviceAttributeMultiprocessorCount, dev) != hipSuccess) { grid = -1; return; }
        if (hipFuncSetAttribute((const void*)fwd, hipFuncAttributeMaxDynamicSharedMemorySize, LDS_BYTES) != hipSuccess) { fprintf(stderr, "kernel_launch: hipFuncSetAttribute failed\n"); grid = -1; return; }
        if (hipOccupancyMaxActiveBlocksPerMultiprocessor(&per_cu, (const void*)fwd, NTHREADS, LDS_BYTES) != hipSuccess || per_cu < 1) fprintf(stderr, "kernel_launch: occupancy query reports %d\n", per_cu);
        (void)hipGetLastError();
        grid = cus;
    }
    if (grid < 0) return;
    if (hipMemsetAsync((char*)d_ws + WS_CTL, 0, CTL_ZERO_BYTES, stream) != hipSuccess) return;
    Args a{};
    for (int i = 0; i < 25; ++i) a.in[i] = (const float*)d_in[i];
    a.out = (float*)d_out; a.ws = (unsigned char*)d_ws;
#if MK_ONE_LAUNCH
    a.ph_lo = 0; a.ph_hi = N_PHASES;
    hipLaunchKernelGGL(fwd, dim3(grid), dim3(NTHREADS), LDS_BYTES, stream, a);
#else
    for (int p = 0; p < N_PHASES; ++p) { a.ph_lo = p; a.ph_hi = p + 1; hipLaunchKernelGGL(fwd, dim3(grid), dim3(NTHREADS), LDS_BYTES, stream, a); }
#endif
}
```

```cpp
#include <hip/hip_runtime.h>
#include <cstdio>
#include <cstdint>

#ifndef REP_ATT
#define REP_ATT 1
#endif
#ifndef REP_SPA
#define REP_SPA 1
#endif
#ifndef REP_PRO
#define REP_PRO 1
#endif
#ifndef MK_ONE_LAUNCH
#define MK_ONE_LAUNCH 1
#endif

#define LAS __attribute__((address_space(3)))
#define GAS __attribute__((address_space(1)))
typedef unsigned short bf16;
typedef short bf16x8 __attribute__((ext_vector_type(8)));
typedef float f32x4 __attribute__((ext_vector_type(4)));
typedef float f32x2 __attribute__((ext_vector_type(2)));
typedef unsigned u32x4 __attribute__((ext_vector_type(4)));
typedef unsigned u32x2 __attribute__((ext_vector_type(2)));
typedef GAS unsigned gu32;

constexpr int NB = 16, SEQ = 2048, D = 1024, M = NB * SEQ;
constexpr int PW = 2048;
constexpr int INW = 2072;
constexpr int DFF = 2816, DFE = 3584, NEXP = 8, CAP = 32768;
constexpr int NCMP = 127;
constexpr float ALPHA = 1.4142135623730951f;
constexpr float LN_EPS = 1e-5f;
constexpr int NWAVES = 8, NTHREADS = 512;

constexpr size_t MiB = 1u << 20;
constexpr size_t WS_CTL = 0, CTL_ZERO_BYTES = 1 * MiB;
constexpr size_t WS_SMALL = 1 * MiB;
constexpr size_t WS_ROWTOK = 2 * MiB, WS_ROWDST = 3 * MiB, WS_ROWGATE = 4 * MiB;
constexpr size_t WS_WIN = 5 * MiB;
constexpr size_t WS_WC1 = 9 * MiB;
constexpr size_t WS_WO = 11 * MiB;
constexpr size_t WS_FGU = 13 * MiB;
constexpr size_t WS_FDN = 24 * MiB;
constexpr size_t WS_GIN = 30 * MiB;
constexpr size_t WS_GOUT = 34 * MiB;
constexpr size_t WS_MGU = 36 * MiB;
constexpr size_t WS_MDN = 148 * MiB;
constexpr size_t WS_XB = 204 * MiB;
constexpr size_t WS_BIG = 268 * MiB;
constexpr size_t WS_P = WS_BIG;
constexpr size_t WS_O = WS_BIG + 128 * MiB;
constexpr size_t WS_H = WS_BIG;
constexpr size_t WS_U = WS_BIG, WS_V = WS_BIG + 64 * MiB, WS_Z = WS_BIG + 128 * MiB;
constexpr size_t WS_HM = WS_BIG;
constexpr size_t WS_Y2 = WS_BIG + 112 * MiB;
constexpr size_t WS_GATES = 460 * MiB;
constexpr size_t WS_KC = 463 * MiB;
constexpr size_t WS_H1 = 480 * MiB;
constexpr size_t WS_KCC = 484 * MiB;
constexpr size_t WS_KCCB = 486 * MiB;
constexpr size_t WS_END = 508 * MiB;
static_assert(WS_Y2 + 128 * MiB <= WS_END && WS_H + (size_t)M * DFF * 2 <= WS_GATES && WS_KC + 17 * MiB <= WS_H1, "ws map");
constexpr int CW_BAR = 4096;
constexpr int CW_CNT = 16384;

constexpr int RING_BYTES = 131072;
constexpr int LDSCTL_OFF = RING_BYTES;
constexpr int LDS_STATS_OFF = RING_BYTES + 1024;
constexpr int LDS_MOE_OFF = RING_BYTES + 4096;
constexpr int LDS_IDX_OFF = RING_BYTES + 8192;
constexpr int LDS_BYTES = 147456;

#define LDS_WAIT() asm volatile("s_waitcnt lgkmcnt(0)" ::: "memory")
#define VM_WAIT() asm volatile("s_waitcnt vmcnt(0)" ::: "memory")
__device__ __forceinline__ unsigned f2bf(float f) { unsigned u = __builtin_bit_cast(unsigned, f); return (u + 0x7fffu + ((u >> 16) & 1u)) >> 16; }
__device__ __forceinline__ unsigned pk2(float lo, float hi) { return f2bf(lo) | (f2bf(hi) << 16); }
__device__ __forceinline__ float bflo(unsigned u) { return __builtin_bit_cast(float, u << 16); }
__device__ __forceinline__ float bfhi(unsigned u) { return __builtin_bit_cast(float, u & 0xffff0000u); }
__device__ __forceinline__ float bf2f(bf16 b) { return __builtin_bit_cast(float, (unsigned)b << 16); }
__device__ __forceinline__ float wave_sum(float v) {
#pragma unroll
    for (int o = 1; o < 64; o <<= 1) v += __shfl_xor(v, o);
    return v;
}
__device__ __forceinline__ float wave_max(float v) {
#pragma unroll
    for (int o = 1; o < 64; o <<= 1) v = fmaxf(v, __shfl_xor(v, o));
    return v;
}
__device__ __forceinline__ float gelu_tanh(float x) {
    const float u = x * (-2.302208198f) * (1.0f + 0.044715f * x * x);
    return x * __builtin_amdgcn_rcpf(1.0f + __builtin_amdgcn_exp2f(u));
}
__device__ __forceinline__ float silu(float x) { return x * __builtin_amdgcn_rcpf(1.0f + __builtin_amdgcn_exp2f(-1.4426950408889634f * x)); }
__device__ __forceinline__ float sigmoidf(float x) { return __builtin_amdgcn_rcpf(1.0f + __builtin_amdgcn_exp2f(-1.4426950408889634f * x)); }

namespace pg8 {
constexpr int BM = 256, BK = 64, HALF = 128, HTB = HALF * BK * 2, STAGE_BYTES = 8 * HTB, NXCD = 8, WGM = 8;
__host__ __device__ __forceinline__ int lds_byte(int r, int c) { const int st = (r >> 4) * 2 + (c >> 5), rr = r & 15, cc = c & 31, ob = rr * 64 + cc * 2; return st * 1024 + (ob ^ (((ob >> 9) & 1) << 5)); }
__host__ __device__ __forceinline__ void stage_rc(int b, int& R, int& C) { const int st = b / 1024, sb = b % 1024, swz = sb ^ (((sb >> 9) & 1) << 5); R = (st >> 1) * 16 + swz / 64; C = (st & 1) * 32 + (swz % 64) / 2; }
__host__ __device__ __forceinline__ int perm32(int rho) { const int n = rho >> 4, i = rho & 15; return 8 * (i >> 2) + 4 * n + (i & 3); }

struct Unit { int pm, pn, e, te, ne; };
struct Gemm { const char* A; const char* Bt; int K; size_t eStrideB; };

struct ADense { unsigned pitchB;
    __device__ __forceinline__ unsigned first(const Unit& u, int R) const { return (unsigned)(u.pm * 256 + R) * pitchB; }
    __device__ __forceinline__ void prefetch(const Unit&, int, int, int) const {}
    __device__ __forceinline__ unsigned next(const Unit& u, int, int R) const { return (unsigned)(u.pm * 256 + R) * pitchB; } };
struct AGather { const int* rowtok; unsigned pitchB; LAS int* idx;
    __device__ __forceinline__ unsigned first(const Unit& u, int R) const { const int ri = u.te * 256 + R; const int tok = rowtok[u.e * CAP + ri]; return (unsigned)(ri < u.ne ? tok : 0) * pitchB; }
    __device__ __forceinline__ void prefetch(const Unit& u, int slot, int wid, int lane) const {
        if (wid < 4) __builtin_amdgcn_global_load_lds((const unsigned*)(rowtok + u.e * CAP + u.te * 256 + wid * 64 + lane), (LAS unsigned*)(idx + slot * 256 + wid * 64), 4, 0, 0); }
    __device__ __forceinline__ unsigned next(const Unit& u, int slot, int R) const { const int ri = u.te * 256 + R; const int tok = idx[slot * 256 + R]; return (unsigned)(ri < u.ne ? tok : 0) * pitchB; } };

__device__ __forceinline__ bool static_unit(int i, int G, int c, int nM, int nN, int& pm, int& pn) {
    const int nwg = nM * nN; const long L = (long)i * G + c; if (L >= nwg) return false;
    int wgid = (int)L; { const int q = nwg / NXCD, r = nwg % NXCD, xcd = wgid % NXCD, off = wgid / NXCD; wgid = (xcd < r ? xcd * (q + 1) : r * (q + 1) + (xcd - r) * q) + off; }
    const int nig = WGM * nN, gid = wgid / nig, fm = gid * WGM, gsz = (nM - fm) < WGM ? (nM - fm) : WGM;
    pm = fm + ((wgid % nig) % gsz); pn = (wgid % nig) / gsz; return true;
}
struct StaticOrder { int nM, nN, G, c;
    __device__ __forceinline__ bool next(int i, Unit& u) const { u.e = 0; u.te = 0; u.ne = 0; return static_unit(i, G, c, nM, nN, u.pm, u.pn); } };
struct CmpOrder { int c;
    __device__ __forceinline__ bool next(int i, Unit& u) const { if (i > 0 || c >= 32) return false; u.pm = c; u.pn = 0; u.e = c >> 4; u.te = 0; u.ne = 0; return true; } };
struct MoeOrder { int nM, nN, G, c, tile0; const LAS int* tab;
    __device__ __forceinline__ bool next(int i, Unit& u) const {
        int pm, pn; if (!static_unit(i, G, c, nM, nN, pm, pn)) return false;
        const int ct = tile0 + pm; int e = 0;
#pragma unroll
        for (int k = 1; k < 8; ++k) e += (ct >= tab[8 + k]) ? 1 : 0;
        e = __builtin_amdgcn_readfirstlane(e);
        u.pm = pm; u.pn = pn; u.e = e; u.te = __builtin_amdgcn_readfirstlane(ct - tab[8 + e]); u.ne = __builtin_amdgcn_readfirstlane(tab[e]); return true; } };

__device__ __forceinline__ u32x4 pack8(const f32x4& a, const f32x4& b) { u32x4 w; w.x = pk2(a[0], a[1]); w.y = pk2(a[2], a[3]); w.z = pk2(b[0], b[1]); w.w = pk2(b[2], b[3]); return w; }

struct EpiRes {
    static constexpr bool PERM = false;
    const float* res; float* out; float alpha;
    __device__ __forceinline__ void operator()(const f32x4 (&acc)[2][2][4][2], const Unit& u, int wr, int wc, int fr, int fq) const {
        const int row0 = u.pm * BM + wr * 64 + fr, col0 = u.pn * BM + wc * 32 + 4 * fq;
#pragma unroll
        for (int ai = 0; ai < 2; ++ai)
#pragma unroll
            for (int m = 0; m < 4; ++m) { const size_t off = (size_t)(row0 + ai * HALF + m * 16) * D + col0;
#pragma unroll
                for (int bj = 0; bj < 2; ++bj)
#pragma unroll
                    for (int n = 0; n < 2; ++n) { const size_t o = off + bj * HALF + n * 16; const f32x4 r = *(const f32x4*)(res + o); *(f32x4*)(out + o) = acc[ai][bj][m][n] + alpha * r; } }
    }
};
template <int MODE> struct EpiBf {
    static constexpr bool PERM = true;
    bf16* O; bf16* O2; int ldc; const float* bias; const int* rowdst; const float* rowgate;
    __device__ __forceinline__ void operator()(const f32x4 (&acc)[2][2][4][2], const Unit& u, int wr, int wc, int fr, int fq) const {
        const int lr0 = wr * 64 + fr, ct = wc * 32 + 8 * fq;
#pragma unroll
        for (int ai = 0; ai < 2; ++ai)
#pragma unroll
            for (int m = 0; m < 4; ++m) {
                const int lr = lr0 + ai * HALF + m * 16; const int row = u.pm * BM + lr;
                if (MODE == 0) {
#pragma unroll
                    for (int bj = 0; bj < 2; ++bj) { const u32x4 w = pack8(acc[ai][bj][m][0], acc[ai][bj][m][1]);
                        *(u32x4*)(O + (size_t)row * PW + u.pn * BM + bj * HALF + ct) = w;
                        if (u.pn == 5) { const int b = row >> 11, t = row & 2047, hh = wc >> 1, d = (wc & 1) * 32 + 8 * fq;
                            *(u32x4*)(O2 + ((size_t)((bj * 32 + b * 2 + hh) * 2048 + t)) * 64 + d) = w; } }
                } else if (MODE == 1) {
#pragma unroll
                    for (int bj = 0; bj < 2; ++bj) { const int col = bj * HALF + ct; const float* bp = bias + u.e * 256 + col;
                        const f32x4 b0 = *(const f32x4*)bp, b1 = *(const f32x4*)(bp + 4); f32x4 v0 = acc[ai][bj][m][0] + b0, v1 = acc[ai][bj][m][1] + b1;
#pragma unroll
                        for (int j = 0; j < 4; ++j) { v0[j] = gelu_tanh(v0[j]); v1[j] = gelu_tanh(v1[j]); }
                        *(u32x4*)(O + (size_t)row * 256 + col) = pack8(v0, v1); }
                } else if (MODE == 2) {
                    bf16* dst = (u.pn < 4) ? O : O2;
#pragma unroll
                    for (int bj = 0; bj < 2; ++bj) { f32x4 v0 = acc[ai][bj][m][0], v1 = acc[ai][bj][m][1];
#pragma unroll
                        for (int j = 0; j < 4; ++j) { v0[j] = gelu_tanh(v0[j]); v1[j] = gelu_tanh(v1[j]); }
                        *(u32x4*)(dst + (size_t)row * D + (u.pn & 3) * BM + bj * HALF + ct) = pack8(v0, v1); }
                } else if (MODE == 3) {
                    f32x4 v0, v1;
#pragma unroll
                    for (int j = 0; j < 4; ++j) { v0[j] = silu(acc[ai][0][m][0][j]) * acc[ai][1][m][0][j]; v1[j] = silu(acc[ai][0][m][1][j]) * acc[ai][1][m][1][j]; }
                    *(u32x4*)(O + (size_t)row * ldc + u.pn * HALF + ct) = pack8(v0, v1);
                } else {
                    const int gi = u.te * 256 + lr;
                    if (gi < u.ne) { const int dst = rowdst[u.e * CAP + gi]; const float gt = rowgate[u.e * CAP + gi];
#pragma unroll
                        for (int bj = 0; bj < 2; ++bj) { const f32x4 v0 = acc[ai][bj][m][0] * gt, v1 = acc[ai][bj][m][1] * gt;
                            *(u32x4*)(O + (size_t)dst * D + u.pn * BM + bj * HALF + ct) = pack8(v0, v1); } }
                }
            }
    }
};

template <class Epi, class Sched, class AL>
__device__ __forceinline__ void gemm_phase(LAS unsigned char* lds, const Gemm g, const Sched& S, const Epi& E, const AL& al) {
    const int tid = threadIdx.x, wid = __builtin_amdgcn_readfirstlane(tid >> 6), lane = tid & 63, wr = wid >> 2, wc = wid & 3, fr = lane & 15, fq = lane >> 4;
    const int K = g.K, nt = K / BK;
    int Rs[2]; unsigned Cb[2], voffB[2];
#pragma unroll
    for (int i = 0; i < 2; ++i) { int R, C; stage_rc(tid * 16 + i * 8192, R, C); const int Rb = Epi::PERM ? ((R & ~31) + perm32(R & 31)) : R;
        Rs[i] = R; Cb[i] = (unsigned)C * 2u; voffB[i] = (unsigned)(Rb * K + C) * 2u; }
    const size_t kstep = (size_t)(BK * 2);
    const size_t hstepB = (size_t)HALF * K * 2;
    const size_t tstepB = 2 * hstepB;
    const unsigned ldsw = (unsigned)wid * 1024u;
    const int aoff = lds_byte(wr * 64 + fr, fq * 8), boff = lds_byte(wc * 32 + fr, fq * 8);
#define PG8_SA(b, h) (((b) * 2 + (h)) * HTB)
#define PG8_SB(b, h) ((4 + (b) * 2 + (h)) * HTB)
#define PG8_STAGE(bufoff, gbase, voff) do { _Pragma("unroll") for (int _i = 0; _i < 2; ++_i) \
        __builtin_amdgcn_global_load_lds((const unsigned*)((const char*)(gbase) + (voff)[_i]), (LAS unsigned*)(lds + (bufoff) + ldsw + _i * 8192), 16, 0, 0); } while (0)
#define PG8_LDA(dst, b, h) do { _Pragma("unroll") for (int m = 0; m < 4; ++m) _Pragma("unroll") for (int k = 0; k < 2; ++k) dst[m][k] = *(const LAS bf16x8*)(lds + PG8_SA(b, h) + aoff + m * 2048 + k * 1024); } while (0)
#define PG8_LDB(dst, b, h) do { _Pragma("unroll") for (int n = 0; n < 2; ++n) _Pragma("unroll") for (int k = 0; k < 2; ++k) dst[n][k] = *(const LAS bf16x8*)(lds + PG8_SB(b, h) + boff + n * 2048 + k * 1024); } while (0)
#define PG8_MMA(ai, bj, At, Bt) do { __builtin_amdgcn_s_setprio(1); _Pragma("unroll") for (int m = 0; m < 4; ++m) _Pragma("unroll") for (int n = 0; n < 2; ++n) _Pragma("unroll") for (int k = 0; k < 2; ++k) \
        acc[ai][bj][m][n] = __builtin_amdgcn_mfma_f32_16x16x32_bf16(Bt[n][k], At[m][k], acc[ai][bj][m][n], 0, 0, 0); __builtin_amdgcn_s_setprio(0); } while (0)
#define PG8_WAIT_V(n) asm volatile("s_waitcnt vmcnt(" #n ")" ::: "memory")
#define PG8_WAIT_L(n) asm volatile("s_waitcnt lgkmcnt(" #n ")" ::: "memory")
#define PG8_BAR __builtin_amdgcn_s_barrier()
#define PG8_SCHED __builtin_amdgcn_sched_barrier(0)
#define PG8_VOFF(dst, u) do { _Pragma("unroll") for (int _h = 0; _h < 2; ++_h) _Pragma("unroll") for (int _i = 0; _i < 2; ++_i) dst[_h][_i] = al.first(u, _h * HALF + Rs[_i]) + Cb[_i]; } while (0)
#define PG8_VOFFN(dst, u, slot) do { _Pragma("unroll") for (int _h = 0; _h < 2; ++_h) _Pragma("unroll") for (int _i = 0; _i < 2; ++_i) dst[_h][_i] = al.next(u, slot, _h * HALF + Rs[_i]) + Cb[_i]; } while (0)
    Unit cur, nxt; int ui = 0;
    if (!S.next(0, cur)) return;
    f32x4 acc[2][2][4][2];
#pragma unroll
    for (int a = 0; a < 2; ++a)
#pragma unroll
        for (int b = 0; b < 2; ++b)
#pragma unroll
            for (int m = 0; m < 4; ++m)
#pragma unroll
                for (int n = 0; n < 2; ++n) acc[a][b][m][n] = (f32x4){0.f, 0.f, 0.f, 0.f};
    bf16x8 At[4][2], B0[2][2], B1[2][2];
    unsigned vC[2][2], vP[2][2], vN[2][2];
    PG8_VOFF(vC, cur);
#pragma unroll
    for (int h = 0; h < 2; ++h)
#pragma unroll
        for (int i = 0; i < 2; ++i) vP[h][i] = vC[h][i];
    const char* const A0 = g.A;
    const char* cB = g.Bt + (size_t)cur.e * g.eStrideB + (size_t)cur.pn * tstepB;
    PG8_STAGE(PG8_SB(0, 0), cB, voffB); PG8_STAGE(PG8_SB(0, 1), cB + hstepB, voffB); PG8_STAGE(PG8_SA(0, 0), A0, vC[0]); PG8_STAGE(PG8_SA(0, 1), A0, vC[1]);
    if (wr == 1) PG8_BAR;
    PG8_WAIT_V(2); PG8_BAR;
    PG8_STAGE(PG8_SB(1, 0), cB + kstep, voffB); PG8_STAGE(PG8_SA(1, 0), A0 + kstep, vC[0]); PG8_STAGE(PG8_SB(1, 1), cB + hstepB + kstep, voffB);
    PG8_WAIT_V(6); PG8_BAR;
    for (;;) {
        const bool has_next = S.next(ui + 1, nxt);
        const char* nB = cB;
        if (has_next) { al.prefetch(nxt, (ui + 1) & 1, wid, lane); nB = g.Bt + (size_t)nxt.e * g.eStrideB + (size_t)nxt.pn * tstepB; }
        for (int t = 0; t < nt; t += 2) {
            const bool last = (t == nt - 2);
            if (last && has_next) { PG8_VOFFN(vN, nxt, (ui + 1) & 1);
#pragma unroll
                for (int h = 0; h < 2; ++h)
#pragma unroll
                    for (int i = 0; i < 2; ++i) vP[h][i] = vN[h][i]; }
            const char* a1 = A0 + (size_t)(t + 1) * kstep;
            const char* a2 = last ? A0 : A0 + (size_t)(t + 2) * kstep; const char* b2 = last ? nB : cB + (size_t)(t + 2) * kstep;
            const char* a3 = a2 + kstep; const char* b3 = b2 + kstep;
            PG8_LDB(B0, 0, 0); PG8_LDB(B1, 0, 1); PG8_SCHED; PG8_LDA(At, 0, 0); PG8_STAGE(PG8_SA(1, 1), a1, vC[1]);
            PG8_WAIT_V(8); PG8_WAIT_L(0); PG8_BAR; PG8_MMA(0, 0, At, B0); PG8_MMA(0, 1, At, B1); PG8_BAR; PG8_SCHED;
            PG8_LDA(At, 0, 1); PG8_STAGE(PG8_SB(0, 0), b2, voffB); PG8_STAGE(PG8_SB(0, 1), b2 + hstepB, voffB); PG8_STAGE(PG8_SA(0, 0), a2, vP[0]);
            PG8_WAIT_V(8); PG8_WAIT_L(0); PG8_BAR; PG8_MMA(1, 0, At, B0); PG8_MMA(1, 1, At, B1); PG8_BAR; PG8_SCHED;
            PG8_LDB(B0, 1, 0); PG8_LDB(B1, 1, 1); PG8_SCHED; PG8_LDA(At, 1, 0); PG8_STAGE(PG8_SA(0, 1), a2, vP[1]);
            PG8_WAIT_V(8); PG8_WAIT_L(0); PG8_BAR; PG8_MMA(0, 0, At, B0); PG8_MMA(0, 1, At, B1); PG8_BAR; PG8_SCHED;
            PG8_LDA(At, 1, 1); PG8_STAGE(PG8_SB(1, 0), b3, voffB); PG8_STAGE(PG8_SB(1, 1), b3 + hstepB, voffB); PG8_STAGE(PG8_SA(1, 0), a3, vP[0]);
            PG8_WAIT_V(8); PG8_WAIT_L(0); PG8_BAR; PG8_MMA(1, 0, At, B0); PG8_MMA(1, 1, At, B1); PG8_BAR; PG8_SCHED;
        }
        if (wr == 0) PG8_BAR;
        E(acc, cur, wr, wc, fr, fq);
        if (!has_next) break;
#pragma unroll
        for (int a = 0; a < 2; ++a)
#pragma unroll
            for (int b = 0; b < 2; ++b)
#pragma unroll
                for (int m = 0; m < 4; ++m)
#pragma unroll
                    for (int n = 0; n < 2; ++n) acc[a][b][m][n] = (f32x4){0.f, 0.f, 0.f, 0.f};
        cur = nxt; cB = nB; ++ui;
#pragma unroll
        for (int h = 0; h < 2; ++h)
#pragma unroll
            for (int i = 0; i < 2; ++i) vC[h][i] = vP[h][i];
        if (wr == 1) PG8_BAR;
    }
    PG8_WAIT_V(0);
    PG8_BAR;
#undef PG8_SA
#undef PG8_SB
#undef PG8_STAGE
#undef PG8_LDA
#undef PG8_LDB
#undef PG8_MMA
#undef PG8_WAIT_V
#undef PG8_WAIT_L
#undef PG8_BAR
#undef PG8_SCHED
#undef PG8_VOFF
#undef PG8_VOFFN
}
}

#define XB_TMO      128
#define XB_XCNT(j)  (256  + 64 * (j))
#define XB_XSUB(j)  (1280 + 64 * (j))
#define XB_XGEN(j)  (2304 + 64 * (j))
#define XB_TOP      3328
#define XB_TOPGEN   3392
#define XCD_BAR_WORDS 3456
#define XB_SPIN_CAP (1u << 18)
__device__ __forceinline__ unsigned xb_ld(unsigned* p)              { return __hip_atomic_load(p, __ATOMIC_RELAXED, __HIP_MEMORY_SCOPE_AGENT); }
__device__ __forceinline__ unsigned xb_add(unsigned* p, unsigned v) { return __hip_atomic_fetch_add(p, v, __ATOMIC_RELAXED, __HIP_MEMORY_SCOPE_AGENT); }
__device__ __forceinline__ unsigned xb_xcc_id() { return (unsigned)__builtin_amdgcn_s_getreg((3 << 11) | 20) & 0xFu; }
#define XB_SPIN(cond, bar) do { unsigned _sp = 0; while (cond) { __builtin_amdgcn_s_sleep(1); \
    if ((++_sp & 255u) == 0u) { if (xb_ld(&(bar)[XB_TMO])) break; if (_sp > XB_SPIN_CAP) { atomicAdd(&(bar)[XB_TMO], 1u); break; } } } } while (0)
struct XcdBarrier { unsigned* bar; unsigned x; volatile LAS unsigned* st; };
__device__ __forceinline__ XcdBarrier xcd_barrier_post(unsigned* bar, volatile LAS unsigned* st) {
    XcdBarrier b; b.bar = bar; b.x = xb_xcc_id(); b.st = st;
    if (threadIdx.x == 0) (void)xb_add(&bar[XB_XCNT(b.x)], 1u);
    return b;
}
__device__ __forceinline__ void xcd_barrier_complete(unsigned* bar, unsigned x, unsigned& nloc, unsigned& nx) {
    const unsigned G = gridDim.x * gridDim.y * gridDim.z;
    unsigned sum, cnt, mine, sp = 0u;
    for (;;) {
        sum = 0u; cnt = 0u; mine = 0u;
#pragma unroll
        for (unsigned j = 0; j < 16; ++j) { const unsigned c = xb_ld(&bar[XB_XCNT(j)]); sum += c; cnt += (c > 0u) ? 1u : 0u; mine = (j == x) ? c : mine; }
        if (sum == G) break;
        __builtin_amdgcn_s_sleep(1);
        if ((++sp & 255u) == 0u) { if (xb_ld(&bar[XB_TMO])) break; if (sp > XB_SPIN_CAP) { atomicAdd(&bar[XB_TMO], 1u); break; } }
    }
    nloc = mine > 0u ? mine : 1u; nx = cnt > 0u ? cnt : 1u;
}
__device__ __forceinline__ void xcd_barrier(const XcdBarrier& b) {
    asm volatile("s_waitcnt vmcnt(0)" ::: "memory");
    __syncthreads();
    if (threadIdx.x == 0) {
        unsigned* bar = b.bar;
        __builtin_amdgcn_s_waitcnt(0);
        unsigned nloc = b.st[0], nx = b.st[1];
        if (nloc == 0u) { xcd_barrier_complete(bar, b.x, nloc, nx); b.st[0] = nloc; b.st[1] = nx; }
        const unsigned old = xb_add(&bar[XB_XSUB(b.x)], 1u);
        const unsigned gen = old / nloc;
        if (old + 1u == (gen + 1u) * nloc) {
            __builtin_amdgcn_fence(__ATOMIC_RELEASE, "agent");
            asm volatile("s_waitcnt vmcnt(0)" ::: "memory");
            const unsigned og = xb_add(&bar[XB_TOP], 1u);
            const unsigned tg = og / nx;
            if (og + 1u == (tg + 1u) * nx) xb_add(&bar[XB_TOPGEN], 1u);
            else XB_SPIN(xb_ld(&bar[XB_TOPGEN]) == tg, bar);
            __builtin_amdgcn_fence(__ATOMIC_ACQUIRE, "agent");
            xb_add(&bar[XB_XGEN(b.x)], 1u);
            asm volatile("s_waitcnt vmcnt(0)" ::: "memory");
        } else {
            XB_SPIN(xb_ld(&bar[XB_XGEN(b.x)]) == gen, bar);
            __builtin_amdgcn_fence(__ATOMIC_ACQUIRE, "agent");
            asm volatile("s_waitcnt vmcnt(0)" ::: "memory");
        }
    }
    __syncthreads();
}

struct Args {
    const float* in[25]; float* out; unsigned char* ws; int ph_lo, ph_hi;
};
struct Frame {
    LAS unsigned char* lds; gu32* ctl; unsigned char* ws;
    int tid, lane, wave, vcu, G;
};
enum { I_X = 0, I_WIN, I_SINK, I_PEK, I_WK1, I_WK2, I_PEV, I_WV1, I_WV2, I_WO, I_FG, I_FU, I_FD, I_GIN, I_GLNG, I_GLNB, I_GWS, I_GBS, I_GOUT, I_RT, I_MG, I_MU, I_MD, I_LNG, I_LNB };

__device__ __forceinline__ void tr_item(const float* W, int pitch, int k0, int n0, bf16* dst, int ldk, LAS float* scr, int lane) {
#pragma unroll 8
    for (int i = 0; i < 32; ++i) { const int kk = 2 * i + (lane >> 5); scr[kk * 33 + (lane & 31)] = W[(size_t)(k0 + kk) * pitch + n0 + (lane & 31)]; }
    LDS_WAIT(); asm volatile("" ::: "memory");
    const int c = lane & 7;
#pragma unroll
    for (int j = 0; j < 4; ++j) { const int n = (lane >> 3) + 8 * j; const LAS float* s = scr + (8 * c) * 33 + n;
        u32x4 o; o.x = pk2(s[0 * 33], s[1 * 33]); o.y = pk2(s[2 * 33], s[3 * 33]); o.z = pk2(s[4 * 33], s[5 * 33]); o.w = pk2(s[6 * 33], s[7 * 33]);
        *(u32x4*)(dst + (size_t)n * ldk + 8 * c) = o; }
    LDS_WAIT(); asm volatile("" ::: "memory");
}
__device__ __forceinline__ void tr_matrix_item(const float* W, int pitch, int K, int N, bf16* WT, int inter_up  , LAS float* scr, int item, int lane) {
    const int nblk = N / 32, kb = item / nblk, nb = item % nblk, k0 = 64 * kb, n0 = 32 * nb;
    const int drow = inter_up < 0 ? n0 : ((n0 >> 7) * 256 + (n0 & 127) + inter_up * 128);
    tr_item(W, pitch, k0, n0, WT + (size_t)drow * K + k0, K, scr, lane);
}

__device__ __forceinline__ void p0_prologue(Frame& F, const Args& a) {
    LAS float* scr = (LAS float*)(F.lds + F.wave * 16384);
    const int gw = F.vcu * NWAVES + F.wave, NGW = F.G * NWAVES;
    unsigned char* ws = F.ws;
    constexpr int IT_WIN = (D / 64) * (2048 / 32), IT_C1 = (2048 / 64) * (256 / 32), IT_SQ = (D / 64) * (D / 32), IT_FG = (D / 64) * (DFF / 32), IT_FD = (DFF / 64) * (D / 32),
                  IT_GIN = (D / 64) * (2048 / 32), IT_MG = (D / 64) * (DFE / 32), IT_MD = (DFE / 64) * (D / 32);
    constexpr int NITEMS = IT_WIN + 2 * IT_C1 + IT_SQ + 2 * IT_FG + IT_FD + IT_GIN + IT_SQ + NEXP * (2 * IT_MG + IT_MD);
    for (int it = gw; it < NITEMS; it += NGW) {
        int r = it;
        if (r < IT_WIN) { tr_matrix_item(a.in[I_WIN], INW, D, 2048, (bf16*)(ws + WS_WIN), -1, scr, r, F.lane); continue; } r -= IT_WIN;
        if (r < IT_C1) { tr_matrix_item(a.in[I_WK1], 256, 2048, 256, (bf16*)(ws + WS_WC1), -1, scr, r, F.lane); continue; } r -= IT_C1;
        if (r < IT_C1) { tr_matrix_item(a.in[I_WV1], 256, 2048, 256, (bf16*)(ws + WS_WC1) + 256 * 2048, -1, scr, r, F.lane); continue; } r -= IT_C1;
        if (r < IT_SQ) { tr_matrix_item(a.in[I_WO], D, D, D, (bf16*)(ws + WS_WO), -1, scr, r, F.lane); continue; } r -= IT_SQ;
        if (r < IT_FG) { tr_matrix_item(a.in[I_FG], DFF, D, DFF, (bf16*)(ws + WS_FGU), 0, scr, r, F.lane); continue; } r -= IT_FG;
        if (r < IT_FG) { tr_matrix_item(a.in[I_FU], DFF, D, DFF, (bf16*)(ws + WS_FGU), 1, scr, r, F.lane); continue; } r -= IT_FG;
        if (r < IT_FD) { tr_matrix_item(a.in[I_FD], D, DFF, D, (bf16*)(ws + WS_FDN), -1, scr, r, F.lane); continue; } r -= IT_FD;
        if (r < IT_GIN) { tr_matrix_item(a.in[I_GIN], 2048, D, 2048, (bf16*)(ws + WS_GIN), -1, scr, r, F.lane); continue; } r -= IT_GIN;
        if (r < IT_SQ) { tr_matrix_item(a.in[I_GOUT], D, D, D, (bf16*)(ws + WS_GOUT), -1, scr, r, F.lane); continue; } r -= IT_SQ;
        { const int per_e = 2 * IT_MG + IT_MD; const int e = r / per_e; int q = r % per_e;
          if (q < IT_MG) { tr_matrix_item(a.in[I_MG] + (size_t)e * D * DFE, DFE, D, DFE, (bf16*)(ws + WS_MGU) + (size_t)e * 2 * DFE * D, 0, scr, q, F.lane); continue; } q -= IT_MG;
          if (q < IT_MG) { tr_matrix_item(a.in[I_MU] + (size_t)e * D * DFE, DFE, D, DFE, (bf16*)(ws + WS_MGU) + (size_t)e * 2 * DFE * D, 1, scr, q, F.lane); continue; } q -= IT_MG;
          tr_matrix_item(a.in[I_MD] + (size_t)e * DFE * D, D, DFE, D, (bf16*)(ws + WS_MDN) + (size_t)e * D * DFE, -1, scr, q, F.lane); }
    }
    if (blockIdx.x < 16) {
        const int kv = blockIdx.x >> 3, n = (blockIdx.x & 7) * 32 + (F.tid & 31), ks = F.tid >> 5;
        const float* pe = a.in[kv ? I_PEV : I_PEK]; const float* w1 = a.in[kv ? I_WV1 : I_WK1]; float* b1 = (float*)(ws + WS_SMALL) + kv * 256;
        float sacc = 0.f;
#pragma unroll 8
        for (int k = ks * 128; k < ks * 128 + 128; ++k) sacc += pe[k] * w1[(size_t)k * 256 + n];
        LAS float* red = (LAS float*)(F.lds + 124 * 1024);
        red[F.tid] = sacc; __syncthreads();
        if (F.tid < 32) { float t = 0.f; for (int q = 0; q < 16; ++q) t += red[q * 32 + F.tid]; b1[n] = t; }
        __syncthreads();
    }
    {
        const float* x = a.in[I_X]; const float* win = a.in[I_WIN]; bf16* xb = (bf16*)(ws + WS_XB); float* gates = (float*)(ws + WS_GATES);
        LAS float* wg = (LAS float*)F.lds;
        __syncthreads();
        for (int i = F.tid; i < 24 * 1024; i += NTHREADS) { const int ch = i / 24, q = i % 24; wg[q * 1024 + ch] = win[(size_t)ch * INW + 2048 + q]; }
        __syncthreads();
        for (int m = gw; m < M; m += NGW) {
            const f32x4* xr = (const f32x4*)(x + (size_t)m * D) + F.lane; f32x4 v[4];
#pragma unroll
            for (int j = 0; j < 4; ++j) v[j] = xr[64 * j];
            unsigned long long* o8 = (unsigned long long*)(xb + (size_t)m * D) + F.lane;
#pragma unroll
            for (int j = 0; j < 4; ++j) o8[64 * j] = (unsigned long long)pk2(v[j][0], v[j][1]) | ((unsigned long long)pk2(v[j][2], v[j][3]) << 32);
            float mine = 0.f;
#pragma unroll 2
            for (int q = 0; q < 24; ++q) { float gq = 0.f;
#pragma unroll
                for (int j = 0; j < 4; ++j) { const f32x4 wv = *(const LAS f32x4*)(wg + q * 1024 + 256 * j + 4 * F.lane); gq += v[j][0] * wv[0] + v[j][1] * wv[1] + v[j][2] * wv[2] + v[j][3] * wv[3]; }
                gq = wave_sum(gq); mine = (F.lane == q) ? gq : mine; }
            if (F.lane < 24) gates[(size_t)m * 24 + F.lane] = mine;
        }
        __syncthreads();
    }
    if (blockIdx.x == 2 && F.tid < 256) ((u32x4*)(ws + WS_KC + (size_t)2 * 32 * 2048 * 64 * 2))[F.tid] = (u32x4){0u, 0u, 0u, 0u};
}

__device__ __forceinline__ void load_q(float (&q)[64], const bf16* qp, float scale) {
#pragma unroll
    for (int i = 0; i < 8; ++i) { const u32x4 v = ((const u32x4*)qp)[i];
        q[8 * i + 0] = bflo(v.x) * scale; q[8 * i + 1] = bfhi(v.x) * scale; q[8 * i + 2] = bflo(v.y) * scale; q[8 * i + 3] = bfhi(v.y) * scale;
        q[8 * i + 4] = bflo(v.z) * scale; q[8 * i + 5] = bfhi(v.z) * scale; q[8 * i + 6] = bflo(v.w) * scale; q[8 * i + 7] = bfhi(v.w) * scale; }
}
__device__ __forceinline__ float dot_bf(const float (&q)[64], const bf16* kp) {
    float s = 0.f;
#pragma unroll
    for (int i = 0; i < 8; ++i) { const u32x4 v = ((const u32x4*)kp)[i];
        s += q[8 * i + 0] * bflo(v.x) + q[8 * i + 1] * bfhi(v.x) + q[8 * i + 2] * bflo(v.y) + q[8 * i + 3] * bfhi(v.y)
           + q[8 * i + 4] * bflo(v.z) + q[8 * i + 5] * bfhi(v.z) + q[8 * i + 6] * bflo(v.w) + q[8 * i + 7] * bfhi(v.w); }
    return s;
}
__device__ __forceinline__ float dot_f32(const float (&q)[64], const float* kp) {
    float s = 0.f;
#pragma unroll
    for (int i = 0; i < 16; ++i) { const f32x4 v = ((const f32x4*)kp)[i]; s += q[4 * i] * v[0] + q[4 * i + 1] * v[1] + q[4 * i + 2] * v[2] + q[4 * i + 3] * v[3]; }
    return s;
}
__device__ __forceinline__ float pv_bf(float o, float e, const bf16* vbase, size_t pitch, int j0, int j1, int lane) {
    for (int j = j0; j < j1; ++j) { const float p = __builtin_bit_cast(float, __builtin_amdgcn_readlane(__builtin_bit_cast(int, e), j)); o += p * bf2f(vbase[(size_t)j * pitch + lane]); }
    return o;
}
__device__ __forceinline__ float pv_f32(float o, float e, const float* vbase, size_t pitch, int j0, int j1, int lane) {
    for (int j = j0; j < j1; ++j) { const float p = __builtin_bit_cast(float, __builtin_amdgcn_readlane(__builtin_bit_cast(int, e), j)); o += p * vbase[(size_t)j * pitch + lane]; }
    return o;
}
__device__ __forceinline__ float alibi_slope(int h) { return exp2f(-0.5f * (float)(h + 1)); }

__device__ __forceinline__ void p4_attention(Frame& F, const Args& a) {
    const int gw = F.vcu * NWAVES + F.wave, NGW = F.G * NWAVES, lane = F.lane;
    const bf16* P = (const bf16*)(F.ws + WS_P); bf16* O = (bf16*)(F.ws + WS_O);
    const float NINF = -__builtin_inff();
    for (int task = gw; task < M * 8; task += NGW) {
        const int m = task >> 3, h = task & 7, b = m >> 11, t = m & 2047, kvh = h >> 2;
        const float slope = alibi_slope(h), sink = a.in[I_SINK][h];
        float q[64]; load_q(q, P + (size_t)m * PW + h * 64, 0.125f);
        const bf16* Kb = P + (size_t)b * SEQ * PW + 512 + kvh * 64; const bf16* Vb = P + (size_t)b * SEQ * PW + 640 + kvh * 64;
        float s[2];
#pragma unroll
        for (int c = 0; c < 2; ++c) { const int kp = t - 127 + 64 * c + lane; const bool valid = kp >= 0; const int kc = valid ? kp : 0;
            const float d = dot_bf(q, Kb + (size_t)kc * PW); s[c] = valid ? d - slope * (float)(t - kp) : NINF; }
        float mx = fmaxf(wave_max(fmaxf(s[0], s[1])), sink);
        float e0 = __expf(s[0] - mx), e1 = __expf(s[1] - mx);
        const float den = wave_sum(e0 + e1) + __expf(sink - mx);
        float o = 0.f;
#pragma unroll
        for (int c = 0; c < 2; ++c) { const int base = t - 127 + 64 * c; const int j0 = base < 0 ? (-base < 64 ? -base : 64) : 0;
            o = pv_bf(o, c ? e1 : e0, Vb + (long)base * PW, PW, j0, 64, lane); }
        O[(size_t)m * D + h * 64 + lane] = (bf16)f2bf(o / den);
    }
    const float* KCC = (const float*)(F.ws + WS_KCC); const float* gates = (const float*)(F.ws + WS_GATES);
    LAS float* sc = (LAS float*)(F.lds + F.wave * 1024);
    for (int task = gw; task < M * 2; task += NGW) {
        const int m = task >> 1, hkv = task & 1, b = m >> 11, t = m & 2047, tb = t >> 6;
        const int nvc = t >= 31 ? ((t - 31) / 16 + 1 < NCMP ? (t - 31) / 16 + 1 : NCMP) : 0;
        const float* kcc = KCC + (size_t)((b * 2 + hkv) * 128) * 64; const float* vcc = KCC + (size_t)4096 * 64 + (size_t)((b * 2 + hkv) * 128) * 64;
        float oc0 = 0.f, oc1 = 0.f, oc2 = 0.f, oc3 = 0.f, ps0 = 0.f, ps1 = 0.f;
#pragma unroll 1
        for (int g = 0; g < 4; ++g) {
            const int hb = hkv * 4 + g; const float slope = alibi_slope(8 + hb);
            float q[64]; load_q(q, P + (size_t)m * PW + 768 + hb * 64, 0.125f);
            float s[2];
#pragma unroll
            for (int c = 0; c < 2; ++c) { const int cb = 64 * c + lane; const bool valid = cb < nvc;
                const float d = dot_f32(q, kcc + (size_t)cb * 64); s[c] = valid ? d - slope * (float)(t - (16 * cb + 31)) : NINF; }
            float mx = wave_max(fmaxf(s[0], s[1])); if (!(mx > NINF)) mx = 0.f;
            float e0 = (lane < nvc) ? __expf(s[0] - mx) : 0.f, e1 = (64 + lane < nvc) ? __expf(s[1] - mx) : 0.f;
            const float den = wave_sum(e0 + e1); const float inv = den > 0.f ? 1.0f / den : 1.0f;
            e0 *= inv; e1 *= inv; ps0 += e0; ps1 += e1;
            float o = 0.f;
            o = pv_f32(o, e0, vcc, 64, 0, nvc < 64 ? nvc : 64, lane);
            o = pv_f32(o, e1, vcc + 64 * 64, 64, 0, nvc > 64 ? nvc - 64 : 0, lane);
            oc0 = (g == 0) ? o : oc0; oc1 = (g == 1) ? o : oc1; oc2 = (g == 2) ? o : oc2; oc3 = (g == 3) ? o : oc3;
        }
        sc[lane] = ps0; sc[64 + lane] = ps1; LDS_WAIT(); asm volatile("" ::: "memory");
        float imp = 0.f;
        if (lane < 32) {
#pragma unroll
            for (int k = -1; k <= 3; ++k) { const int c = 4 * lane + k; if (c >= 0 && c < NCMP) imp += sc[c]; } }
        LDS_WAIT(); asm volatile("" ::: "memory");
        const bool validj = lane <= tb, forced = (lane == 0) || (lane == tb) || (lane == tb - 1);
        const float rank = (lane >= 32) ? NINF : (forced ? __builtin_inff() : (validj ? imp : NINF));
        int cnt = 0;
        for (int jj = 0; jj < 32; ++jj) { const float rj = __builtin_bit_cast(float, __builtin_amdgcn_readlane(__builtin_bit_cast(int, rank), jj)); cnt += (rj > rank || (rj == rank && jj < lane)) ? 1 : 0; }
        const unsigned selmask = (unsigned)__ballot(lane < 32 && cnt < 8 && validj);
#pragma unroll 1
        for (int g = 0; g < 4; ++g) {
            const int hb = hkv * 4 + g; const float slope = alibi_slope(8 + hb);
            float q[64]; load_q(q, P + (size_t)m * PW + 768 + hb * 64, 0.125f);
            float oslc = 0.f;
            {
                const bf16* Kb = P + (size_t)b * SEQ * PW + 1536 + hkv * 64; const bf16* Vb = P + (size_t)b * SEQ * PW + 1664 + hkv * 64;
                float s[8]; unsigned mm = selmask; float mx = NINF;
#pragma unroll
                for (int i = 0; i < 8; ++i) { s[i] = NINF;
                    if (mm) { const int j = __builtin_ctz(mm); mm &= mm - 1; const int kp = 64 * j + lane; const bool valid = kp <= t; const int kc = valid ? kp : t;
                        const float d = dot_bf(q, Kb + (size_t)kc * PW); s[i] = valid ? d - slope * (float)(t - kp) : NINF; }
                    mx = fmaxf(mx, s[i]); }
                mx = wave_max(mx);
                float den = 0.f;
#pragma unroll
                for (int i = 0; i < 8; ++i) { s[i] = __expf(s[i] - mx); den += s[i]; }
                den = wave_sum(den);
                mm = selmask;
#pragma unroll
                for (int i = 0; i < 8; ++i) { if (mm) { const int j = __builtin_ctz(mm); mm &= mm - 1; const int nk = (t - 64 * j + 1) < 64 ? (t - 64 * j + 1) : 64;
                        oslc = pv_bf(oslc, s[i], Vb + (size_t)(64 * j) * PW, PW, 0, nk, lane); } }
                oslc /= den;
            }
            float owin = 0.f;
            {
                const bf16* Kb = P + (size_t)b * SEQ * PW + 1792 + hkv * 64; const bf16* Vb = P + (size_t)b * SEQ * PW + 1920 + hkv * 64;
                float s[4]; float mx = NINF;
#pragma unroll
                for (int c = 0; c < 4; ++c) { const int kp = t - 255 + 64 * c + lane; const bool valid = kp >= 0; const int kc = valid ? kp : 0;
                    const float d = dot_bf(q, Kb + (size_t)kc * PW); s[c] = valid ? d - slope * (float)(t - kp) : NINF; mx = fmaxf(mx, s[c]); }
                mx = wave_max(mx);
                float den = 0.f;
#pragma unroll
                for (int c = 0; c < 4; ++c) { s[c] = __expf(s[c] - mx); den += s[c]; }
                den = wave_sum(den);
#pragma unroll
                for (int c = 0; c < 4; ++c) { const int base = t - 255 + 64 * c; const int j0 = base < 0 ? (-base < 64 ? -base : 64) : 0;
                    owin = pv_bf(owin, s[c], Vb + (long)base * PW, PW, j0, 64, lane); }
                owin /= den;
            }
            const float* gp = gates + (size_t)m * 24 + hb * 3;
            const float oc = (g == 0) ? oc0 : (g == 1) ? oc1 : (g == 2) ? oc2 : oc3;
            const float r = sigmoidf(gp[0]) * oc + sigmoidf(gp[1]) * oslc + sigmoidf(gp[2]) * owin;
            O[(size_t)m * D + 512 + hb * 64 + lane] = (bf16)f2bf(r);
        }
    }
}


namespace att {
typedef float f32x16 __attribute__((ext_vector_type(16)));
typedef short s16x4 __attribute__((ext_vector_type(4)));
typedef __bf16 bf16x2_t __attribute__((ext_vector_type(2)));
constexpr int KP = 144;
constexpr int TILEB = 64 * KP;
constexpr int BUFB = 2 * TILEB;
constexpr float LOG2E = 1.4426950408889634f;
__device__ __forceinline__ unsigned cvtpk(float lo, float hi) { f32x2 v = {lo, hi}; bf16x2_t b = __builtin_convertvector(v, bf16x2_t); return __builtin_bit_cast(unsigned, b); }
__device__ __forceinline__ f32x16 zero16() { f32x16 z;
#pragma unroll
    for (int i = 0; i < 16; ++i) z[i] = 0.f; return z; }
struct Stage { u32x4 k, v; };
__device__ __forceinline__ void stage_load(Stage& s, const bf16* Kg, const bf16* Vg, size_t pitch, int row0, int tid) {
    const int key = tid >> 3, ch = tid & 7; s.k = *(const u32x4*)(Kg + (size_t)(row0 + key) * pitch + ch * 8); s.v = *(const u32x4*)(Vg + (size_t)(row0 + key) * pitch + ch * 8); }
__device__ __forceinline__ void stage_store(const Stage& s, LAS unsigned char* buf, int tid) {
    const int key = tid >> 3, ch = tid & 7; *(LAS u32x4*)(buf + key * KP + ch * 16) = s.k; *(LAS u32x4*)(buf + TILEB + key * KP + ch * 16) = s.v; }
__device__ __forceinline__ bf16x8 pack_frag(const f32x16& x, int s) {
    u32x4 w; w.x = cvtpk(x[8 * s], x[8 * s + 1]); w.y = cvtpk(x[8 * s + 2], x[8 * s + 3]); w.z = cvtpk(x[8 * s + 4], x[8 * s + 5]); w.w = cvtpk(x[8 * s + 6], x[8 * s + 7]); return __builtin_bit_cast(bf16x8, w); }

template <int MODE>
__device__ __forceinline__ void stream(f32x16 (&oT)[2], f32x16& imp, float& m_run, float& l_run, const bf16x8 (&qf)[4], const bf16* Kg, const bf16* Vg, size_t pitch,
                                       int first, int ntile, unsigned umask, int tq, float slope, unsigned selmask, int W, LAS unsigned char* lds, int tid, int lane) {
    const int r = lane & 31, h = lane >> 5;
    const float NINF = -__builtin_inff();
    if (ntile <= 0) return;
    __syncthreads();
    Stage st; unsigned mm = umask;
    int kt = (MODE == 1) ? __builtin_ctz(mm) : first; if (MODE == 1) mm &= mm - 1;
    stage_load(st, Kg, Vg, pitch, 64 * kt, tid);
    for (int i = 0; i < ntile; ++i) {
        LAS unsigned char* buf = lds + (i & 1) * BUFB;
        stage_store(st, buf, tid);
        __syncthreads();
        const int ktc = kt;
        if (i + 1 < ntile) { kt = (MODE == 1) ? __builtin_ctz(mm) : kt + 1; if (MODE == 1) mm &= mm - 1; stage_load(st, Kg, Vg, pitch, 64 * kt, tid); }
        f32x16 p[2];
#pragma unroll
        for (int blk = 0; blk < 2; ++blk) { p[blk] = zero16();
#pragma unroll
            for (int d0 = 0; d0 < 4; ++d0) { const bf16x8 ka = *(const LAS bf16x8*)(buf + (32 * blk + r) * KP + (16 * d0 + 8 * h) * 2);
                p[blk] = __builtin_amdgcn_mfma_f32_32x32x16_bf16(ka, qf[d0], p[blk], 0, 0, 0); } }
        float fb, step;
        if (MODE == 2) { fb = (float)(tq - 31 - 16 * (64 * ktc + 4 * h)); step = 16.f; } else { fb = (float)(tq - 64 * ktc - 4 * h); step = 1.f; }
        const bool lane_on = (MODE == 1) ? ((selmask >> ktc) & 1u) != 0u : true;
        float tmax = NINF;
#pragma unroll
        for (int blk = 0; blk < 2; ++blk)
#pragma unroll
            for (int i2 = 0; i2 < 16; ++i2) { const float dist = fb - step * (float)(32 * blk + (i2 & 3) + 8 * (i2 >> 2));
                bool valid = dist >= 0.f && lane_on; if (MODE == 0) valid = valid && dist < (float)W;
                const float sv = valid ? p[blk][i2] - slope * dist : NINF; p[blk][i2] = sv; tmax = fmaxf(tmax, sv); }
        tmax = fmaxf(tmax, __shfl_xor(tmax, 32));
        const float m_new = fmaxf(m_run, tmax), m_use = (m_new == NINF) ? 0.f : m_new;
        const float alpha = __builtin_amdgcn_exp2f((m_run - m_use) * LOG2E), mb = -m_use * LOG2E;
        float rs = 0.f;
#pragma unroll
        for (int blk = 0; blk < 2; ++blk)
#pragma unroll
            for (int i2 = 0; i2 < 16; ++i2) { const float e = __builtin_amdgcn_exp2f(fmaf(p[blk][i2], LOG2E, mb)); p[blk][i2] = e; rs += e; }
        l_run = l_run * alpha + rs; m_run = m_new;
#pragma unroll
        for (int i2 = 0; i2 < 16; ++i2) { oT[0][i2] *= alpha; oT[1][i2] *= alpha; if (MODE == 2) imp[i2] *= alpha; }
        const LAS unsigned char* vb = buf + TILEB + (4 * h + ((lane >> 2) & 3)) * KP + (16 * ((lane >> 4) & 1) + 4 * (lane & 3)) * 2;
#pragma unroll
        for (int blk = 0; blk < 2; ++blk)
#pragma unroll
            for (int s = 0; s < 2; ++s) { const int ks = 2 * blk + s; const bf16x8 pf = pack_frag(p[blk], s);
#pragma unroll
                for (int db = 0; db < 2; ++db) { const LAS unsigned char* ad = vb + (16 * ks) * KP + (32 * db) * 2;
                    const s16x4 lo = __builtin_bit_cast(s16x4, __builtin_amdgcn_ds_read_tr16_b64_v4i16((LAS s16x4*)ad));
                    const s16x4 hi = __builtin_bit_cast(s16x4, __builtin_amdgcn_ds_read_tr16_b64_v4i16((LAS s16x4*)(ad + 8 * KP)));
                    const bf16x8 vf = (bf16x8){lo[0], lo[1], lo[2], lo[3], hi[0], hi[1], hi[2], hi[3]};
                    oT[db] = __builtin_amdgcn_mfma_f32_32x32x16_bf16(vf, pf, oT[db], 0, 0, 0); }
                if (MODE == 2) {
                    u32x4 w;
#pragma unroll
                    for (int e2 = 0; e2 < 4; ++e2) { const int c0 = 64 * ktc + 16 * ks + 8 * (e2 >> 1) + 4 * h + 2 * (e2 & 1), c1 = c0 + 1;
                        const unsigned b0 = (c0 >= 4 * r - 1 && c0 <= 4 * r + 3) ? 0x3F80u : 0u, b1 = (c1 >= 4 * r - 1 && c1 <= 4 * r + 3) ? 0x3F80u : 0u; w[e2] = b0 | (b1 << 16); }
                    imp = __builtin_amdgcn_mfma_f32_32x32x16_bf16(__builtin_bit_cast(bf16x8, w), pf, imp, 0, 0, 0); } }
    }
}
__device__ __forceinline__ void load_qfrag(bf16x8 (&qf)[4], const bf16* qrow, int h) {
#pragma unroll
    for (int d0 = 0; d0 < 4; ++d0) { const u32x4 v = *(const u32x4*)(qrow + 16 * d0 + 8 * h); u32x4 w;
        w.x = cvtpk(bflo(v.x) * 0.125f, bfhi(v.x) * 0.125f); w.y = cvtpk(bflo(v.y) * 0.125f, bfhi(v.y) * 0.125f); w.z = cvtpk(bflo(v.z) * 0.125f, bfhi(v.z) * 0.125f); w.w = cvtpk(bflo(v.w) * 0.125f, bfhi(v.w) * 0.125f);
        qf[d0] = __builtin_bit_cast(bf16x8, w); }
}
__device__ __forceinline__ void fold(f32x16 (&res)[2], const f32x16 (&oT)[2], float sc) {
#pragma unroll
    for (int i = 0; i < 16; ++i) { res[0][i] += sc * oT[0][i]; res[1][i] += sc * oT[1][i]; } }
__device__ __forceinline__ void store_o(bf16* orow, const f32x16 (&res)[2], int h) {
#pragma unroll
    for (int db = 0; db < 2; ++db)
#pragma unroll
        for (int a4 = 0; a4 < 4; ++a4) { u32x2 w; w.x = cvtpk(res[db][4 * a4], res[db][4 * a4 + 1]); w.y = cvtpk(res[db][4 * a4 + 2], res[db][4 * a4 + 3]);
            *(u32x2*)(orow + 32 * db + 8 * a4 + 4 * h) = w; }
}
}

__device__ __forceinline__ void p4_attention_mfma(Frame& F, const Args& a) {
    using namespace att;
    const int lane = F.lane, tid = F.tid, w = F.wave, r = lane & 31, h = lane >> 5, g = r >> 3, qi = r & 7;
    const bf16* P = (const bf16*)(F.ws + WS_P); bf16* O = (bf16*)(F.ws + WS_O);
    const bf16* KCB = (const bf16*)(F.ws + WS_KCCB); const float* gates = (const float*)(F.ws + WS_GATES);
    LAS unsigned* ubuf = (LAS unsigned*)(F.lds + 4 * BUFB);
    const float NINF = -__builtin_inff();
    const int x = F.vcu, bh = x >> 3, qslot = x & 7, b = bh >> 1, hkv = bh & 1;
    if (x >= 256) return;
    for (int rr = 0; rr < 4; ++rr) {
        const int qt = (rr & 1) ? 8 * rr + 7 - qslot : 8 * rr + qslot;
        const int tq = 64 * qt + 8 * w + qi; const size_t m = (size_t)b * SEQ + tq;
        const bf16* Pb = P + (size_t)b * SEQ * PW;
        {
            const int hd = hkv * 4 + g; const float slope = alibi_slope(hd);
            bf16x8 qf[4]; load_qfrag(qf, P + m * PW + hd * 64, h);
            f32x16 oT[2] = {zero16(), zero16()}, dummy = zero16(); float m_run = NINF, l_run = 0.f;
            const int first = qt >= 2 ? qt - 2 : 0;
            stream<0>(oT, dummy, m_run, l_run, qf, Pb + 512 + hkv * 64, Pb + 640 + hkv * 64, PW, first, qt - first + 1, 0u, tq, slope, 0u, 128, F.lds, tid, lane);
            float l_tot = l_run + __shfl_xor(l_run, 32); l_tot += __expf(a.in[I_SINK][hd] - m_run);
            f32x16 res[2] = {zero16(), zero16()}; fold(res, oT, 1.0f / l_tot);
            store_o(O + m * D + hd * 64, res, h);
        }
        {
            const int hb = hkv * 4 + g; const float slope = alibi_slope(8 + hb);
            bf16x8 qf[4]; load_qfrag(qf, P + m * PW + 768 + hb * 64, h);
            const float* gp = gates + m * 24 + hb * 3;
            const float g0 = sigmoidf(gp[0]), g1 = sigmoidf(gp[1]), g2 = sigmoidf(gp[2]);
            f32x16 res[2] = {zero16(), zero16()};
            unsigned selmask = 0u;
            {
                f32x16 oT[2] = {zero16(), zero16()}, imp = zero16(); float m_run = NINF, l_run = 0.f;
                const int nvc_max = (64 * qt + 63 >= 31) ? ((64 * qt + 63 - 31) / 16 + 1) : 0;
                const int ntile = nvc_max > 64 ? 2 : (nvc_max > 0 ? 1 : 0);
                stream<2>(oT, imp, m_run, l_run, qf, KCB + (size_t)(bh * 128) * 64, KCB + (size_t)4096 * 64 + (size_t)(bh * 128) * 64, 64, 0, ntile, 0u, tq, slope, 0u, 0, F.lds, tid, lane);
                const float l_tot = l_run + __shfl_xor(l_run, 32); const float inv = l_tot > 0.f ? 1.0f / l_tot : 0.f;
                fold(res, oT, g0 * inv);
                float R[32];
#pragma unroll
                for (int i = 0; i < 16; ++i) { float v = imp[i] * inv; v += __shfl_xor(v, 8); v += __shfl_xor(v, 16); const float o = __shfl_xor(v, 32);
                    const int j0 = (i & 3) + 8 * (i >> 2); R[j0] = h ? o : v; R[j0 + 4] = h ? v : o; }
                const int tb = tq >> 6;
#pragma unroll
                for (int j = 0; j < 32; ++j) R[j] = (j == 0 || j == tb || j == tb - 1) ? __builtin_inff() : (j <= tb ? R[j] : NINF);
#pragma unroll 1
                for (int rd = 0; rd < 8; ++rd) { float best = NINF; int bj = -1;
#pragma unroll
                    for (int j = 0; j < 32; ++j) { if (R[j] > best) { best = R[j]; bj = j; } }
                    if (bj >= 0) selmask |= 1u << bj;
#pragma unroll
                    for (int j = 0; j < 32; ++j) R[j] = (j == bj) ? NINF : R[j]; }
            }
            unsigned um = selmask;
#pragma unroll
            for (int o2 = 1; o2 < 64; o2 <<= 1) um |= (unsigned)__shfl_xor((int)um, o2);
            __syncthreads();
            if (lane == 0) ubuf[w] = um;
            __syncthreads();
            um = ubuf[0] | ubuf[1] | ubuf[2] | ubuf[3] | ubuf[4] | ubuf[5] | ubuf[6] | ubuf[7];
            um = (unsigned)__builtin_amdgcn_readfirstlane((int)um);
            {
                f32x16 oT[2] = {zero16(), zero16()}, dummy = zero16(); float m_run = NINF, l_run = 0.f;
                stream<1>(oT, dummy, m_run, l_run, qf, Pb + 1536 + hkv * 64, Pb + 1664 + hkv * 64, PW, 0, __builtin_popcount(um), um, tq, slope, selmask, 0, F.lds, tid, lane);
                const float l_tot = l_run + __shfl_xor(l_run, 32); fold(res, oT, g1 / l_tot);
            }
            {
                f32x16 oT[2] = {zero16(), zero16()}, dummy = zero16(); float m_run = NINF, l_run = 0.f;
                const int first = qt >= 4 ? qt - 4 : 0;
                stream<0>(oT, dummy, m_run, l_run, qf, Pb + 1792 + hkv * 64, Pb + 1920 + hkv * 64, PW, first, qt - first + 1, 0u, tq, slope, 0u, 256, F.lds, tid, lane);
                const float l_tot = l_run + __shfl_xor(l_run, 32); fold(res, oT, g2 / l_tot);
            }
            store_o(O + m * D + 512 + hb * 64, res, h);
        }
    }
}


__device__ __forceinline__ void p11_spatial_mfma(Frame& F, const Args& a) {
    using namespace att;
    constexpr int VP = 272;
    const bf16* U = (const bf16*)(F.ws + WS_U); const bf16* V = (const bf16*)(F.ws + WS_V); bf16* Z = (bf16*)(F.ws + WS_Z);
    LAS f32x2* st = (LAS f32x2*)(F.lds + LDS_STATS_OFF);
    const float* lng = a.in[I_GLNG]; const float* lnb = a.in[I_GLNB]; const float* ws_ = a.in[I_GWS]; const float* bs = a.in[I_GBS];
    const int tid = F.tid, lane = F.lane, w = F.wave, r = lane & 31, h = lane >> 5, tb = w & 3, cb0 = 2 * (w >> 2);
    for (int unit = blockIdx.x; unit < NB * 16; unit += F.G) {
        const int m0 = unit * 128;
        __syncthreads();
        for (int rr = 0; rr < 16; ++rr) { const int row = w * 16 + rr; const bf16* vr = V + (size_t)(m0 + row) * D;
            const u32x4 p0 = ((const u32x4*)vr)[lane], p1 = ((const u32x4*)vr)[64 + lane]; float x[16];
            x[0] = bflo(p0.x); x[1] = bfhi(p0.x); x[2] = bflo(p0.y); x[3] = bfhi(p0.y); x[4] = bflo(p0.z); x[5] = bfhi(p0.z); x[6] = bflo(p0.w); x[7] = bfhi(p0.w);
            x[8] = bflo(p1.x); x[9] = bfhi(p1.x); x[10] = bflo(p1.y); x[11] = bfhi(p1.y); x[12] = bflo(p1.z); x[13] = bfhi(p1.z); x[14] = bflo(p1.w); x[15] = bfhi(p1.w);
            float sm = 0.f;
#pragma unroll
            for (int i = 0; i < 16; ++i) sm += x[i];
            const float mean = wave_sum(sm) * (1.f / D); float s2 = 0.f;
#pragma unroll
            for (int i = 0; i < 16; ++i) { const float d = x[i] - mean; s2 += d * d; }
            const float rstd = 1.f / sqrtf(wave_sum(s2) * (1.f / D) + LN_EPS);
            if (lane == 0) st[row] = (f32x2){mean, rstd}; }
        __syncthreads();
#pragma unroll 1
        for (int g = 0; g < 8; ++g) {
            LAS unsigned char* buf = F.lds + (g & 1) * (128 * VP);
            { const int c8 = tid & 15; const float* gp = lng + g * 128 + 8 * c8; const float* bp = lnb + g * 128 + 8 * c8;
              const f32x4 ga = *(const f32x4*)gp, gb = *(const f32x4*)(gp + 4), ba = *(const f32x4*)bp, bb = *(const f32x4*)(bp + 4);
#pragma unroll
              for (int k = 0; k < 4; ++k) { const int sidx = (tid >> 4) + 32 * k; const f32x2 ms = st[sidx];
                  const u32x4 v = *(const u32x4*)(V + (size_t)(m0 + sidx) * D + g * 128 + 8 * c8); u32x4 o;
                  o.x = cvtpk((bflo(v.x) - ms.x) * ms.y * ga[0] + ba[0], (bfhi(v.x) - ms.x) * ms.y * ga[1] + ba[1]);
                  o.y = cvtpk((bflo(v.y) - ms.x) * ms.y * ga[2] + ba[2], (bfhi(v.y) - ms.x) * ms.y * ga[3] + ba[3]);
                  o.z = cvtpk((bflo(v.z) - ms.x) * ms.y * gb[0] + bb[0], (bfhi(v.z) - ms.x) * ms.y * gb[1] + bb[1]);
                  o.w = cvtpk((bflo(v.w) - ms.x) * ms.y * gb[2] + bb[2], (bfhi(v.w) - ms.x) * ms.y * gb[3] + bb[3]);
                  *(LAS u32x4*)(buf + sidx * VP + c8 * 16) = o; } }
            const int t = 32 * tb + r; bf16x8 wf[8];
#pragma unroll
            for (int ks = 0; ks < 8; ++ks) { const int s0 = 16 * ks + 8 * h; const float* wp = ws_ + (size_t)g * 16384 + t * 128 + s0; u32x4 o = (u32x4){0u, 0u, 0u, 0u};
                if (ks <= 2 * tb + 1) { f32x4 w0 = *(const f32x4*)wp, w1 = *(const f32x4*)(wp + 4);
#pragma unroll
                    for (int j = 0; j < 4; ++j) { if (s0 + j > t) w0[j] = 0.f; if (s0 + 4 + j > t) w1[j] = 0.f; }
                    o.x = cvtpk(w0[0], w0[1]); o.y = cvtpk(w0[2], w0[3]); o.z = cvtpk(w1[0], w1[1]); o.w = cvtpk(w1[2], w1[3]); }
                wf[ks] = __builtin_bit_cast(bf16x8, o); }
            __syncthreads();
            f32x16 acc[2] = {zero16(), zero16()};
            const LAS unsigned char* ab = buf + (8 * h + ((lane >> 2) & 3)) * VP + (16 * ((lane >> 4) & 1) + 4 * (lane & 3)) * 2;
#pragma unroll
            for (int ks = 0; ks < 8; ++ks) { if (ks <= 2 * tb + 1) {
#pragma unroll
                for (int cb = 0; cb < 2; ++cb) { const LAS unsigned char* ad = ab + (16 * ks) * VP + (32 * (cb0 + cb)) * 2;
                    const s16x4 lo = __builtin_bit_cast(s16x4, __builtin_amdgcn_ds_read_tr16_b64_v4i16((LAS s16x4*)ad));
                    const s16x4 hi = __builtin_bit_cast(s16x4, __builtin_amdgcn_ds_read_tr16_b64_v4i16((LAS s16x4*)(ad + 4 * VP)));
                    const bf16x8 vf = (bf16x8){lo[0], lo[1], lo[2], lo[3], hi[0], hi[1], hi[2], hi[3]};
                    acc[cb] = __builtin_amdgcn_mfma_f32_32x32x16_bf16(vf, wf[ks], acc[cb], 0, 0, 0); } } }
            const float bt = bs[g * 128 + t]; const size_t rowo = (size_t)(m0 + t) * D + g * 128;
#pragma unroll
            for (int cb = 0; cb < 2; ++cb)
#pragma unroll
                for (int a4 = 0; a4 < 4; ++a4) { const size_t o = rowo + 32 * (cb0 + cb) + 8 * a4 + 4 * h; const u32x2 uu = *(const u32x2*)(U + o); u32x2 zz;
                    zz.x = cvtpk(bflo(uu.x) * (acc[cb][4 * a4] + bt), bfhi(uu.x) * (acc[cb][4 * a4 + 1] + bt)); zz.y = cvtpk(bflo(uu.y) * (acc[cb][4 * a4 + 2] + bt), bfhi(uu.y) * (acc[cb][4 * a4 + 3] + bt));
                    *(u32x2*)(Z + o) = zz; }
        }
    }
}

template <int MODE>
__device__ __forceinline__ void ln_phase(Frame& F, const Args& a, const float* lg, const float* lb) {
    const int gw = F.vcu * NWAVES + F.wave, NGW = F.G * NWAVES, lane = F.lane;
    float* out = a.out; bf16* xb = (bf16*)(F.ws + WS_XB);
    f32x4 gg[4], bb[4];
#pragma unroll
    for (int j = 0; j < 4; ++j) { gg[j] = *((const f32x4*)lg + lane + 64 * j); bb[j] = *((const f32x4*)lb + lane + 64 * j); }
    LAS float* wrl = (LAS float*)F.lds;
    LAS int* rinfo = (LAS int*)(F.lds + 32768);
    LAS int* lcnt = (LAS int*)(F.lds + 32768 + 4096);
    LAS int* lbase = lcnt + 8;
    int nrow = 0;
    if (MODE == 1) {
        __syncthreads();
        for (int i = F.tid; i < 8192; i += NTHREADS) wrl[(i & 7) * 1024 + (i >> 3)] = a.in[I_RT][i];
        if (F.tid < 8) lcnt[F.tid] = 0;
        __syncthreads();
    }
    for (int m = gw; m < M; m += NGW) {
        f32x4* xr = (f32x4*)(out + (size_t)m * D) + lane; f32x4 v[4]; float s = 0.f;
#pragma unroll
        for (int j = 0; j < 4; ++j) v[j] = xr[64 * j];
        if (MODE == 2) {
            const bf16* y = (const bf16*)(F.ws + WS_Y2) + (size_t)m * 2 * D;
#pragma unroll
            for (int j = 0; j < 4; ++j) { const u32x2 y0 = *((const u32x2*)y + lane + 64 * j), y1 = *((const u32x2*)(y + D) + lane + 64 * j);
                v[j][0] = ALPHA * v[j][0] + bflo(y0.x) + bflo(y1.x); v[j][1] = ALPHA * v[j][1] + bfhi(y0.x) + bfhi(y1.x);
                v[j][2] = ALPHA * v[j][2] + bflo(y0.y) + bflo(y1.y); v[j][3] = ALPHA * v[j][3] + bfhi(y0.y) + bfhi(y1.y); }
        }
#pragma unroll
        for (int j = 0; j < 4; ++j) s += (v[j][0] + v[j][1]) + (v[j][2] + v[j][3]);
        const float mean = wave_sum(s) * (1.f / D); float s2 = 0.f;
#pragma unroll
        for (int j = 0; j < 4; ++j) { v[j] = v[j] - mean; s2 += (v[j][0] * v[j][0] + v[j][1] * v[j][1]) + (v[j][2] * v[j][2] + v[j][3] * v[j][3]); }
        const float rstd = 1.f / sqrtf(wave_sum(s2) * (1.f / D) + LN_EPS);
#pragma unroll
        for (int j = 0; j < 4; ++j) { v[j] = v[j] * rstd * gg[j] + bb[j]; xr[64 * j] = v[j]; }
        if (MODE != 2) {
            unsigned long long* o8 = (unsigned long long*)(xb + (size_t)m * D) + lane;
#pragma unroll
            for (int j = 0; j < 4; ++j) o8[64 * j] = (unsigned long long)pk2(v[j][0], v[j][1]) | ((unsigned long long)pk2(v[j][2], v[j][3]) << 32);
        }
        if (MODE == 1) {
            float lg8[8];
#pragma unroll
            for (int e = 0; e < 8; ++e) { float t8 = 0.f;
#pragma unroll
                for (int j = 0; j < 4; ++j) { const f32x4 wv = *(const LAS f32x4*)(wrl + e * 1024 + 256 * j + 4 * lane); t8 += v[j][0] * wv[0] + v[j][1] * wv[1] + v[j][2] * wv[2] + v[j][3] * wv[3]; }
                lg8[e] = wave_sum(t8); }
            int e0 = 0; float v0 = lg8[0];
#pragma unroll
            for (int e = 1; e < 8; ++e) if (lg8[e] > v0) { v0 = lg8[e]; e0 = e; }
            int e1 = -1; float v1 = -__builtin_inff();
#pragma unroll
            for (int e = 0; e < 8; ++e) if (e != e0 && lg8[e] > v1) { v1 = lg8[e]; e1 = e; }
            const float g0 = 1.0f / (1.0f + __expf(v1 - v0)), g1 = 1.0f - g0;
            if (lane == 0) {
                const int slot = F.wave * 16 + nrow;
                const int p0 = __hip_atomic_fetch_add((int*)(lcnt + e0), 1, __ATOMIC_RELAXED, __HIP_MEMORY_SCOPE_WORKGROUP), p1 = __hip_atomic_fetch_add((int*)(lcnt + e1), 1, __ATOMIC_RELAXED, __HIP_MEMORY_SCOPE_WORKGROUP);
                rinfo[slot * 8 + 0] = m; rinfo[slot * 8 + 1] = e0; rinfo[slot * 8 + 2] = e1; rinfo[slot * 8 + 3] = p0; rinfo[slot * 8 + 4] = p1; rinfo[slot * 8 + 5] = __builtin_bit_cast(int, g0); rinfo[slot * 8 + 6] = __builtin_bit_cast(int, g1);
            }
            ++nrow;
        }
    }
    if (MODE == 1) {
        __syncthreads();
        if (F.tid < 8) lbase[F.tid] = (int)atomicAdd((unsigned*)(F.ctl + CW_CNT + 64 * F.tid), (unsigned)lcnt[F.tid]);
        __syncthreads();
        int* rowtok = (int*)(F.ws + WS_ROWTOK); int* rowdst = (int*)(F.ws + WS_ROWDST); float* rowgate = (float*)(F.ws + WS_ROWGATE);
        if (F.tid < 128) { const int slot = F.tid; const int wv_ = slot >> 4, k = slot & 15;
            if ((F.vcu * NWAVES + wv_) + k * NGW < M) { const int m = rinfo[slot * 8], e0 = rinfo[slot * 8 + 1], e1 = rinfo[slot * 8 + 2];
                const int q0 = e0 * CAP + lbase[e0] + rinfo[slot * 8 + 3], q1 = e1 * CAP + lbase[e1] + rinfo[slot * 8 + 4];
                rowtok[q0] = m; rowdst[q0] = 2 * m; rowgate[q0] = __builtin_bit_cast(float, rinfo[slot * 8 + 5]);
                rowtok[q1] = m; rowdst[q1] = 2 * m + 1; rowgate[q1] = __builtin_bit_cast(float, rinfo[slot * 8 + 6]); } }
    }
}

__device__ __forceinline__ void p3_compress2(Frame& F, const Args& a) {
    const bf16* H1 = (const bf16*)(F.ws + WS_H1); float* KCC = (float*)(F.ws + WS_KCC);
    const int gt = blockIdx.x * NTHREADS + F.tid, NT = F.G * NTHREADS;
    for (int idx = gt; idx < 2 * 4096 * 64; idx += NT) {
        const int n = idx & 63, r = (idx >> 6) & 4095, kv = idx >> 18;
        const float* w2 = a.in[kv ? I_WV2 : I_WK2]; const bf16* h = H1 + (size_t)(kv * 4096 + r) * 256; float s = 0.f;
        for (int j8 = 0; j8 < 32; ++j8) { const u32x4 v = ((const u32x4*)h)[j8]; const float* w = w2 + (size_t)(8 * j8) * 64 + n;
            s += bflo(v.x) * w[0] + bfhi(v.x) * w[64] + bflo(v.y) * w[128] + bfhi(v.y) * w[192] + bflo(v.z) * w[256] + bfhi(v.z) * w[320] + bflo(v.w) * w[384] + bfhi(v.w) * w[448]; }
        KCC[idx] = s; ((bf16*)(F.ws + WS_KCCB))[idx] = (bf16)f2bf(s);
    }
}

__device__ __forceinline__ void p11_spatial(Frame& F, const Args& a) {
    const bf16* U = (const bf16*)(F.ws + WS_U); const bf16* V = (const bf16*)(F.ws + WS_V); bf16* Z = (bf16*)(F.ws + WS_Z);
    LAS float* Wl = (LAS float*)(F.lds); LAS float* vn = (LAS float*)(F.lds + 65536); LAS f32x2* st = (LAS f32x2*)(F.lds + LDS_STATS_OFF);
    const float* lng = a.in[I_GLNG]; const float* lnb = a.in[I_GLNB]; const float* ws_ = a.in[I_GWS]; const float* bs = a.in[I_GBS];
    const int tid = F.tid, lane = F.lane;
    for (int unit = blockIdx.x; unit < NB * 16; unit += F.G) {
        const int m0 = unit * 128;
        __syncthreads();
        for (int rr = 0; rr < 16; ++rr) { const int r = F.wave * 16 + rr; const bf16* vr = V + (size_t)(m0 + r) * D;
            const u32x4 p0 = ((const u32x4*)vr)[lane], p1 = ((const u32x4*)vr)[64 + lane]; float x[16];
            x[0] = bflo(p0.x); x[1] = bfhi(p0.x); x[2] = bflo(p0.y); x[3] = bfhi(p0.y); x[4] = bflo(p0.z); x[5] = bfhi(p0.z); x[6] = bflo(p0.w); x[7] = bfhi(p0.w);
            x[8] = bflo(p1.x); x[9] = bfhi(p1.x); x[10] = bflo(p1.y); x[11] = bfhi(p1.y); x[12] = bflo(p1.z); x[13] = bfhi(p1.z); x[14] = bflo(p1.w); x[15] = bfhi(p1.w);
            float s = 0.f;
#pragma unroll
            for (int i = 0; i < 16; ++i) s += x[i];
            const float mean = wave_sum(s) * (1.f / D); float s2 = 0.f;
#pragma unroll
            for (int i = 0; i < 16; ++i) { const float d = x[i] - mean; s2 += d * d; }
            const float rstd = 1.f / sqrtf(wave_sum(s2) * (1.f / D) + LN_EPS);
            if (lane == 0) st[r] = (f32x2){mean, rstd}; }
        __syncthreads();
        for (int g = 0; g < 8; ++g) {
            for (int i = tid; i < 128 * 32; i += NTHREADS) { const int t = i >> 5, s4 = (i & 31) * 4; f32x4 w = *(const f32x4*)(ws_ + (size_t)g * 16384 + t * 128 + s4);
                if (s4 + 0 > t) w[0] = 0.f; if (s4 + 1 > t) w[1] = 0.f; if (s4 + 2 > t) w[2] = 0.f; if (s4 + 3 > t) w[3] = 0.f; *(LAS f32x4*)(Wl + t * 128 + s4) = w; }
            { const int ch = tid & 127; const float gch = lng[g * 128 + ch], bch = lnb[g * 128 + ch];
              for (int s = tid >> 7; s < 128; s += 4) { const f32x2 ms = st[s]; vn[s * 128 + ch] = (bf2f(V[(size_t)(m0 + s) * D + g * 128 + ch]) - ms.x) * ms.y * gch + bch; } }
            __syncthreads();
            { const int ch = tid & 127, tq = tid >> 7; float acc[32];
#pragma unroll
              for (int i = 0; i < 32; ++i) acc[i] = 0.f;
              const int s4end = (tq * 32 + 32) / 4;
              for (int s4 = 0; s4 < s4end; ++s4) { const float v0 = vn[(4 * s4) * 128 + ch], v1 = vn[(4 * s4 + 1) * 128 + ch], v2 = vn[(4 * s4 + 2) * 128 + ch], v3 = vn[(4 * s4 + 3) * 128 + ch];
#pragma unroll
                  for (int i = 0; i < 32; ++i) { const f32x4 w = *(const LAS f32x4*)(Wl + (tq * 32 + i) * 128 + 4 * s4); acc[i] += w[0] * v0 + w[1] * v1 + w[2] * v2 + w[3] * v3; } }
#pragma unroll
              for (int i = 0; i < 32; ++i) { const int t = tq * 32 + i; const size_t o = (size_t)(m0 + t) * D + g * 128 + ch;
                  Z[o] = (bf16)f2bf(bf2f(U[o]) * (acc[i] + bs[g * 128 + t])); } }
            __syncthreads();
        }
    }
}

constexpr int N_PHASES = 25;
__global__ void __launch_bounds__(NTHREADS, 2) fwd(Args args) {
    extern __shared__ __attribute__((aligned(16))) unsigned char lds[];
    Frame F;
    F.lds = (LAS unsigned char*)lds; F.ws = args.ws; F.ctl = (gu32*)(args.ws + WS_CTL);
    F.tid = threadIdx.x; F.lane = F.tid & 63; F.wave = __builtin_amdgcn_readfirstlane(F.tid >> 6);
    F.G = gridDim.x; { const int bx = blockIdx.x; F.vcu = (F.G % 8 == 0) ? (bx % 8) * (F.G / 8) + bx / 8 : bx; }
    for (int u = F.tid; u < (LDS_BYTES - LDSCTL_OFF) / 4; u += NTHREADS) ((LAS unsigned*)(F.lds + LDSCTL_OFF))[u] = 0u;
    __syncthreads();
    unsigned char* ws = args.ws;
#if MK_ONE_LAUNCH
    XcdBarrier bar = xcd_barrier_post((unsigned*)(F.ctl + CW_BAR), (volatile LAS unsigned*)(F.lds + LDSCTL_OFF));
#define GRID_BAR() xcd_barrier(bar)
#else
#define GRID_BAR() do { } while (0)
#endif
    const int lo = args.ph_lo, hi = args.ph_hi;
#define IN(k) (lo <= (k) && (k) < hi)
#define SEAM(k) do { if (IN(k) && IN((k) + 1)) GRID_BAR(); } while (0)
    const int G = F.G, c = (int)blockIdx.x;
    const float* lng = args.in[I_LNG]; const float* lnb = args.in[I_LNB];

    if (IN(0)) { for (int rep = 0; rep < REP_PRO; ++rep) p0_prologue(F, args); } SEAM(0);
    if (IN(1)) { pg8::Gemm g{(const char*)(ws + WS_XB), (const char*)(ws + WS_WIN), D, 0}; pg8::StaticOrder S{M / 256, 8, G, c};
        pg8::EpiBf<0> E{(bf16*)(ws + WS_P), (bf16*)(ws + WS_KC), PW, nullptr, nullptr, nullptr}; pg8::ADense al{(unsigned)D * 2u};
        pg8::gemm_phase(F.lds, g, S, E, al); } SEAM(1);
    if (IN(2)) { pg8::Gemm g{(const char*)(ws + WS_KC), (const char*)(ws + WS_WC1), 2048, (size_t)256 * 2048 * 2}; pg8::CmpOrder S{c};
        pg8::EpiBf<1> E{(bf16*)(ws + WS_H1), nullptr, 256, (const float*)(ws + WS_SMALL), nullptr, nullptr}; pg8::ADense al{1024u * 2u};
        pg8::gemm_phase(F.lds, g, S, E, al); } SEAM(2);
    if (IN(3)) { p3_compress2(F, args); } SEAM(3);
    if (IN(4)) { for (int rep = 0; rep < REP_ATT; ++rep) p4_attention_mfma(F, args); } SEAM(4);
    if (IN(5)) { pg8::Gemm g{(const char*)(ws + WS_O), (const char*)(ws + WS_WO), D, 0}; pg8::StaticOrder S{M / 256, 4, G, c};
        pg8::EpiRes E{args.in[I_X], args.out, ALPHA}; pg8::ADense al{(unsigned)D * 2u};
        pg8::gemm_phase(F.lds, g, S, E, al); } SEAM(5);
    if (IN(6)) { ln_phase<0>(F, args, lng + 0 * D, lnb + 0 * D); } SEAM(6);
    if (IN(7)) { pg8::Gemm g{(const char*)(ws + WS_XB), (const char*)(ws + WS_FGU), D, 0}; pg8::StaticOrder S{M / 256, DFF / 128, G, c};
        pg8::EpiBf<3> E{(bf16*)(ws + WS_H), nullptr, DFF, nullptr, nullptr, nullptr}; pg8::ADense al{(unsigned)D * 2u};
        pg8::gemm_phase(F.lds, g, S, E, al); } SEAM(7);
    if (IN(8)) { pg8::Gemm g{(const char*)(ws + WS_H), (const char*)(ws + WS_FDN), DFF, 0}; pg8::StaticOrder S{M / 256, 4, G, c};
        pg8::EpiRes E{args.out, args.out, ALPHA}; pg8::ADense al{(unsigned)DFF * 2u};
        pg8::gemm_phase(F.lds, g, S, E, al); } SEAM(8);
    if (IN(9)) { ln_phase<0>(F, args, lng + 1 * D, lnb + 1 * D); } SEAM(9);
    if (IN(10)) { pg8::Gemm g{(const char*)(ws + WS_XB), (const char*)(ws + WS_GIN), D, 0}; pg8::StaticOrder S{M / 256, 8, G, c};
        pg8::EpiBf<2> E{(bf16*)(ws + WS_U), (bf16*)(ws + WS_V), D, nullptr, nullptr, nullptr}; pg8::ADense al{(unsigned)D * 2u};
        pg8::gemm_phase(F.lds, g, S, E, al); } SEAM(10);
    if (IN(11)) { for (int rep = 0; rep < REP_SPA; ++rep) p11_spatial_mfma(F, args); } SEAM(11);
    if (IN(12)) { pg8::Gemm g{(const char*)(ws + WS_Z), (const char*)(ws + WS_GOUT), D, 0}; pg8::StaticOrder S{M / 256, 4, G, c};
        pg8::EpiRes E{args.out, args.out, ALPHA}; pg8::ADense al{(unsigned)D * 2u};
        pg8::gemm_phase(F.lds, g, S, E, al); } SEAM(12);
    if (IN(13)) { ln_phase<1>(F, args, lng + 2 * D, lnb + 2 * D); } SEAM(13);
    {
        LAS int* tab = (LAS int*)(F.lds + LDS_MOE_OFF);
        if (hi > 14 && lo < 24) {
            __syncthreads();
            if (F.tid == 0) { int ts = 0;
                for (int e = 0; e < 8; ++e) { int n = (int)__hip_atomic_load(F.ctl + CW_CNT + 64 * e, __ATOMIC_RELAXED, __HIP_MEMORY_SCOPE_AGENT); if (n > CAP) n = CAP; tab[e] = n; tab[8 + e] = ts; ts += (n + 255) >> 8; }
                tab[16] = ts; }
            __syncthreads();
        }
        const int T = tab[16];
#pragma unroll 1
        for (int ch = 0; ch < 5; ++ch) {
            const int tile0 = 64 * ch; int nM = T - tile0; nM = nM < 0 ? 0 : (nM > 64 ? 64 : nM);
            nM = __builtin_amdgcn_readfirstlane(nM);
            if (IN(14 + 2 * ch)) { pg8::Gemm g{(const char*)(ws + WS_XB), (const char*)(ws + WS_MGU), D, (size_t)2 * DFE * D * 2}; pg8::MoeOrder S{nM, DFE / 128, G, c, tile0, tab};
                pg8::EpiBf<3> E{(bf16*)(ws + WS_HM), nullptr, DFE, nullptr, nullptr, nullptr}; pg8::AGather al{(const int*)(ws + WS_ROWTOK), (unsigned)D * 2u, (LAS int*)(F.lds + LDS_IDX_OFF)};
                pg8::gemm_phase(F.lds, g, S, E, al); }
            SEAM(14 + 2 * ch);
            if (IN(15 + 2 * ch)) { pg8::Gemm g{(const char*)(ws + WS_HM), (const char*)(ws + WS_MDN), DFE, (size_t)D * DFE * 2}; pg8::MoeOrder S{nM, 4, G, c, tile0, tab};
                pg8::EpiBf<4> E{(bf16*)(ws + WS_Y2), nullptr, D, nullptr, (const int*)(ws + WS_ROWDST), (const float*)(ws + WS_ROWGATE)}; pg8::ADense al{(unsigned)DFE * 2u};
                pg8::gemm_phase(F.lds, g, S, E, al); }
            SEAM(15 + 2 * ch);
        }
    }
    if (IN(24)) { ln_phase<2>(F, args, lng + 3 * D, lnb + 3 * D); }
#undef IN
#undef SEAM
}

extern "C" void kernel_launch(void* const* d_in, const int* in_sizes, int n_in, void* d_out, int out_size, void* d_ws, size_t ws_size, hipStream_t stream) {
    static int grid = 0;
    if (grid == 0) {
        if (n_in != 25 || in_sizes[0] != M * D || out_size != M * D || ws_size < WS_END) { fprintf(stderr, "kernel_launch: unexpected shapes (n_in %d, in0 %d, out %d, ws %zu); nothing launched\n", n_in, n_in > 0 ? in_sizes[0] : -1, out_size, ws_size); grid = -1; return; }
        int dev = 0, cus = 0, per_cu = 0;
        if (hipGetDevice(&dev) != hipSuccess || hipDeviceGetAttribute(&cus, hipDeviceAttributeMultiprocessorCount, dev) != hipSuccess) { grid = -1; return; }
        if (hipFuncSetAttribute((const void*)fwd, hipFuncAttributeMaxDynamicSharedMemorySize, LDS_BYTES) != hipSuccess) { fprintf(stderr, "kernel_launch: hipFuncSetAttribute failed\n"); grid = -1; return; }
        if (hipOccupancyMaxActiveBlocksPerMultiprocessor(&per_cu, (const void*)fwd, NTHREADS, LDS_BYTES) != hipSuccess || per_cu < 1) fprintf(stderr, "kernel_launch: occupancy query reports %d\n", per_cu);
        (void)hipGetLastError();
        grid = cus;
    }
    if (grid < 0) return;
    if (hipMemsetAsync((char*)d_ws + WS_CTL, 0, CTL_ZERO_BYTES, stream) != hipSuccess) return;
    Args a{};
    for (int i = 0; i < 25; ++i) a.in[i] = (const float*)d_in[i];
    a.out = (float*)d_out; a.ws = (unsigned char*)d_ws;
#if MK_ONE_LAUNCH
    a.ph_lo = 0; a.ph_hi = N_PHASES;
    hipLaunchKernelGGL(fwd, dim3(grid), dim3(NTHREADS), LDS_BYTES, stream, a);
#else
    for (int p = 0; p < N_PHASES; ++p) { a.ph_lo = p; a.ph_hi = p + 1; hipLaunchKernelGGL(fwd, dim3(grid), dim3(NTHREADS), LDS_BYTES, stream, a); }
#endif
}
```
